# Optimizing an MI355X kernel written in HIP

```python
import jax, jax.numpy as jnp
from jax import lax
import numpy as np

D_MODEL = 1024
BATCH = 8
SEQ = 2048
DEPTH = 1

GRID_W = 64
N_META = 16
EPS = 1e-6

NA_HEADS = 8
NA_HEAD_DIM = 64
NA_WIDTH = NA_HEADS * NA_HEAD_DIM
NA_WIN_H = 8
NA_WIN_W = 16

HG_HEADS = 4
HG_DK = 128
HG_DV = 128
HG_KDIM = HG_HEADS * HG_DK
HG_VDIM = HG_HEADS * HG_DV
HG_CHUNK = 16

D_FF = 4 * D_MODEL

IN_SPLIT = (NA_WIDTH, NA_WIDTH, NA_WIDTH,
            HG_KDIM, HG_KDIM, HG_KDIM, HG_VDIM, HG_VDIM,
            D_MODEL, D_MODEL)
IN_COLS = sum(IN_SPLIT)

kernel_name = "hybrid_natten_hgrn2_griffin_block"


def rms_norm(x, g):
    xf = x.astype(jnp.float32)
    y = xf * lax.rsqrt(jnp.mean(xf * xf, axis=-1, keepdims=True) + EPS)
    return (y * g.astype(jnp.float32)).astype(x.dtype)


def split_cols(a):
    outs, off = [], 0
    for n in IN_SPLIT:
        outs.append(a[..., off:off + n])
        off += n
    return outs


def neighbourhood_attention(q, k, v, rpb):
    B, L, H, dh = q.shape
    T = L - N_META
    rows = T // GRID_W
    kh = min(NA_WIN_H, rows)
    scale = dh ** -0.5
    qm, km, vm = q[:, :N_META], k[:, :N_META], v[:, :N_META]
    qg = q[:, N_META:].reshape(B, rows, GRID_W, H, dh)
    kg = k[:, N_META:].reshape(B, rows, GRID_W, H, dh)
    vg = v[:, N_META:].reshape(B, rows, GRID_W, H, dh)

    r = jnp.arange(rows)
    row_start = jnp.clip(r - kh // 2, 0, rows - kh)
    row_idx = row_start[:, None] + jnp.arange(kh)[None, :]
    k_blk = kg[:, row_idx]
    v_blk = vg[:, row_idx]

    s_win = jnp.einsum('brchd,brjwhd->bhrcjw', qg, k_blk).astype(jnp.float32) * scale
    c = jnp.arange(GRID_W)
    col_start = jnp.clip(c - NA_WIN_W // 2, 0, GRID_W - NA_WIN_W)
    in_win = (c[None, :] >= col_start[:, None]) & (c[None, :] < col_start[:, None] + NA_WIN_W)
    dr = row_idx - r[:, None]
    dc = jnp.clip(c[None, :] - c[:, None], -(NA_WIN_W - 1), NA_WIN_W - 1)
    bias = rpb.astype(jnp.float32)[:, dr[:, None, :, None] + NA_WIN_H - 1,
                                   dc[None, :, None, :] + NA_WIN_W - 1]
    s_win = jnp.where(in_win[:, None, :], s_win + bias[None], -1e30)

    s_meta = jnp.einsum('brchd,bmhd->bhrcm', qg, km).astype(jnp.float32) * scale
    s = jnp.concatenate([s_win.reshape(B, H, rows, GRID_W, kh * GRID_W), s_meta], axis=-1)
    p = jax.nn.softmax(s, axis=-1).astype(v.dtype)
    p_win = p[..., :kh * GRID_W].reshape(B, H, rows, GRID_W, kh, GRID_W)
    p_meta = p[..., kh * GRID_W:]
    o_grid = (jnp.einsum('bhrcjw,brjwhd->brchd', p_win, v_blk)
              + jnp.einsum('bhrcm,bmhd->brchd', p_meta, vm)).reshape(B, T, H, dh)

    s_mm = jnp.einsum('bmhd,bnhd->bhmn', qm, km).astype(jnp.float32) * scale
    p_mm = jax.nn.softmax(s_mm, axis=-1).astype(v.dtype)
    o_meta = jnp.einsum('bhmn,bnhd->bmhd', p_mm, vm)
    return jnp.concatenate([o_meta, o_grid], axis=1)


def chunk_scan(q, k, v, log_f):
    B, L, H, dk = q.shape
    dv = v.shape[-1]
    n = L // HG_CHUNK

    def to_chunks(a):
        return a.reshape(B, n, HG_CHUNK, H, a.shape[-1]).transpose(1, 0, 3, 2, 4)

    tri = jnp.tril(jnp.ones((HG_CHUNK, HG_CHUNK), dtype=bool))

    def step(S, inp):
        qi, ki, vi, gi = inp
        b = jnp.cumsum(gi, axis=-2)
        o_inter = jnp.einsum('bhtk,bhkv->bhtv', qi * jnp.exp(b), S)
        diff = jnp.where(tri[:, :, None], b[..., :, None, :] - b[..., None, :, :], -jnp.inf)
        A = jnp.einsum('bhtk,bhsk,bhtsk->bhts', qi, ki, jnp.exp(diff))
        o_intra = jnp.einsum('bhts,bhsv->bhtv', A, vi)
        b_last = b[..., -1:, :]
        S_new = (jnp.exp(b_last[..., 0, :])[..., None] * S
                 + jnp.einsum('bhsk,bhsv->bhkv', ki * jnp.exp(b_last - b), vi))
        return S_new, o_inter + o_intra

    S0 = jnp.zeros((B, H, dk, dv), jnp.float32)
    _, o = lax.scan(step, S0, (to_chunks(q), to_chunks(k), to_chunks(v), to_chunks(log_f)))
    return o.transpose(1, 0, 3, 2, 4).reshape(B, L, H, dv)


def hgrn2_branch(q, z_fwd, z_bwd, i, g, lb, gain):
    B, L, _ = q.shape
    dtype = q.dtype

    def heads(a, d):
        return a.astype(jnp.float32).reshape(B, L, HG_HEADS, d)

    qh = jax.nn.silu(heads(q, HG_DK))
    vh = heads(i, HG_DV)

    def gates(z, lb_dir):
        lb_h = lb_dir.reshape(HG_HEADS, HG_DK)
        log_f = jnp.logaddexp(jnp.log(lb_h), jnp.log1p(-lb_h) + jax.nn.log_sigmoid(heads(z, HG_DK)))
        return -jnp.expm1(log_f), log_f

    k_f, lf_f = gates(z_fwd, lb[0])
    k_b, lf_b = gates(z_bwd, lb[1])
    rev = lambda a: jnp.flip(a, axis=1)
    o = chunk_scan(qh, k_f, vh, lf_f) + rev(chunk_scan(rev(qh), rev(k_b), rev(vh), rev(lf_b)))
    o = o * lax.rsqrt(jnp.mean(o * o, axis=-1, keepdims=True) + EPS)
    o = o.reshape(B, L, HG_VDIM) * gain.astype(jnp.float32) * jax.nn.silu(g.astype(jnp.float32))
    return o.astype(dtype)


def setup_inputs(seed: int = 0) -> dict:
    key = jax.random.key(seed)
    ks = jax.random.split(key, 14)
    f32 = jnp.float32
    nrm = lambda k, shape, s: jax.random.normal(k, shape, f32) * s
    return {
        "x": nrm(ks[0], (BATCH, SEQ, D_MODEL), 1.0),
        "meta_tokens": nrm(ks[1], (N_META, D_MODEL), 1.0),
        "w_in": nrm(ks[2], (DEPTH, D_MODEL, IN_COLS), D_MODEL ** -0.5),
        "w_na_out": nrm(ks[3], (DEPTH, NA_WIDTH, D_MODEL), NA_WIDTH ** -0.5),
        "w_hg_out": nrm(ks[4], (DEPTH, HG_VDIM, D_MODEL), HG_VDIM ** -0.5),
        "w_o": nrm(ks[5], (DEPTH, D_MODEL, D_MODEL), D_MODEL ** -0.5),
        "w_up": nrm(ks[6], (DEPTH, D_MODEL, D_FF), D_MODEL ** -0.5),
        "w_down": nrm(ks[7], (DEPTH, D_FF, D_MODEL), D_FF ** -0.5),
        "norm_mix": 1.0 + nrm(ks[8], (DEPTH, D_MODEL), 0.05),
        "norm_mlp": 1.0 + nrm(ks[9], (DEPTH, D_MODEL), 0.05),
        "norm_final": 1.0 + nrm(ks[10], (D_MODEL,), 0.05),
        "hg_norm": 1.0 + nrm(ks[11], (DEPTH, HG_VDIM), 0.05),
        "na_rpb": nrm(ks[12], (DEPTH, NA_HEADS, 2 * NA_WIN_H - 1, 2 * NA_WIN_W - 1), 0.1),
        "hg_lb_logits": nrm(ks[13], (2, DEPTH + 1, HG_KDIM), 0.5),
    }


def reference(x, meta_tokens, w_in, w_na_out, w_hg_out, w_o, w_up, w_down,
              norm_mix, norm_mlp, norm_final, hg_norm, na_rpb, hg_lb_logits):
    B = x.shape[0]
    h = jnp.concatenate([jnp.broadcast_to(meta_tokens.astype(x.dtype)[None], (B, N_META, D_MODEL)), x], axis=1)
    L = h.shape[1]
    lb_all = jnp.cumsum(jax.nn.softmax(hg_lb_logits.astype(jnp.float32), axis=1), axis=1)
    for l in range(DEPTH):
        a = rms_norm(h, norm_mix[l])
        (q_na, k_na, v_na, q_hg, z_f, z_b, i_hg, g_hg, gate_na, gate_hg) = split_cols(a @ w_in[l])
        hd = lambda t: t.reshape(B, L, NA_HEADS, NA_HEAD_DIM)
        y_na = neighbourhood_attention(hd(q_na), hd(k_na), hd(v_na), na_rpb[l]).reshape(B, L, NA_WIDTH) @ w_na_out[l]
        y_hg = hgrn2_branch(q_hg, z_f, z_b, i_hg, g_hg, lb_all[:, l], hg_norm[l]) @ w_hg_out[l]
        mix = jax.nn.sigmoid(gate_na) * y_na + jax.nn.sigmoid(gate_hg) * y_hg
        h = h + mix @ w_o[l]
        m = rms_norm(h, norm_mlp[l])
        h = h + jnp.square(jax.nn.relu(m @ w_up[l])) @ w_down[l]
    h = rms_norm(h, norm_final)
    return h[:, N_META:]
```

```cpp
#include <hip/hip_runtime.h>
#include <cstdio>
#include <cstdint>
constexpr int NWAVES = 8;
constexpr int NB = 8, SEQ = 2048, D = 1024, M = NB * SEQ, NIN = 6144, FF = 4096;
constexpr float EPS = 1e-6f;
constexpr size_t MiB = 1u << 20, KiB = 1024;
constexpr size_t WS_SSQ1 = 245 * MiB, WS_SSQ2 = 246 * MiB,
                WS_KNAM = 128 * KiB, WS_VTM = 144 * KiB, WS_KFTM = 160 * KiB, WS_VHTM = 176 * KiB, WS_GFM = 192 * KiB, WS_LB = 196 * KiB, WS_DSEG = 256 * KiB;
constexpr size_t WS_WIN = 1 * MiB, WS_WNA = 13 * MiB, WS_WHG = 14 * MiB, WS_WO = 15 * MiB, WS_WUP = 17 * MiB, WS_WDN = 237 * MiB;
constexpr size_t WS_XN = 25 * MiB;
constexpr size_t WS_QNA = 57 * MiB, WS_KNA = 73 * MiB, WS_VT = 89 * MiB, WS_QF = 105 * MiB, WS_QB = 121 * MiB, WS_KF = 137 * MiB, WS_KFT = 153 * MiB, WS_KB = 169 * MiB, WS_KBT = 185 * MiB,
                 WS_VHT = 201 * MiB, WS_GHG = 217 * MiB, WS_GF = 233 * MiB, WS_GB = 235 * MiB;
constexpr size_t WS_OHG = WS_KNA;
constexpr size_t WS_T = WS_VT, WS_MIX = WS_KF, WS_U = WS_QNA, WS_END = 247 * MiB;
constexpr int LDS_BYTES = 163840, LDS_CTL = 162816;
constexpr size_t WS_C4CNT = 768 * 1024 + 16 * 1024;

namespace pg8 {
#define PG8_LAS __attribute__((address_space(3)))
typedef unsigned short bf16_t;
typedef short bf16x8 __attribute__((ext_vector_type(8)));
typedef float f32x4 __attribute__((ext_vector_type(4)));
typedef unsigned u32x4 __attribute__((ext_vector_type(4)));
constexpr int BM = 256, BK = 64, HALF = 128, HTB = HALF * BK * 2  , STAGE_BYTES = 8 * HTB, NXCD = 8, WGM = 8;

__host__ __device__ __forceinline__ int lds_byte(int r, int c) { const int st = (r >> 4) * 2 + (c >> 5), rr = r & 15, cc = c & 31, ob = rr * 64 + cc * 2; return st * 1024 + (ob ^ (((ob >> 9) & 1) << 5)); }
__host__ __device__ __forceinline__ void stage_rc(int b, int& R, int& C) { const int st = b / 1024, sb = b % 1024, swz = sb ^ (((sb >> 9) & 1) << 5); R = (st >> 1) * 16 + swz / 64; C = (st & 1) * 32 + (swz % 64) / 2; }
__host__ __device__ __forceinline__ int perm32(int rho) { const int n = rho >> 4, i = rho & 15; return 8 * (i >> 2) + 4 * n + (i & 3); }

struct Unit { int pm, pn; };
struct Gemm { const bf16_t* A; const bf16_t* Bt; int M, N, K; };

struct StaticOrder {
    int nM, nN, nwg, G, c;
    __host__ __device__ void init(int M, int N, int G_, int c_) { nM = M / BM; nN = N / BM; nwg = nM * nN; G = G_; c = c_; }
    __host__ __device__ bool next(int i, Unit& u) const {
        const long L = (long)i * G + c; if (L >= nwg) return false;
        int wgid = (int)L; { const int q = nwg / NXCD, r = nwg % NXCD, xcd = wgid % NXCD, off = wgid / NXCD; wgid = (xcd < r ? xcd * (q + 1) : r * (q + 1) + (xcd - r) * q) + off; }
        const int nig = WGM * nN, gid = wgid / nig, fm = gid * WGM, gsz = (nM - fm) < WGM ? (nM - fm) : WGM;
        u.pm = fm + ((wgid % nig) % gsz); u.pn = (wgid % nig) / gsz; return true;
    }
    __device__ __forceinline__ void a_ready(const Unit&) const {}
    __device__ __forceinline__ void done(const Unit&) const {}
};


struct PairOrder {
    StaticOrder base; Unit u0;
    __host__ __device__ void init(int M_, int N_, int G_, int c_) { base.init(M_, N_, G_, c_); base.next(0, u0); }
    __host__ __device__ bool next(int i, Unit& u) const { if (i >= 2) return false; u.pm = u0.pm + 64 * i; u.pn = u0.pn + 4 * i; return true; }
    __device__ __forceinline__ void a_ready(const Unit&) const {}
    __device__ __forceinline__ void done(const Unit&) const {}
};

typedef float cvt_f32x2_t __attribute__((ext_vector_type(2)));
typedef __bf16 cvt_bf16x2_t __attribute__((ext_vector_type(2)));
__device__ __forceinline__ unsigned cvt_pk_bf16(float lo, float hi) { const cvt_f32x2_t v = {lo, hi}; const cvt_bf16x2_t b = __builtin_convertvector(v, cvt_bf16x2_t); return __builtin_bit_cast(unsigned, b); }
__device__ __forceinline__ unsigned short f2bf(float f) { unsigned u = __builtin_bit_cast(unsigned, f); return (unsigned short)((u + 0x7fffu + ((u >> 16) & 1u)) >> 16); }
__device__ __forceinline__ float bflo(unsigned w) { return __builtin_bit_cast(float, w << 16); }
__device__ __forceinline__ float bfhi(unsigned w) { return __builtin_bit_cast(float, w & 0xffff0000u); }
__device__ __forceinline__ float sigm(float x) { return __builtin_amdgcn_rcpf(1.0f + __expf(-x)); }
template <int CTRL> __device__ __forceinline__ float dpp_mov(float v) { return __builtin_bit_cast(float, __builtin_amdgcn_update_dpp(0, __builtin_bit_cast(int, v), CTRL, 0xf, 0xf, true)); }
__device__ __forceinline__ float row_prefix16(float v, int fr) {
    v += dpp_mov<0x111>(v); v += dpp_mov<0x112>(v); v += dpp_mov<0x114>(v); v += dpp_mov<0x118>(v); (void)fr;
    return v;
}
__device__ __forceinline__ float row_suffix16(float v, int fr) {
    v += dpp_mov<0x101>(v); v += dpp_mov<0x102>(v); v += dpp_mov<0x104>(v); v += dpp_mov<0x108>(v); (void)fr;
    return v;
}

enum EpiMode { EM_IN = 0, EM_C1A = 1, EM_C1B = 2, EM_C2 = 3, EM_C3 = 4, EM_C4 = 5 };
template <int MODE> struct EpiAll {
    static constexpr bool PERM = true, AFTER_DRAIN = false;
    static constexpr int mode = MODE; unsigned char* ws; float* out; const float* x; const float* gain; const float* gfin;
    __device__ __forceinline__ void operator()(const f32x4 (&acc)[2][2][4][2], const Unit& u, int wr, int wc, int fr, int fq) const {
        const int pn = u.pn;
        const int row0 = u.pm * BM + wr * 64 + fr;
#define EP_B(off) ((bf16_t*)(ws + (off)))
#define EP_F(off) ((float*)(ws + (off)))
        bf16_t* const QNA = EP_B(WS_QNA); bf16_t* const KNA = EP_B(WS_KNA); bf16_t* const VT = EP_B(WS_VT); bf16_t* const QF = EP_B(WS_QF); bf16_t* const QB = EP_B(WS_QB); bf16_t* const KF = EP_B(WS_KF); bf16_t* const KB = EP_B(WS_KB);
        bf16_t* const KFT = EP_B(WS_KFT); bf16_t* const KBT = EP_B(WS_KBT); bf16_t* const VHT = EP_B(WS_VHT); bf16_t* const GHG = EP_B(WS_GHG); float* const GF = EP_F(WS_GF); float* const GB = EP_F(WS_GB); const float* const LB = EP_F(WS_LB);
        bf16_t* const SNA = (bf16_t*)out; bf16_t* const SHG = (bf16_t*)out + (size_t)M * D;
        bf16_t* const T = EP_B(WS_T); bf16_t* const MIX = EP_B(WS_MIX); bf16_t* const H1B = EP_B(WS_XN); bf16_t* const U = EP_B(WS_U); float* const ssq1 = EP_F(WS_SSQ1); float* const ssq2 = EP_F(WS_SSQ2);
#undef EP_B
#undef EP_F
        const int cl0 = wc * 32 + 8 * fq;
        if (mode == EM_IN) {
            if (pn < 4) {
                bf16_t* base = (pn < 2) ? QNA : KNA; const float sc = (pn < 2) ? 0.125f : 1.0f; const int colt = (pn & 1) * 256 + cl0;
#pragma unroll
                for (int ai = 0; ai < 2; ++ai)
#pragma unroll
                    for (int m = 0; m < 4; ++m) { bf16_t* rowp = base + (size_t)(row0 + ai * HALF + m * 16) * 512 + colt;
#pragma unroll
                        for (int bj = 0; bj < 2; ++bj) { const f32x4 v0 = acc[ai][bj][m][0] * sc, v1 = acc[ai][bj][m][1] * sc; u32x4 w;
                            w.x = cvt_pk_bf16(v0[0], v0[1]); w.y = cvt_pk_bf16(v0[2], v0[3]); w.z = cvt_pk_bf16(v1[0], v1[1]); w.w = cvt_pk_bf16(v1[2], v1[3]);
                            *(u32x4*)(rowp + bj * HALF) = w; } }
            } else if (pn < 6) {
                const int colt = (pn - 4) * 256 + cl0;
#pragma unroll
                for (int ai = 0; ai < 2; ++ai)
#pragma unroll
                    for (int m = 0; m < 4; ++m) { const int row = row0 + ai * HALF + m * 16; const int b = row >> 11, t = row & 2047, r = t >> 6, c = t & 63;
#pragma unroll
                        for (int bj = 0; bj < 2; ++bj) { const int col = colt + bj * HALF; const int h = col >> 6, d0 = col & 63;
                            bf16_t* bp = VT + ((((size_t)(b * 8 + h) * 32 + r) * 64 + d0) * 64 + c);
#pragma unroll
                            for (int n = 0; n < 2; ++n)
#pragma unroll
                                for (int j = 0; j < 4; ++j) bp[(4 * n + j) * 64] = f2bf(acc[ai][bj][m][n][j]); } }
            } else if (pn < 14) {
                const int ch0 = (pn - 6) * 64 + wc * 16 + fq * 4;
                const f32x4 lbf = *(const f32x4*)(LB + ch0), lbb = *(const f32x4*)(LB + 512 + ch0);
#pragma unroll
                for (int ai = 0; ai < 2; ++ai)
#pragma unroll
                    for (int m = 0; m < 4; ++m) { const int row = row0 + ai * HALF + m * 16; const int chunk = row >> 4;
                        const f32x4 q = acc[ai][0][m][0], zf = acc[ai][0][m][1], zb = acc[ai][1][m][0], iv = acc[ai][1][m][1];
                        float qfv[4], kfv[4], qbv[4], kbv[4]; f32x4 gfv, gbv;
#pragma unroll
                        for (int j = 0; j < 4; ++j) {
                            const float qs = q[j] * sigm(q[j]);
                            const float ff = lbf[j] + (1.0f - lbf[j]) * sigm(zf[j]);
                            const float fb = lbb[j] + (1.0f - lbb[j]) * sigm(zb[j]);
                            const float bf_ = row_prefix16(__builtin_amdgcn_logf(ff) * 0.69314718056f, fr), bb_ = row_suffix16(__builtin_amdgcn_logf(fb) * 0.69314718056f, fr);
                            const float ef = __expf(bf_), eb = __expf(bb_);
                            qfv[j] = qs * ef; kfv[j] = (1.0f - ff) * __expf(-bf_);
                            qbv[j] = qs * eb; kbv[j] = (1.0f - fb) * __expf(-bb_);
                            gfv[j] = ef; gbv[j] = eb;
                        }
                        typedef unsigned u32x2 __attribute__((ext_vector_type(2)));
                        const size_t ro = (size_t)row * 512 + ch0;
                        u32x2 w;
                        w.x = cvt_pk_bf16(qfv[0], qfv[1]); w.y = cvt_pk_bf16(qfv[2], qfv[3]); *(u32x2*)(QF + ro) = w;
                        w.x = cvt_pk_bf16(qbv[0], qbv[1]); w.y = cvt_pk_bf16(qbv[2], qbv[3]); *(u32x2*)(QB + ro) = w;
                        w.x = cvt_pk_bf16(kfv[0], kfv[1]); w.y = cvt_pk_bf16(kfv[2], kfv[3]); *(u32x2*)(KF + ro) = w;
                        w.x = cvt_pk_bf16(kbv[0], kbv[1]); w.y = cvt_pk_bf16(kbv[2], kbv[3]); *(u32x2*)(KB + ro) = w;
                        const size_t to = ((size_t)chunk * 512 + ch0) * 16 + fr;
#pragma unroll
                        for (int j = 0; j < 4; ++j) { KFT[to + j * 16] = f2bf(kfv[j]); KBT[to + j * 16] = f2bf(kbv[j]); VHT[to + j * 16] = f2bf(iv[j]); }
                        if (fr == 15) *(f32x4*)(GF + (size_t)chunk * 512 + ch0) = gfv;
                        if (fr == 0)  *(f32x4*)(GB + (size_t)chunk * 512 + ch0) = gbv;
                    }
            } else if (pn < 16) {
                const int colt = (pn - 14) * 256 + cl0;
#pragma unroll
                for (int bj = 0; bj < 2; ++bj) { const f32x4 g0 = *(const f32x4*)(gain + colt + bj * HALF), g1 = *(const f32x4*)(gain + colt + bj * HALF + 4);
#pragma unroll
                    for (int ai = 0; ai < 2; ++ai)
#pragma unroll
                        for (int m = 0; m < 4; ++m) { f32x4 v0 = acc[ai][bj][m][0], v1 = acc[ai][bj][m][1];
#pragma unroll
                            for (int j = 0; j < 4; ++j) { v0[j] = v0[j] * sigm(v0[j]) * g0[j]; v1[j] = v1[j] * sigm(v1[j]) * g1[j]; }
                            u32x4 w; w.x = cvt_pk_bf16(v0[0], v0[1]); w.y = cvt_pk_bf16(v0[2], v0[3]); w.z = cvt_pk_bf16(v1[0], v1[1]); w.w = cvt_pk_bf16(v1[2], v1[3]);
                            *(u32x4*)(GHG + (size_t)(row0 + ai * HALF + m * 16) * 512 + colt + bj * HALF) = w; } }
            } else {
                bf16_t* base = (pn < 20) ? SNA : SHG; const int colt = ((pn - 16) & 3) * 256 + cl0;
#pragma unroll
                for (int ai = 0; ai < 2; ++ai)
#pragma unroll
                    for (int m = 0; m < 4; ++m)
#pragma unroll
                        for (int bj = 0; bj < 2; ++bj) { f32x4 v0 = acc[ai][bj][m][0], v1 = acc[ai][bj][m][1];
#pragma unroll
                            for (int j = 0; j < 4; ++j) { v0[j] = sigm(v0[j]); v1[j] = sigm(v1[j]); }
                            u32x4 w; w.x = cvt_pk_bf16(v0[0], v0[1]); w.y = cvt_pk_bf16(v0[2], v0[3]); w.z = cvt_pk_bf16(v1[0], v1[1]); w.w = cvt_pk_bf16(v1[2], v1[3]);
                            *(u32x4*)(base + (size_t)(row0 + ai * HALF + m * 16) * 1024 + colt + bj * HALF) = w; }
            }
            return;
        }
        const int colt = (mode == EM_C1A ? (pn & 3) : pn) * BM + cl0;
        if (mode == EM_C1A || mode == EM_C1B) {
            const bool second = (mode == EM_C1B) || (pn >= 4); const int row0c = (mode == EM_C1A) ? (row0 & (M - 1)) : row0;
            const bf16_t* gate = second ? SHG : SNA; bf16_t* dst = second ? MIX : T;
#pragma unroll
            for (int ai = 0; ai < 2; ++ai) {
                u32x4 gv[4][2], tv[4][2];
#pragma unroll
                for (int m = 0; m < 4; ++m)
#pragma unroll
                    for (int bj = 0; bj < 2; ++bj) { const size_t off = (size_t)(row0c + ai * HALF + m * 16) * 1024 + colt + bj * HALF;
                        gv[m][bj] = *(const u32x4*)(gate + off); if (second) tv[m][bj] = *(const u32x4*)(T + off); else tv[m][bj] = (u32x4){0u, 0u, 0u, 0u}; }
#pragma unroll
                for (int m = 0; m < 4; ++m)
#pragma unroll
                    for (int bj = 0; bj < 2; ++bj) { const size_t off = (size_t)(row0c + ai * HALF + m * 16) * 1024 + colt + bj * HALF;
                        const u32x4 g = gv[m][bj], tt = tv[m][bj]; const f32x4 a0 = acc[ai][bj][m][0], a1 = acc[ai][bj][m][1];
                        const float r0 = a0[0] * bflo(g.x) + bflo(tt.x), r1 = a0[1] * bfhi(g.x) + bfhi(tt.x), r2 = a0[2] * bflo(g.y) + bflo(tt.y), r3 = a0[3] * bfhi(g.y) + bfhi(tt.y);
                        const float r4 = a1[0] * bflo(g.z) + bflo(tt.z), r5 = a1[1] * bfhi(g.z) + bfhi(tt.z), r6 = a1[2] * bflo(g.w) + bflo(tt.w), r7 = a1[3] * bfhi(g.w) + bfhi(tt.w);
                        u32x4 w; w.x = cvt_pk_bf16(r0, r1); w.y = cvt_pk_bf16(r2, r3); w.z = cvt_pk_bf16(r4, r5); w.w = cvt_pk_bf16(r6, r7);
                        *(u32x4*)(dst + off) = w; }
            }
        } else if (mode == EM_C4) {
            f32x4 (&hacc)[2][2][4][2] = const_cast<f32x4 (&)[2][2][4][2]>(acc);
#pragma unroll
            for (int ai = 0; ai < 2; ++ai)
#pragma unroll
                for (int mp = 0; mp < 2; ++mp) {
                    f32x4 pre[2][2][2];
#pragma unroll
                    for (int mm = 0; mm < 2; ++mm)
#pragma unroll
                        for (int bj = 0; bj < 2; ++bj) { const size_t off = (size_t)(row0 + ai * HALF + (2 * mp + mm) * 16) * 1024 + colt + bj * HALF;
                            const u32x4 hb = *(const u32x4*)(H1B + off);
                            pre[mm][bj][0] = (f32x4){bflo(hb.x), bfhi(hb.x), bflo(hb.y), bfhi(hb.y)}; pre[mm][bj][1] = (f32x4){bflo(hb.z), bfhi(hb.z), bflo(hb.w), bfhi(hb.w)}; }
#pragma unroll
                    for (int mm = 0; mm < 2; ++mm) { const int m = 2 * mp + mm; const int row = row0 + ai * HALF + m * 16; float s = 0.f;
#pragma unroll
                        for (int bj = 0; bj < 2; ++bj) { const f32x4 h0 = pre[mm][bj][0] + acc[ai][bj][m][0], h1 = pre[mm][bj][1] + acc[ai][bj][m][1];
                            hacc[ai][bj][m][0] = h0; hacc[ai][bj][m][1] = h1;
                            s += (h0[0] * h0[0] + h0[1] * h0[1]) + (h0[2] * h0[2] + h0[3] * h0[3]) + (h1[0] * h1[0] + h1[1] * h1[1]) + (h1[2] * h1[2] + h1[3] * h1[3]); }
                        s += __shfl_xor(s, 16); s += __shfl_xor(s, 32);
                        if (fq == 0) ssq2[(size_t)row * 16 + pn * 4 + wc] = s; }
                    asm volatile("" ::: "memory");
                }
            asm volatile("s_waitcnt vmcnt(0)" ::: "memory");
            __builtin_amdgcn_s_barrier();
            if (threadIdx.x == 0) {
                unsigned* cnt = (unsigned*)(ws + WS_C4CNT) + 16 * u.pm;
                __builtin_amdgcn_fence(__ATOMIC_RELEASE, "agent");
                asm volatile("s_waitcnt vmcnt(0)" ::: "memory");
                __hip_atomic_fetch_add(cnt, 1u, __ATOMIC_RELAXED, __HIP_MEMORY_SCOPE_AGENT);
                unsigned spins = 0;
                while (__hip_atomic_load(cnt, __ATOMIC_RELAXED, __HIP_MEMORY_SCOPE_AGENT) < 4u) { __builtin_amdgcn_s_sleep(2); if (++spins > (1u << 22)) break; }
                __builtin_amdgcn_fence(__ATOMIC_ACQUIRE, "agent");
                asm volatile("s_waitcnt vmcnt(0)" ::: "memory");
            }
            __builtin_amdgcn_s_barrier();
            asm volatile("" ::: "memory");
            const f32x4 gA0 = *(const f32x4*)(gfin + colt), gA1 = *(const f32x4*)(gfin + colt + 4), gB0 = *(const f32x4*)(gfin + colt + HALF), gB1 = *(const f32x4*)(gfin + colt + HALF + 4);
#pragma unroll
            for (int ai = 0; ai < 2; ++ai)
#pragma unroll
                for (int mp = 0; mp < 2; ++mp) {
                    f32x4 pp[2][4];
#pragma unroll
                    for (int mm = 0; mm < 2; ++mm)
#pragma unroll
                        for (int q = 0; q < 4; ++q) pp[mm][q] = *(const f32x4*)(ssq2 + (size_t)(row0 + ai * HALF + (2 * mp + mm) * 16) * 16 + 4 * q);
#pragma unroll
                    for (int mm = 0; mm < 2; ++mm) { const int m = 2 * mp + mm; const int row = row0 + ai * HALF + m * 16; const size_t off = (size_t)row * 1024 + colt;
                        const f32x4 p0 = pp[mm][0], p1 = pp[mm][1], p2 = pp[mm][2], p3 = pp[mm][3];
                        const float rs = rsqrtf(((((p0[0] + p0[1]) + (p0[2] + p0[3])) + ((p1[0] + p1[1]) + (p1[2] + p1[3]))) + (((p2[0] + p2[1]) + (p2[2] + p2[3])) + ((p3[0] + p3[1]) + (p3[2] + p3[3])))) * (1.0f / 1024.0f) + 1e-6f);
                        *(f32x4*)(out + off) = acc[ai][0][m][0] * rs * gA0; *(f32x4*)(out + off + 4) = acc[ai][0][m][1] * rs * gA1;
                        *(f32x4*)(out + off + HALF) = acc[ai][1][m][0] * rs * gB0; *(f32x4*)(out + off + HALF + 4) = acc[ai][1][m][1] * rs * gB1; }
                    asm volatile("" ::: "memory");
                }
        } else if (mode == EM_C2) {
            const float* base = (mode == EM_C2) ? x : (const float*)out; float* ssq = (mode == EM_C2) ? ssq1 : ssq2;
#pragma unroll
            for (int ai = 0; ai < 2; ++ai) {
                f32x4 pre[4][2][2];
#pragma unroll
                for (int m = 0; m < 4; ++m)
#pragma unroll
                    for (int bj = 0; bj < 2; ++bj) { const size_t off = (size_t)(row0 + ai * HALF + m * 16) * 1024 + colt + bj * HALF;
                        pre[m][bj][0] = *(const f32x4*)(base + off); pre[m][bj][1] = *(const f32x4*)(base + off + 4); }
#pragma unroll
                for (int m = 0; m < 4; ++m) { const int row = row0 + ai * HALF + m * 16; float s = 0.f;
#pragma unroll
                    for (int bj = 0; bj < 2; ++bj) { const size_t off = (size_t)row * 1024 + colt + bj * HALF;
                        const f32x4 h0 = pre[m][bj][0] + acc[ai][bj][m][0], h1 = pre[m][bj][1] + acc[ai][bj][m][1];
                        s += (h0[0] * h0[0] + h0[1] * h0[1]) + (h0[2] * h0[2] + h0[3] * h0[3]) + (h1[0] * h1[0] + h1[1] * h1[1]) + (h1[2] * h1[2] + h1[3] * h1[3]);
                        if (mode == EM_C2) { u32x4 w; w.x = cvt_pk_bf16(h0[0], h0[1]); w.y = cvt_pk_bf16(h0[2], h0[3]); w.z = cvt_pk_bf16(h1[0], h1[1]); w.w = cvt_pk_bf16(h1[2], h1[3]);
                            *(u32x4*)(H1B + off) = w; } }
                    s += __shfl_xor(s, 16); s += __shfl_xor(s, 32);
                    if (fq == 0) ssq[(size_t)row * 16 + pn * 4 + wc] = s; }
            }
        } else {
#pragma unroll
            for (int ai = 0; ai < 2; ++ai) {
                f32x4 pp[4][4];
#pragma unroll
                for (int m = 0; m < 4; ++m)
#pragma unroll
                    for (int q = 0; q < 4; ++q) pp[m][q] = *(const f32x4*)(ssq1 + (size_t)(row0 + ai * HALF + m * 16) * 16 + 4 * q);
#pragma unroll
                for (int m = 0; m < 4; ++m) { const int row = row0 + ai * HALF + m * 16;
                    const f32x4 p0 = pp[m][0], p1 = pp[m][1], p2 = pp[m][2], p3 = pp[m][3];
                    const float rs = rsqrtf(((((p0[0] + p0[1]) + (p0[2] + p0[3])) + ((p1[0] + p1[1]) + (p1[2] + p1[3]))) + (((p2[0] + p2[1]) + (p2[2] + p2[3])) + ((p3[0] + p3[1]) + (p3[2] + p3[3])))) * (1.0f / 1024.0f) + 1e-6f);
#pragma unroll
                    for (int bj = 0; bj < 2; ++bj) { f32x4 v0 = acc[ai][bj][m][0] * rs, v1 = acc[ai][bj][m][1] * rs;
#pragma unroll
                        for (int j = 0; j < 4; ++j) { const float a = fmaxf(v0[j], 0.f), b = fmaxf(v1[j], 0.f); v0[j] = a * a; v1[j] = b * b; }
                        u32x4 w; w.x = cvt_pk_bf16(v0[0], v0[1]); w.y = cvt_pk_bf16(v0[2], v0[3]); w.z = cvt_pk_bf16(v1[0], v1[1]); w.w = cvt_pk_bf16(v1[2], v1[3]);
                        *(u32x4*)(U + (size_t)row * 4096 + colt + bj * HALF) = w; } }
            }
        }
    }
};

template <class Epi, class Sched, bool ALIGN_EPI = false, bool SP2 = false>
__device__ __forceinline__ void gemm_phase(PG8_LAS unsigned char* lds, const Gemm g, const Sched& S, const Epi& E) {
    int tid_ = threadIdx.x; asm volatile("" : "+v"(tid_));
    const int tid = tid_, wid = __builtin_amdgcn_readfirstlane(tid >> 6), lane = tid & 63, wr = wid >> 2, wc = wid & 3, fr = lane & 15, fq = lane >> 4;
    const int K = g.K, nt = K / BK;
    unsigned voffA[2], voffB[2];
#pragma unroll
    for (int i = 0; i < 2; ++i) { int R, C; stage_rc(tid * 16 + i * 8192, R, C); const int Rb = Epi::PERM ? ((R & ~31) + perm32(R & 31)) : R;
        voffA[i] = (unsigned)(R * K + C) * 2u; voffB[i] = (unsigned)(Rb * K + C) * 2u; }
    const size_t kstep = (size_t)(BK * 2);
    const size_t hstep = (size_t)HALF * K * 2;
    const size_t tstep = 2 * hstep;
    const unsigned ldsw = (unsigned)wid * 1024u;
    const int aoff = lds_byte(wr * 64 + fr, fq * 8), boff = lds_byte(wc * 32 + fr, fq * 8);
#define PG8_SA(b, h) (((b) * 2 + (h)) * HTB)
#define PG8_SB(b, h) ((4 + (b) * 2 + (h)) * HTB)
#define PG8_STAGE(bufoff, gbase, voff) do { _Pragma("unroll") for (int _i = 0; _i < 2; ++_i) \
        __builtin_amdgcn_global_load_lds((const unsigned*)((const char*)(gbase) + (voff)[_i]), (PG8_LAS unsigned*)(lds + (bufoff) + ldsw + _i * 8192), 16, 0, 0); } while (0)
#define PG8_LDA(dst, b, h) do { _Pragma("unroll") for (int m = 0; m < 4; ++m) _Pragma("unroll") for (int k = 0; k < 2; ++k) dst[m][k] = *(const PG8_LAS bf16x8*)(lds + PG8_SA(b, h) + aoff + m * 2048 + k * 1024); } while (0)
#define PG8_LDB(dst, b, h) do { _Pragma("unroll") for (int n = 0; n < 2; ++n) _Pragma("unroll") for (int k = 0; k < 2; ++k) dst[n][k] = *(const PG8_LAS bf16x8*)(lds + PG8_SB(b, h) + boff + n * 2048 + k * 1024); } while (0)
#define PG8_MMA(ai, bj, At, Bt) do { __builtin_amdgcn_s_setprio(1); _Pragma("unroll") for (int m = 0; m < 4; ++m) _Pragma("unroll") for (int n = 0; n < 2; ++n) _Pragma("unroll") for (int k = 0; k < 2; ++k) \
        acc[ai][bj][m][n] = __builtin_amdgcn_mfma_f32_16x16x32_bf16(Bt[n][k], At[m][k], acc[ai][bj][m][n], 0, 0, 0); __builtin_amdgcn_s_setprio(0); } while (0)
#define PG8_WAIT_V(n) asm volatile("s_waitcnt vmcnt(" #n ")" ::: "memory")
#define PG8_WAIT_L(n) asm volatile("s_waitcnt lgkmcnt(" #n ")" ::: "memory")
#define PG8_BAR __builtin_amdgcn_s_barrier()
#define PG8_SCHED __builtin_amdgcn_sched_barrier(0)
    Unit cur, nxt; int ui = 0;
    if (!S.next(0, cur)) return;
    f32x4 acc[2][2][4][2];
#pragma unroll
    for (int a = 0; a < 2; ++a)
#pragma unroll
        for (int b = 0; b < 2; ++b)
#pragma unroll
            for (int m = 0; m < 4; ++m)
#pragma unroll
                for (int n = 0; n < 2; ++n) acc[a][b][m][n] = (f32x4){0.f, 0.f, 0.f, 0.f};
    bf16x8 At[4][2], B0[2][2], B1[2][2];
    const char* cA = (const char*)g.A + (size_t)cur.pm * tstep; const char* cB = (const char*)g.Bt + (size_t)cur.pn * tstep;
    S.a_ready(cur);
    if constexpr (SP2) {
        PG8_STAGE(PG8_SB(0, 0), cB, voffB); PG8_STAGE(PG8_SB(0, 1), cB + hstep, voffB); PG8_STAGE(PG8_SA(0, 0), cA, voffA); PG8_STAGE(PG8_SA(0, 1), cA + hstep, voffA);
        if (wr == 1) PG8_BAR;
        PG8_WAIT_V(2); PG8_BAR;
        PG8_STAGE(PG8_SB(1, 0), cB + kstep, voffB); PG8_STAGE(PG8_SA(1, 0), cA + kstep, voffA); PG8_STAGE(PG8_SB(1, 1), cB + hstep + kstep, voffB);
        PG8_WAIT_V(6); PG8_BAR;
    } else {
        PG8_STAGE(PG8_SB(0, 0), cB, voffB); PG8_STAGE(PG8_SA(0, 0), cA, voffA); PG8_STAGE(PG8_SB(0, 1), cB + hstep, voffB); PG8_STAGE(PG8_SA(0, 1), cA + hstep, voffA);
        if (wr == 1) PG8_BAR;
        PG8_WAIT_V(4); PG8_BAR;
        PG8_STAGE(PG8_SB(1, 0), cB + kstep, voffB); PG8_STAGE(PG8_SA(1, 0), cA + kstep, voffA); PG8_STAGE(PG8_SB(1, 1), cB + hstep + kstep, voffB);
        PG8_WAIT_V(6); PG8_BAR;
    }
    for (;;) {
        const bool has_next = S.next(ui + 1, nxt);
        const char* nA = has_next ? (const char*)g.A + (size_t)nxt.pm * tstep : cA; const char* nB = has_next ? (const char*)g.Bt + (size_t)nxt.pn * tstep : cB;
        for (int t = 0; t < nt; t += 2) {
            const bool last = (t == nt - 2);
            const char* a1 = cA + (size_t)(t + 1) * kstep;
            const char* a2 = last ? nA : cA + (size_t)(t + 2) * kstep; const char* b2 = last ? nB : cB + (size_t)(t + 2) * kstep;
            const char* a3 = a2 + kstep; const char* b3 = b2 + kstep;
            if (last && has_next) S.a_ready(nxt);
            if constexpr (SP2) {
            PG8_LDB(B0, 0, 0); PG8_LDB(B1, 0, 1); PG8_SCHED; PG8_LDA(At, 0, 0); PG8_STAGE(PG8_SA(1, 1), a1 + hstep, voffA);
            PG8_WAIT_V(8); PG8_WAIT_L(0); PG8_BAR; PG8_MMA(0, 0, At, B0); PG8_MMA(0, 1, At, B1); PG8_BAR; PG8_SCHED;
            PG8_LDA(At, 0, 1); PG8_STAGE(PG8_SB(0, 0), b2, voffB); PG8_STAGE(PG8_SB(0, 1), b2 + hstep, voffB); PG8_STAGE(PG8_SA(0, 0), a2, voffA);
            PG8_WAIT_V(8); PG8_WAIT_L(0); PG8_BAR; PG8_MMA(1, 0, At, B0); PG8_MMA(1, 1, At, B1); PG8_BAR; PG8_SCHED;
            PG8_LDB(B0, 1, 0); PG8_LDB(B1, 1, 1); PG8_SCHED; PG8_LDA(At, 1, 0); PG8_STAGE(PG8_SA(0, 1), a2 + hstep, voffA);
            PG8_WAIT_V(8); PG8_WAIT_L(0); PG8_BAR; PG8_MMA(0, 0, At, B0); PG8_MMA(0, 1, At, B1); PG8_BAR; PG8_SCHED;
            PG8_LDA(At, 1, 1); PG8_STAGE(PG8_SB(1, 0), b3, voffB); PG8_STAGE(PG8_SB(1, 1), b3 + hstep, voffB); PG8_STAGE(PG8_SA(1, 0), a3, voffA);
            PG8_WAIT_V(8); PG8_WAIT_L(0); PG8_BAR; PG8_MMA(1, 0, At, B0); PG8_MMA(1, 1, At, B1); PG8_BAR; PG8_SCHED;
            } else {
            PG8_LDB(B0, 0, 0); PG8_SCHED; PG8_LDA(At, 0, 0); PG8_STAGE(PG8_SA(1, 1), a1 + hstep, voffA);
            PG8_WAIT_L(8); PG8_BAR; PG8_WAIT_L(0); PG8_MMA(0, 0, At, B0); PG8_BAR; PG8_SCHED;
            PG8_LDB(B1, 0, 1); PG8_STAGE(PG8_SB(0, 0), b2, voffB);
            PG8_BAR; PG8_WAIT_L(0); PG8_MMA(0, 1, At, B1); PG8_BAR;
            PG8_LDA(At, 0, 1); PG8_STAGE(PG8_SA(0, 0), a2, voffA);
            PG8_BAR; PG8_WAIT_L(0); PG8_MMA(1, 0, At, B0); PG8_BAR; PG8_SCHED;
            PG8_STAGE(PG8_SB(0, 1), b2 + hstep, voffB);
            PG8_WAIT_V(6); PG8_BAR; PG8_MMA(1, 1, At, B1); PG8_BAR;
            PG8_LDB(B0, 1, 0); PG8_SCHED; PG8_LDA(At, 1, 0); PG8_STAGE(PG8_SA(0, 1), a2 + hstep, voffA);
            PG8_WAIT_L(8); PG8_BAR; PG8_WAIT_L(0); PG8_MMA(0, 0, At, B0); PG8_BAR; PG8_SCHED;
            PG8_LDB(B1, 1, 1); PG8_STAGE(PG8_SB(1, 0), b3, voffB);
            PG8_BAR; PG8_WAIT_L(0); PG8_MMA(0, 1, At, B1); PG8_BAR;
            PG8_LDA(At, 1, 1); PG8_STAGE(PG8_SA(1, 0), a3, voffA);
            PG8_BAR; PG8_WAIT_L(0); PG8_MMA(1, 0, At, B0); PG8_BAR; PG8_SCHED;
            PG8_STAGE(PG8_SB(1, 1), b3 + hstep, voffB);
            PG8_WAIT_V(6); PG8_BAR; PG8_MMA(1, 1, At, B1); PG8_BAR;
            }
        }
        if constexpr (ALIGN_EPI) { if (wr == 0) PG8_BAR; }
        if constexpr (!Epi::AFTER_DRAIN) { E(acc, cur, wr, wc, fr, fq); S.done(cur); }
        if (!has_next) break;
#pragma unroll
        for (int a = 0; a < 2; ++a)
#pragma unroll
            for (int b = 0; b < 2; ++b)
#pragma unroll
                for (int m = 0; m < 4; ++m)
#pragma unroll
                    for (int n = 0; n < 2; ++n) acc[a][b][m][n] = (f32x4){0.f, 0.f, 0.f, 0.f};
        cur = nxt; cA = nA; cB = nB; ++ui;
        if constexpr (ALIGN_EPI) { if (wr == 1) PG8_BAR; }
    }
    PG8_WAIT_V(0);
    if constexpr (!ALIGN_EPI) { if (wr == 0) PG8_BAR; }
    PG8_BAR;
    if constexpr (Epi::AFTER_DRAIN) { E.fused(acc, cur, wr, wc, fr, fq, lds, wid, lane); S.done(cur); }
#undef PG8_SA
#undef PG8_SB
#undef PG8_STAGE
#undef PG8_LDA
#undef PG8_LDB
#undef PG8_MMA
#undef PG8_WAIT_V
#undef PG8_WAIT_L
#undef PG8_BAR
#undef PG8_SCHED
}
}

#define GAS __attribute__((address_space(1)))
#define LAS __attribute__((address_space(3)))
typedef unsigned short bf16;
typedef unsigned v4u __attribute__((ext_vector_type(4)));
typedef unsigned v2u __attribute__((ext_vector_type(2)));
typedef float f32x4 __attribute__((ext_vector_type(4)));
typedef float f32x2 __attribute__((ext_vector_type(2)));
typedef short bf16x8 __attribute__((ext_vector_type(8)));
typedef short s16x4 __attribute__((ext_vector_type(4)));
using pg8::f2bf; using pg8::cvt_pk_bf16; using pg8::bflo; using pg8::bfhi;


__device__ __forceinline__ float wave_sum(float v) {
#pragma unroll
    for (int o = 1; o < 64; o <<= 1) v += __shfl_xor(v, o);
    return v;
}
__device__ __forceinline__ unsigned pk2(float lo, float hi) { return (unsigned)f2bf(lo) | ((unsigned)f2bf(hi) << 16); }

#define XB_TMO      128
#define XB_XCNT(j)  (256  + 64 * (j))
#define XB_XSUB(j)  (1280 + 64 * (j))
#define XB_XGEN(j)  (2304 + 64 * (j))
#define XB_TOP      3328
#define XB_TOPGEN   3392
#define XCD_BAR_WORDS 3456
#define XB_SPIN_CAP (1u << 18)

__device__ __forceinline__ unsigned xb_ld(unsigned* p)              { return __hip_atomic_load(p, __ATOMIC_RELAXED, __HIP_MEMORY_SCOPE_AGENT); }
__device__ __forceinline__ unsigned xb_add(unsigned* p, unsigned v) { return __hip_atomic_fetch_add(p, v, __ATOMIC_RELAXED, __HIP_MEMORY_SCOPE_AGENT); }
__device__ __forceinline__ unsigned xb_xcc_id() { return (unsigned)__builtin_amdgcn_s_getreg((3 << 11) | 20) & 0xFu; }
#define XB_SPIN(cond, bar) do { unsigned _sp = 0; while (cond) { __builtin_amdgcn_s_sleep(1); \
    if ((++_sp & 255u) == 0u) { if (xb_ld(&(bar)[XB_TMO])) break; if (_sp > XB_SPIN_CAP) { atomicAdd(&(bar)[XB_TMO], 1u); break; } } } } while (0)

struct XcdBarrier {
    unsigned* bar; unsigned x;
    volatile LAS unsigned* st;
};

__device__ __forceinline__ XcdBarrier xcd_barrier_post(unsigned* bar, volatile LAS unsigned* st) {
    XcdBarrier b; b.bar = bar; b.x = xb_xcc_id(); b.st = st;
    if (threadIdx.x == 0) (void)xb_add(&bar[XB_XCNT(b.x)], 1u);
    return b;
}
__device__ __forceinline__ void xcd_barrier_complete(unsigned* bar, unsigned x, unsigned& nloc, unsigned& nx) {
    const unsigned G = gridDim.x * gridDim.y * gridDim.z;
    unsigned sum, cnt, mine, sp = 0u;
    for (;;) {
        sum = 0u; cnt = 0u; mine = 0u;
#pragma unroll
        for (unsigned j = 0; j < 16; ++j) { const unsigned c = xb_ld(&bar[XB_XCNT(j)]); sum += c; cnt += (c > 0u) ? 1u : 0u; mine = (j == x) ? c : mine; }
        if (sum == G) break;
        __builtin_amdgcn_s_sleep(1);
        if ((++sp & 255u) == 0u) { if (xb_ld(&bar[XB_TMO])) break; if (sp > XB_SPIN_CAP) { atomicAdd(&bar[XB_TMO], 1u); break; } }
    }
    nloc = mine > 0u ? mine : 1u; nx = cnt > 0u ? cnt : 1u;
}

__device__ __forceinline__ void xcd_barrier(const XcdBarrier& b) {
    asm volatile("s_waitcnt vmcnt(0)" ::: "memory");
    __syncthreads();
    if (threadIdx.x == 0) {
        unsigned* bar = b.bar;
        __builtin_amdgcn_s_waitcnt(0);
        unsigned nloc = b.st[0], nx = b.st[1];
        if (nloc == 0u) { xcd_barrier_complete(bar, b.x, nloc, nx); b.st[0] = nloc; b.st[1] = nx; }
        const unsigned old = xb_add(&bar[XB_XSUB(b.x)], 1u);
        const unsigned gen = old / nloc;
        if (old + 1u == (gen + 1u) * nloc) {
            __builtin_amdgcn_fence(__ATOMIC_RELEASE, "agent");
            asm volatile("s_waitcnt vmcnt(0)" ::: "memory");
            const unsigned og = xb_add(&bar[XB_TOP], 1u);
            const unsigned tg = og / nx;
            if (og + 1u == (tg + 1u) * nx) xb_add(&bar[XB_TOPGEN], 1u);
            else XB_SPIN(xb_ld(&bar[XB_TOPGEN]) == tg, bar);
            __builtin_amdgcn_fence(__ATOMIC_ACQUIRE, "agent");
            xb_add(&bar[XB_XGEN(b.x)], 1u);
            asm volatile("s_waitcnt vmcnt(0)" ::: "memory");
        } else {
            XB_SPIN(xb_ld(&bar[XB_XGEN(b.x)]) == gen, bar);
            __builtin_amdgcn_fence(__ATOMIC_ACQUIRE, "agent");
            asm volatile("s_waitcnt vmcnt(0)" ::: "memory");
        }
    }
    __syncthreads();
}

#define XL_SUB(j) (5120 + 64 * (j))
#define XL_GEN(j) (5632 + 64 * (j))
__device__ __forceinline__ void xcd_local_barrier(const XcdBarrier& b) {
    asm volatile("s_waitcnt vmcnt(0)" ::: "memory");
    __syncthreads();
    if (threadIdx.x == 0) {
        unsigned* bar = b.bar; const unsigned nloc = b.st[0];
        const unsigned old = xb_add(&bar[XL_SUB(b.x)], 1u), gen = old / nloc;
        if (old + 1u == (gen + 1u) * nloc) xb_add(&bar[XL_GEN(b.x)], 1u);
        else XB_SPIN(xb_ld(&bar[XL_GEN(b.x)]) == gen, bar);
        __builtin_amdgcn_fence(__ATOMIC_ACQUIRE, "agent");
        asm volatile("s_waitcnt vmcnt(0)" ::: "memory");
    }
    __syncthreads();
}
constexpr size_t WS_BAR = 768 * KiB, BAR_BYTES = 24 * KiB;
struct Args { const float* in[14]; float* out; unsigned char* ws; };

template <class CM>
__device__ __forceinline__ void tr_item(const float* W, int K, int N, bf16* WT, const float* kscale, LAS float* scr, int item, int lane, CM cmap) {
    const int nblk = N / 32, kb = item / nblk, nb = item % nblk, k0 = 64 * kb, n0 = 32 * nb;
    const int src = cmap(n0 + (lane & 31));
    float tv[32];
#pragma unroll
    for (int i = 0; i < 32; ++i) tv[i] = W[(size_t)(k0 + 2 * i + (lane >> 5)) * N + src];
#pragma unroll
    for (int i = 0; i < 32; ++i) { const int kk = 2 * i + (lane >> 5); float v = tv[i]; if (kscale) v *= kscale[k0 + kk]; scr[kk * 33 + (lane & 31)] = v; }
    asm volatile("s_waitcnt lgkmcnt(0)" ::: "memory");
    const int c = lane & 7;
#pragma unroll
    for (int j = 0; j < 4; ++j) { const int n = (lane >> 3) + 8 * j; const LAS float* s = scr + (8 * c) * 33 + n;
        v4u o; o.x = pk2(s[0 * 33], s[1 * 33]); o.y = pk2(s[2 * 33], s[3 * 33]); o.z = pk2(s[4 * 33], s[5 * 33]); o.w = pk2(s[6 * 33], s[7 * 33]);
        *(v4u*)(WT + (size_t)(n0 + n) * K + k0 + 8 * c) = o; }
    asm volatile("s_waitcnt lgkmcnt(0)" ::: "memory");
}
struct CmId { __device__ __forceinline__ int operator()(int n) const { return n; } };
struct CmIn {
    __device__ __forceinline__ int operator()(int n) const {
        if (n < 1536 || n >= 3584) return n;
        const int q = n - 1536, j = q >> 8, cl = q & 255;
        const int sel = 2 * (cl >> 7) + ((cl >> 2) & 1), ch = 64 * j + 16 * ((cl >> 5) & 3) + 4 * ((cl >> 3) & 3) + (cl & 3);
        return 1536 + 512 * sel + ch;
    }
};

struct HgOps { s16x4 vb[2]; s16x4 ka[8]; f32x4 g[8]; };
__device__ __forceinline__ void hg_load(HgOps& o, const bf16* KT, const bf16* VTt, const float* G, unsigned cb, int vq, int lm, int kq) {
#pragma unroll
    for (int vt = 0; vt < 2; ++vt) o.vb[vt] = *(const s16x4*)(VTt + (unsigned)((cb + 32 * vq + 16 * vt + lm) * 16 + 4 * kq));
#pragma unroll
    for (int kt = 0; kt < 8; ++kt) { o.ka[kt] = *(const s16x4*)(KT + (unsigned)((cb + 16 * kt + lm) * 16 + 4 * kq)); o.g[kt] = *(const f32x4*)(G + (unsigned)(cb + 16 * kt + 4 * kq)); }
}
template <bool TRACKD>
__device__ __forceinline__ void hg_apply(f32x4 (&S)[8][2], f32x4 (&Dp)[8], const HgOps& o) {
#pragma unroll
    for (int kt = 0; kt < 8; ++kt) {
#pragma unroll
        for (int vt = 0; vt < 2; ++vt) { S[kt][vt] = __builtin_amdgcn_mfma_f32_16x16x16bf16_1k(o.ka[kt], o.vb[vt], S[kt][vt], 0, 0, 0); S[kt][vt] = S[kt][vt] * o.g[kt]; }
        if (TRACKD) Dp[kt] = Dp[kt] * o.g[kt];
    }
}
template <bool TRACKD>
__device__ __forceinline__ void hg_update(f32x4 (&S)[8][2], f32x4 (&Dp)[8], const bf16* KT, const bf16* VTt, const float* G, unsigned cb, int vq, int lm, int kq) {
    HgOps o; hg_load(o, KT, VTt, G, cb, vq, lm, kq); hg_apply<TRACKD>(S, Dp, o);
}

__global__ void __launch_bounds__(NWAVES * 64, 2) mk_fwd(Args args) {
    extern __shared__ __attribute__((aligned(16))) unsigned char lds_raw[];
    LAS unsigned char* lds = (LAS unsigned char*)lds_raw;
    const int tid = threadIdx.x, lane = tid & 63, wave = __builtin_amdgcn_readfirstlane(tid >> 6);
    const int G = gridDim.x, bx = blockIdx.x;
    const int gw = bx * NWAVES + wave, NGW = G * NWAVES;
    const int lm = lane & 15, kq = lane >> 4;
    unsigned char* ws = args.ws;
    if (tid < 16) ((LAS unsigned*)(lds + LDS_CTL))[tid] = 0u;
    __syncthreads();
    const XcdBarrier bar = xcd_barrier_post((unsigned*)(ws + WS_BAR), (volatile LAS unsigned*)(lds + LDS_CTL + 32));
    if (tid == 0) ((LAS unsigned*)(lds + LDS_CTL))[0] = xb_add((unsigned*)(ws + WS_BAR) + 3520 + 64 * bar.x, 1u);
    __syncthreads();
    const unsigned my_rank = ((volatile LAS unsigned*)(lds + LDS_CTL))[0];
    const float* x = args.in[0]; const float* meta = args.in[1]; const float* w_in = args.in[2]; const float* w_na = args.in[3]; const float* w_hg = args.in[4];
    const float* w_o = args.in[5]; const float* w_up = args.in[6]; const float* w_dn = args.in[7]; const float* g_mix = args.in[8]; const float* g_mlp = args.in[9];
    const float* g_fin = args.in[10]; const float* hg_gain = args.in[11]; const float* rpb = args.in[12]; const float* lb_logits = args.in[13];
    float* out = args.out;
    float* ssq1 = (float*)(ws + WS_SSQ1); float* ssq2 = (float*)(ws + WS_SSQ2);
    bf16* KNAm = (bf16*)(ws + WS_KNAM); bf16* VTm = (bf16*)(ws + WS_VTM); bf16* KFTm = (bf16*)(ws + WS_KFTM); bf16* VHTm = (bf16*)(ws + WS_VHTM);
    float* GFm = (float*)(ws + WS_GFM); float* LB = (float*)(ws + WS_LB); float* DSEG = (float*)(ws + WS_DSEG);
    bf16* WT_in = (bf16*)(ws + WS_WIN); bf16* WT_na = (bf16*)(ws + WS_WNA); bf16* WT_hg = (bf16*)(ws + WS_WHG); bf16* WT_o = (bf16*)(ws + WS_WO); bf16* WT_up = (bf16*)(ws + WS_WUP); bf16* WT_dn = (bf16*)(ws + WS_WDN);
    bf16* XN = (bf16*)(ws + WS_XN); float* SBUF = (float*)(ws + WS_XN); bf16* H1B = (bf16*)(ws + WS_XN);
    bf16* QNA = (bf16*)(ws + WS_QNA); bf16* KNA = (bf16*)(ws + WS_KNA); bf16* VT = (bf16*)(ws + WS_VT); bf16* QF = (bf16*)(ws + WS_QF); bf16* QB = (bf16*)(ws + WS_QB);
    bf16* KF = (bf16*)(ws + WS_KF); bf16* KFT = (bf16*)(ws + WS_KFT); bf16* KB = (bf16*)(ws + WS_KB); bf16* KBT = (bf16*)(ws + WS_KBT); bf16* VHT = (bf16*)(ws + WS_VHT);
    bf16* GHG = (bf16*)(ws + WS_GHG); float* GF = (float*)(ws + WS_GF); float* GB = (float*)(ws + WS_GB);
    bf16* SNA = (bf16*)out; bf16* SHG = (bf16*)out + (size_t)M * D;
    bf16* ONA = QNA; bf16* OHG = (bf16*)(ws + WS_OHG); bf16* Tb = (bf16*)(ws + WS_T); bf16* MIX = (bf16*)(ws + WS_MIX); bf16* U = (bf16*)(ws + WS_U);

    {
        {
            LAS float* mT = (LAS float*)lds;
            LAS float* red = (LAS float*)(lds + 65536);
            LAS float* fin = (LAS float*)(lds + 65536 + 32768);
#pragma unroll
            for (int rr = 0; rr < 2; ++rr) { const int r = 2 * wave + rr; const float* mr = meta + (size_t)r * D;
                f32x4 v[4]; float s = 0.f;
#pragma unroll
                for (int j = 0; j < 4; ++j) { v[j] = *(const f32x4*)(mr + 4 * lane + 256 * j); s += (v[j].x * v[j].x + v[j].y * v[j].y) + (v[j].z * v[j].z + v[j].w * v[j].w); }
                const float rs = rsqrtf(wave_sum(s) * (1.0f / D) + EPS);
#pragma unroll
                for (int j = 0; j < 4; ++j) { const f32x4 g = *(const f32x4*)(g_mix + 4 * lane + 256 * j); const int k = 4 * lane + 256 * j;
                    mT[(k + 0) * 16 + r] = v[j].x * rs * g.x; mT[(k + 1) * 16 + r] = v[j].y * rs * g.y; mT[(k + 2) * 16 + r] = v[j].z * rs * g.z; mT[(k + 3) * 16 + r] = v[j].w * rs * g.w; } }
            __syncthreads();
            for (int cbk = bx; cbk < 256; cbk += G) {
                const int c = tid & 7, ks = tid >> 3, grp = cbk >> 6, cl0 = (cbk & 63) * 8;
                const int src = (grp == 0 ? 512 : grp == 1 ? 1024 : grp == 2 ? 2048 : 3072) + cl0 + c;
                float a[16];
#pragma unroll
                for (int r = 0; r < 16; ++r) a[r] = 0.f;
                float wv[16];
#pragma unroll
                for (int kk = 0; kk < 16; ++kk) wv[kk] = w_in[(size_t)(ks * 16 + kk) * NIN + src];
#pragma unroll
                for (int kk = 0; kk < 16; ++kk) { const int k = ks * 16 + kk; const float w = wv[kk];
                    const f32x4 m0 = *(const LAS f32x4*)(mT + k * 16), m1 = *(const LAS f32x4*)(mT + k * 16 + 4), m2 = *(const LAS f32x4*)(mT + k * 16 + 8), m3 = *(const LAS f32x4*)(mT + k * 16 + 12);
                    a[0] += w * m0.x; a[1] += w * m0.y; a[2] += w * m0.z; a[3] += w * m0.w; a[4] += w * m1.x; a[5] += w * m1.y; a[6] += w * m1.z; a[7] += w * m1.w;
                    a[8] += w * m2.x; a[9] += w * m2.y; a[10] += w * m2.z; a[11] += w * m2.w; a[12] += w * m3.x; a[13] += w * m3.y; a[14] += w * m3.z; a[15] += w * m3.w; }
#pragma unroll
                for (int r = 0; r < 16; ++r) red[(ks * 16 + r) * 8 + c] = a[r];
                __syncthreads();
                if (tid < 128) { float s = 0.f;
                    for (int q = 0; q < 64; ++q) s += red[q * 128 + tid];
                    fin[tid] = s; }
                __syncthreads();
                if (tid < 8) { const int cl = cl0 + tid;
#pragma unroll
                    for (int r = 0; r < 16; ++r) a[r] = fin[r * 8 + tid];
                    if (grp == 0) {
#pragma unroll
                        for (int r = 0; r < 16; ++r) KNAm[r * 512 + cl] = f2bf(a[r]);
                    } else if (grp == 1) { const int h = cl >> 6, d = cl & 63;
#pragma unroll
                        for (int r = 0; r < 16; ++r) VTm[(h * 64 + d) * 16 + r] = f2bf(a[r]);
                    } else if (grp == 2) {
                        const float l0 = lb_logits[cl], l1 = lb_logits[512 + cl]; const float lb = 1.0f / (1.0f + expf(l1 - l0));
                        float bsum = 0.f;
#pragma unroll
                        for (int r = 0; r < 16; ++r) { const float f = lb + (1.0f - lb) / (1.0f + expf(-a[r])); bsum += logf(f); KFTm[cl * 16 + r] = f2bf((1.0f - f) * expf(-bsum)); }
                        GFm[cl] = expf(bsum);
                    } else {
#pragma unroll
                        for (int r = 0; r < 16; ++r) VHTm[cl * 16 + r] = f2bf(a[r]);
                    }
                }
                __syncthreads();
            }
        }
        if (bx == 32 % G) {
            for (int i = tid; i < 1024; i += NWAVES * 64) { const int dir = i >> 9, c = i & 511; const float l0 = lb_logits[dir * 1024 + c], l1 = lb_logits[dir * 1024 + 512 + c]; LB[i] = 1.0f / (1.0f + expf(l1 - l0)); }
        }
        LAS float* scr = (LAS float*)(lds + wave * 16384);
        constexpr int I_IN = (D / 64) * (NIN / 32), I_NA = (512 / 64) * (D / 32), I_O = (D / 64) * (D / 32), I_UP = (D / 64) * (FF / 32), I_DN = (FF / 64) * (D / 32);
        constexpr int NITEMS = I_IN + 2 * I_NA + I_O + I_UP + I_DN;
        for (int it = gw; it < NITEMS; it += NGW) {
            int r = it;
            if (r < I_IN) { tr_item(w_in, D, NIN, WT_in, (const float*)nullptr, scr, r, lane, CmIn()); continue; } r -= I_IN;
            if (r < I_NA) { tr_item(w_na, 512, D, WT_na, (const float*)nullptr, scr, r, lane, CmId()); continue; } r -= I_NA;
            if (r < I_NA) { tr_item(w_hg, 512, D, WT_hg, (const float*)nullptr, scr, r, lane, CmId()); continue; } r -= I_NA;
            if (r < I_O) { tr_item(w_o, D, D, WT_o, (const float*)nullptr, scr, r, lane, CmId()); continue; } r -= I_O;
            if (r < I_UP) { tr_item(w_up, D, FF, WT_up, g_mlp, scr, r, lane, CmId()); continue; } r -= I_UP;
            tr_item(w_dn, FF, D, WT_dn, (const float*)nullptr, scr, r, lane, CmId());
        }
        for (int m0 = gw; m0 < M; m0 += 4 * NGW) {
            f32x4 v[4][4];
#pragma unroll
            for (int q = 0; q < 4; ++q)
#pragma unroll
                for (int j = 0; j < 4; ++j) v[q][j] = *(const f32x4*)(x + (size_t)(m0 + q * NGW) * D + 4 * lane + 256 * j);
#pragma unroll
            for (int q = 0; q < 4; ++q) { const int m = m0 + q * NGW; float s = 0.f;
#pragma unroll
                for (int j = 0; j < 4; ++j) s += (v[q][j].x * v[q][j].x + v[q][j].y * v[q][j].y) + (v[q][j].z * v[q][j].z + v[q][j].w * v[q][j].w);
                const float rs = rsqrtf(wave_sum(s) * (1.0f / D) + EPS);
#pragma unroll
                for (int j = 0; j < 4; ++j) { const f32x4 g = *(const f32x4*)(g_mix + 4 * lane + 256 * j);
                    v2u o; o.x = pk2(v[q][j].x * rs * g.x, v[q][j].y * rs * g.y); o.y = pk2(v[q][j].z * rs * g.z, v[q][j].w * rs * g.w);
                    *(v2u*)(XN + (size_t)m * D + 4 * lane + 256 * j) = o; } } }
    }
    xcd_barrier(bar);

    int vb = bx; bool xl = false;
    { const unsigned nloc = ((volatile LAS unsigned*)(lds + LDS_CTL + 32))[0], nx = ((volatile LAS unsigned*)(lds + LDS_CTL + 32))[1];
      bool even = (G == 256 && nloc == 32u && nx == 8u && bar.x < 8u && my_rank < 32u);
#pragma unroll
      for (int j = 0; j < 8; ++j) even = even && (xb_ld((unsigned*)(ws + WS_BAR) + XB_XCNT(j)) == 32u);
      if (even) { vb = (int)(my_rank * 8u + bar.x); xl = true; } }
    vb = __builtin_amdgcn_readfirstlane(vb);
#define PHASE_BAR() do { if (xl) xcd_local_barrier(bar); else xcd_barrier(bar); } while (0)
    const int xq = vb & 7, rk = vb >> 3, lw = rk * 8 + wave;
#define MK_EPI(NAME, MODE) pg8::EpiAll<MODE> NAME; NAME.ws = ws; NAME.out = out; NAME.x = x; NAME.gain = hg_gain; NAME.gfin = g_fin;
    {
        MK_EPI(E, pg8::EM_IN)
        pg8::Gemm g{XN, WT_in, M, NIN, D}; pg8::StaticOrder S; S.init(M, NIN, G, vb);
        pg8::gemm_phase<pg8::EpiAll<pg8::EM_IN>, pg8::StaticOrder, true, true>(lds, g, S, E);
    }
    PHASE_BAR();

    { const int wi = xq * 256 + lw;
        const int item = wi >> 2, vq = wi & 3, seg = item & 7, dir = (item >> 3) & 1, h = (item >> 4) & 3, b = item >> 6;
        f32x4 S[8][2], Dp[8];
#pragma unroll
        for (int kt = 0; kt < 8; ++kt) { S[kt][0] = (f32x4){0.f, 0.f, 0.f, 0.f}; S[kt][1] = (f32x4){0.f, 0.f, 0.f, 0.f}; Dp[kt] = (f32x4){1.f, 1.f, 1.f, 1.f}; }
        if (dir == 0 && seg == 0) hg_update<false>(S, Dp, KFTm, VHTm, GFm, (unsigned)(h * 128), vq, lm, kq);
        const bf16* KTp = dir ? KBT : KFT; const float* Gp = dir ? GB : GF;
        const int cstep = dir ? -512 : 512; const int cb0 = (b * 128 + seg * 16 + (dir ? 15 : 0)) * 512 + h * 128;
        {
            LAS unsigned char* stg0 = lds + (wave >> 2) * 9216;
            s16x4 kv[2][2], vbn[2][2], vbr[2][2]; v2u g8 = (v2u){0u, 0u};
#define B1_LOADS(IT) do { _Pragma("unroll") for (int u = 0; u < 2; ++u) { const unsigned cb_ = (unsigned)(cb0 + (2 * (IT) + u) * cstep); \
                _Pragma("unroll") for (int kk = 0; kk < 2; ++kk) kv[u][kk] = *(const s16x4*)(KTp + (unsigned)((cb_ + 16 * (2 * vq + kk) + lm) * 16 + 4 * kq)); \
                _Pragma("unroll") for (int vt = 0; vt < 2; ++vt) vbn[u][vt] = *(const s16x4*)(VHT + (unsigned)((cb_ + 32 * vq + 16 * vt + lm) * 16 + 4 * kq)); \
                if (vq == u) g8 = *(const v2u*)(Gp + cb_ + 2 * lane); } } while (0)
#define B1_STORE(STG) do { _Pragma("unroll") for (int u = 0; u < 2; ++u) { \
                _Pragma("unroll") for (int kk = 0; kk < 2; ++kk) *(LAS s16x4*)((STG) + (u * 8 + 2 * vq + kk) * 512 + lane * 8) = kv[u][kk]; \
                if (vq == u) *(LAS v2u*)((STG) + 8192 + u * 512 + lane * 8) = g8; } } while (0)
            __syncthreads();
            B1_LOADS(0);
            B1_STORE(stg0);
#pragma unroll
            for (int u = 0; u < 2; ++u) { vbr[u][0] = vbn[u][0]; vbr[u][1] = vbn[u][1]; }
            for (int it = 0; it < 8; ++it) {
                __syncthreads();
                LAS unsigned char* stg = stg0 + (it & 1) * 18432;
                if (it < 7) B1_LOADS(it + 1);
                __builtin_amdgcn_sched_barrier(0);
#pragma unroll
                for (int u = 0; u < 2; ++u)
#pragma unroll
                    for (int kt = 0; kt < 8; ++kt) { const s16x4 ka = *(const LAS s16x4*)(stg + (u * 8 + kt) * 512 + lane * 8); const f32x4 g = *(const LAS f32x4*)(stg + 8192 + u * 512 + (16 * kt + 4 * kq) * 4);
#pragma unroll
                        for (int vt = 0; vt < 2; ++vt) { S[kt][vt] = __builtin_amdgcn_mfma_f32_16x16x16bf16_1k(ka, vbr[u][vt], S[kt][vt], 0, 0, 0); S[kt][vt] = S[kt][vt] * g; } }
                __builtin_amdgcn_sched_barrier(0);
                if (it < 7) { B1_STORE(stg0 + ((it + 1) & 1) * 18432);
#pragma unroll
                    for (int u = 0; u < 2; ++u) { vbr[u][0] = vbn[u][0]; vbr[u][1] = vbn[u][1]; } }
            }
#undef B1_LOADS
#undef B1_STORE
        }
        float* sp = SBUF + ((size_t)(item * 4 + vq) * 16) * 256 + lane * 4;
#pragma unroll
        for (int kt = 0; kt < 8; ++kt) { *(f32x4*)(sp + (kt * 2 + 0) * 256) = S[kt][0]; *(f32x4*)(sp + (kt * 2 + 1) * 256) = S[kt][1]; }
        if (vq == 0) {
#pragma unroll
            for (int kt = 0; kt < 8; ++kt) Dp[kt] = (f32x4){1.f, 1.f, 1.f, 1.f};
            for (int i = 0; i < 16; ++i) { const float* gp = Gp + (unsigned)(cb0 + i * cstep + 4 * kq);
#pragma unroll
                for (int kt = 0; kt < 8; ++kt) Dp[kt] = Dp[kt] * *(const f32x4*)(gp + 16 * kt); }
            if (lm == 0) {
#pragma unroll
                for (int kt = 0; kt < 8; ++kt) *(f32x4*)(DSEG + item * 128 + 16 * kt + 4 * kq) = Dp[kt];
            }
        }
    }
    PHASE_BAR();

    for (int i2 = 0; i2 < 2; ++i2) { const int tl = rk * 512 + tid + 16384 * i2;
        const int bhd = xq * 8 + (tl >> 12), e4 = tl & 4095, dir = bhd & 1; const int kt = (e4 >> 7) & 7, ln = e4 & 63; const int k0 = 16 * kt + 4 * (ln >> 4);
        f32x4 carry = (f32x4){0.f, 0.f, 0.f, 0.f};
        for (int s = 0; s < 8; ++s) { const int seg = dir ? 7 - s : s, item = bhd * 8 + seg;
            float* p = SBUF + (size_t)item * 16384 + e4 * 4; const f32x4 loc = *(const f32x4*)p; *(f32x4*)p = carry;
            const f32x4 d = *(const f32x4*)(DSEG + item * 128 + k0); carry = d * carry + loc; }
    }
    {
        LAS float* rp = (LAS float*)lds;
        __syncthreads();
        for (int i = tid; i < 8 * 465; i += NWAVES * 64) rp[i] = rpb[i];
        __syncthreads();
        LAS unsigned char* KS = lds + 15360; LAS unsigned char* VS = lds + 15360 + 73728;
        int prev_hi = -1;
        for (int i4 = 0; i4 < 4; ++i4) {
            const int hh = rk >> 2, rg = rk & 3, rpair = 8 * rg + 2 * i4;
            const int cq = wave & 3, r = rpair + (wave >> 2), h = hh, b = xq;
            const int lo = min(max(rpair - 4, 0), 24);
            __syncthreads();
            { const int c = tid >> 3, q = tid & 7;
              if (i4 == 0) {
                v4u kreg[9], vreg[9];
#pragma unroll
                for (int e9 = 0; e9 < 9; ++e9) { const int row = min(lo + e9, 31);
                    kreg[e9] = *(const v4u*)(KNA + ((size_t)b * SEQ + row * 64 + c) * 512 + h * 64 + q * 8);
                    vreg[e9] = *(const v4u*)(VT + ((((size_t)(b * 8 + h) * 32 + row) * 64 + c) * 64 + q * 8)); }
#pragma unroll
                for (int e9 = 0; e9 < 9; ++e9) { const int kk = ((lo + e9) % 9) * 64 + c;
                    *(LAS v4u*)(KS + kk * 128 + ((q ^ (kk & 7)) * 16)) = kreg[e9]; *(LAS v4u*)(VS + kk * 128 + ((q ^ (kk & 7)) * 16)) = vreg[e9]; }
              } else {
                v4u kreg[2], vreg[2];
#pragma unroll
                for (int e2 = 0; e2 < 2; ++e2) { const int row = min(prev_hi + 1 + e2, 31);
                    kreg[e2] = *(const v4u*)(KNA + ((size_t)b * SEQ + row * 64 + c) * 512 + h * 64 + q * 8);
                    vreg[e2] = *(const v4u*)(VT + ((((size_t)(b * 8 + h) * 32 + row) * 64 + c) * 64 + q * 8)); }
#pragma unroll
                for (int e2 = 0; e2 < 2; ++e2) { const int row = prev_hi + 1 + e2;
                    if (row <= lo + 8 && row < 32) { const int kk = (row % 9) * 64 + c;
                        *(LAS v4u*)(KS + kk * 128 + ((q ^ (kk & 7)) * 16)) = kreg[e2]; *(LAS v4u*)(VS + kk * 128 + ((q ^ (kk & 7)) * 16)) = vreg[e2]; } }
              }
            }
            prev_hi = lo + 8;
            __syncthreads();
            const int c0 = 16 * cq, kc0 = (cq == 0) ? 0 : (cq == 1) ? 8 : (cq == 2) ? 24 : 32;
            const int rs0 = min(max(r - 4, 0), 24);
            const size_t rowq = (size_t)b * SEQ + r * 64 + c0 + lm;
            bf16x8 qf[2], kmf[2]; s16x4 vmf[4];
#pragma unroll
            for (int ks = 0; ks < 2; ++ks) { qf[ks] = *(const bf16x8*)(QNA + rowq * 512 + h * 64 + 32 * ks + 8 * kq); kmf[ks] = *(const bf16x8*)(KNAm + lm * 512 + h * 64 + 32 * ks + 8 * kq); }
#pragma unroll
            for (int dt = 0; dt < 4; ++dt) vmf[dt] = *(const s16x4*)(VTm + (h * 64 + 16 * dt + lm) * 16 + 4 * kq);
            const int cqq = c0 + lm, cs = min(max(cqq - 8, 0), 48);
            f32x4 oa[4];
#pragma unroll
            for (int dt = 0; dt < 4; ++dt) oa[dt] = (f32x4){0.f, 0.f, 0.f, 0.f};
            float mrun = -3.0e38f, lsum = 0.f;
#pragma unroll
            for (int hf = 0; hf < 2; ++hf) {
                f32x4 sc[9]; bf16x8 vf[4][4];
                {   bf16x8 kf[4][2][2];
#pragma unroll
                    for (int j4 = 0; j4 < 4; ++j4)
#pragma unroll
                        for (int t = 0; t < 2; ++t) { const int kcol = kc0 + 8 * (lm >> 2) + 4 * t + (lm & 3); const size_t rowk = (size_t)b * SEQ + (rs0 + 4 * hf + j4) * 64 + kcol;
#pragma unroll
                            for (int ks = 0; ks < 2; ++ks) { const int kk = ((rs0 + 4 * hf + j4) % 9) * 64 + kcol; kf[j4][t][ks] = *(const LAS bf16x8*)(KS + kk * 128 + (((ks * 4 + kq) ^ (kk & 7)) * 16)); } (void)rowk; }
                    __builtin_amdgcn_sched_barrier(0);
#pragma unroll
                    for (int j4 = 0; j4 < 4; ++j4)
#pragma unroll
                        for (int t = 0; t < 2; ++t) { f32x4 a = (f32x4){0.f, 0.f, 0.f, 0.f};
#pragma unroll
                            for (int ks = 0; ks < 2; ++ks) a = __builtin_amdgcn_mfma_f32_16x16x32_bf16(kf[j4][t][ks], qf[ks], a, 0, 0, 0);
                            sc[2 * j4 + t] = a; }
                }
                __builtin_amdgcn_sched_barrier(0);
#pragma unroll
                for (int j4 = 0; j4 < 4; ++j4)
#pragma unroll
                    for (int dt = 0; dt < 4; ++dt) { const int vv = ((rs0 + 4 * hf + j4) % 9) * 64 + 16 * dt + lm; vf[j4][dt] = *(const LAS bf16x8*)(VS + vv * 128 + ((((kc0 >> 3) + kq) ^ (vv & 7)) * 16)); }
                __builtin_amdgcn_sched_barrier(0);
                if (hf == 1) { f32x4 a = (f32x4){0.f, 0.f, 0.f, 0.f};
#pragma unroll
                    for (int ks = 0; ks < 2; ++ks) a = __builtin_amdgcn_mfma_f32_16x16x32_bf16(kmf[ks], qf[ks], a, 0, 0, 0);
                    sc[8] = a; } else sc[8] = (f32x4){-1e30f, -1e30f, -1e30f, -1e30f};
                float mx = -3.0e38f;
#pragma unroll
                for (int j4 = 0; j4 < 4; ++j4)
#pragma unroll
                    for (int t = 0; t < 2; ++t)
#pragma unroll
                        for (int j = 0; j < 4; ++j) { const int kcol = kc0 + 8 * kq + 4 * t + j; const bool inw = (kcol >= cs) && (kcol < cs + 16);
                            const int dr = rs0 + 4 * hf + j4 - r, dc = min(max(kcol - cqq, -15), 15);
                            const float bias = rp[h * 465 + (dr + 7) * 31 + dc + 15];
                            const float s = inw ? sc[2 * j4 + t][j] + bias : -1e30f; sc[2 * j4 + t][j] = s; mx = fmaxf(mx, s); }
#pragma unroll
                for (int j = 0; j < 4; ++j) mx = fmaxf(mx, sc[8][j]);
                mx = fmaxf(mx, __shfl_xor(mx, 16)); mx = fmaxf(mx, __shfl_xor(mx, 32));
                const float mnew = fmaxf(mrun, mx), alpha = __expf(mrun - mnew);
                mrun = mnew; lsum *= alpha;
#pragma unroll
                for (int dt = 0; dt < 4; ++dt) oa[dt] = oa[dt] * alpha;
#pragma unroll
                for (int i = 0; i < 9; ++i)
#pragma unroll
                    for (int j = 0; j < 4; ++j) { const float p = __expf(sc[i][j] - mnew); sc[i][j] = p; lsum += p; }
#pragma unroll
                for (int j4 = 0; j4 < 4; ++j4) {
                    union { bf16x8 v; unsigned u[4]; } pf;
                    pf.u[0] = cvt_pk_bf16(sc[2 * j4][0], sc[2 * j4][1]); pf.u[1] = cvt_pk_bf16(sc[2 * j4][2], sc[2 * j4][3]);
                    pf.u[2] = cvt_pk_bf16(sc[2 * j4 + 1][0], sc[2 * j4 + 1][1]); pf.u[3] = cvt_pk_bf16(sc[2 * j4 + 1][2], sc[2 * j4 + 1][3]);
#pragma unroll
                    for (int dt = 0; dt < 4; ++dt) oa[dt] = __builtin_amdgcn_mfma_f32_16x16x32_bf16(vf[j4][dt], pf.v, oa[dt], 0, 0, 0); }
                if (hf == 1) { union { s16x4 v; unsigned u[2]; } pm; pm.u[0] = cvt_pk_bf16(sc[8][0], sc[8][1]); pm.u[1] = cvt_pk_bf16(sc[8][2], sc[8][3]);
#pragma unroll
                    for (int dt = 0; dt < 4; ++dt) oa[dt] = __builtin_amdgcn_mfma_f32_16x16x16bf16_1k(vmf[dt], pm.v, oa[dt], 0, 0, 0); }
            }
            lsum += __shfl_xor(lsum, 16); lsum += __shfl_xor(lsum, 32);
            const float inv = 1.0f / lsum;
#pragma unroll
            for (int dt = 0; dt < 4; ++dt) { v2u o; o.x = cvt_pk_bf16(oa[dt][0] * inv, oa[dt][1] * inv); o.y = cvt_pk_bf16(oa[dt][2] * inv, oa[dt][3] * inv);
                *(v2u*)(ONA + rowq * 512 + h * 64 + 16 * dt + 4 * kq) = o; }
        }
        __syncthreads();
    }
    PHASE_BAR();

    { const int it = xq * 32 + rk;
        const int seg = it & 7, h = (it >> 3) & 3, b = it >> 5;
        const int dir = wave >> 2, vq = wave & 3, sitem = ((b * 4 + h) * 2 + dir) * 8 + seg;
        LAS unsigned short* ob = (LAS unsigned short*)lds;
        LAS unsigned char* stg0 = lds + 65536 + dir * 17408;
        __syncthreads();
        f32x4 S[8][2], Dp[8];
        { const float* sp = SBUF + ((size_t)(sitem * 4 + vq) * 16) * 256 + lane * 4;
#pragma unroll
          for (int kt = 0; kt < 8; ++kt) { S[kt][0] = *(const f32x4*)(sp + (kt * 2 + 0) * 256); S[kt][1] = *(const f32x4*)(sp + (kt * 2 + 1) * 256); Dp[kt] = (f32x4){1.f, 1.f, 1.f, 1.f}; } }
        if (dir == 0 && seg == 0) hg_update<false>(S, Dp, KFTm, VHTm, GFm, (unsigned)(h * 128), vq, lm, kq);
        const bf16* Qn = dir ? QB : QF; const bf16* Kn = dir ? KB : KF; const bf16* KTp = dir ? KBT : KFT; const float* Gp = dir ? GB : GF;
        {
            LAS v2u* PA = (LAS v2u*)(lds + 135168);
            bf16x8 kn4[4][4], qn4[4][4];
#pragma unroll
            for (int q = 0; q < 4; ++q) { const size_t r0 = ((size_t)b * 128 + seg * 16 + vq + 4 * q) * 16;
#pragma unroll
                for (int ii = 0; ii < 4; ++ii) { const size_t o = (r0 + lm) * 512 + h * 128 + 32 * ii + 8 * kq; kn4[q][ii] = *(const bf16x8*)(Kn + o); qn4[q][ii] = *(const bf16x8*)(Qn + o); } }
#pragma unroll
            for (int q = 0; q < 4; ++q) { f32x4 at = (f32x4){0.f, 0.f, 0.f, 0.f};
#pragma unroll
                for (int ii = 0; ii < 4; ++ii) at = __builtin_amdgcn_mfma_f32_16x16x32_bf16(kn4[q][ii], qn4[q][ii], at, 0, 0, 0);
#pragma unroll
                for (int j = 0; j < 4; ++j) { const int s = 4 * kq + j; const bool keep = dir ? (s >= lm) : (s <= lm); at[j] = keep ? at[j] : 0.f; }
                v2u w; w.x = cvt_pk_bf16(at[0], at[1]); w.y = cvt_pk_bf16(at[2], at[3]);
                PA[(dir * 16 + vq + 4 * q) * 64 + lane] = w; }
        }
        __syncthreads();
        s16x4 qv[2][2], kv[2][2], vbn[2][2]; v2u g8 = (v2u){0u, 0u};
#define B3_LOADS(IT) do { _Pragma("unroll") for (int u = 0; u < 2; ++u) { const int cl_ = dir ? 15 - (2 * (IT) + u) : 2 * (IT) + u; const size_t cgi_ = (size_t)b * 128 + seg * 16 + cl_, row0_ = cgi_ * 16; const unsigned cb_ = (unsigned)(cgi_ * 512 + h * 128); \
            _Pragma("unroll") for (int kk = 0; kk < 2; ++kk) { const int kt_ = 2 * vq + kk; \
                qv[u][kk] = *(const s16x4*)(Qn + (row0_ + lm) * 512 + h * 128 + 16 * kt_ + 4 * kq); \
                kv[u][kk] = *(const s16x4*)(KTp + (unsigned)((cb_ + 16 * kt_ + lm) * 16 + 4 * kq)); } \
            _Pragma("unroll") for (int vt = 0; vt < 2; ++vt) vbn[u][vt] = *(const s16x4*)(VHT + (unsigned)((cb_ + 32 * vq + 16 * vt + lm) * 16 + 4 * kq)); \
            if (vq == u) g8 = *(const v2u*)(Gp + cb_ + 2 * lane); } } while (0)
#define B3_STORE(STG) do { _Pragma("unroll") for (int u = 0; u < 2; ++u) { \
            _Pragma("unroll") for (int kk = 0; kk < 2; ++kk) { const int f_ = u * 8 + 2 * vq + kk; \
                *(LAS s16x4*)((STG) + f_ * 512 + lane * 8) = qv[u][kk]; *(LAS s16x4*)((STG) + 8192 + f_ * 512 + lane * 8) = kv[u][kk]; } \
            if (vq == u) *(LAS v2u*)((STG) + 16384 + u * 512 + lane * 8) = g8; } } while (0)
        B3_LOADS(0);
        B3_STORE(stg0);
        s16x4 vbr[2][2];
#pragma unroll
        for (int u = 0; u < 2; ++u) { vbr[u][0] = vbn[u][0]; vbr[u][1] = vbn[u][1]; }
        for (int it = 0; it < 8; ++it) {
            __syncthreads();
            LAS unsigned char* stg = stg0 + (it & 1) * 34816;
            if (it < 7) B3_LOADS(it + 1);
            __builtin_amdgcn_sched_barrier(0);
#pragma unroll
            for (int u = 0; u < 2; ++u) { const int cl = dir ? 15 - (2 * it + u) : 2 * it + u;
                union { s16x4 v; v2u u2; } pa; pa.u2 = ((const LAS v2u*)(lds + 135168))[(dir * 16 + cl) * 64 + lane];
                f32x4 o2[2]; o2[0] = (f32x4){0.f, 0.f, 0.f, 0.f}; o2[1] = (f32x4){0.f, 0.f, 0.f, 0.f};
#pragma unroll
                for (int kt = 0; kt < 8; ++kt) { const s16x4 q4 = *(const LAS s16x4*)(stg + (u * 8 + kt) * 512 + lane * 8);
#pragma unroll
                    for (int vt = 0; vt < 2; ++vt) { union { s16x4 v; unsigned u[2]; } sb; sb.u[0] = cvt_pk_bf16(S[kt][vt][0], S[kt][vt][1]); sb.u[1] = cvt_pk_bf16(S[kt][vt][2], S[kt][vt][3]);
                        o2[vt] = __builtin_amdgcn_mfma_f32_16x16x16bf16_1k(q4, sb.v, o2[vt], 0, 0, 0); } }
#pragma unroll
                for (int vt = 0; vt < 2; ++vt) { o2[vt] = __builtin_amdgcn_mfma_f32_16x16x16bf16_1k(pa.v, vbr[u][vt], o2[vt], 0, 0, 0);
#pragma unroll
                    for (int j = 0; j < 4; ++j) { LAS unsigned short* op = ob + (16 * cl + 4 * kq + j) * 128 + 32 * vq + 16 * vt + lm;
                        const float val = (it < 4) ? o2[vt][j] : (bflo((unsigned)*op) + o2[vt][j]); *op = f2bf(val); } }
#pragma unroll
                for (int kt = 0; kt < 8; ++kt) { const s16x4 ka = *(const LAS s16x4*)(stg + 8192 + (u * 8 + kt) * 512 + lane * 8); const f32x4 g = *(const LAS f32x4*)(stg + 16384 + u * 512 + (16 * kt + 4 * kq) * 4);
#pragma unroll
                    for (int vt = 0; vt < 2; ++vt) { S[kt][vt] = __builtin_amdgcn_mfma_f32_16x16x16bf16_1k(ka, vbr[u][vt], S[kt][vt], 0, 0, 0); S[kt][vt] = S[kt][vt] * g; } }
            }
            __builtin_amdgcn_sched_barrier(0);
            if (it < 7) { B3_STORE(stg0 + ((it + 1) & 1) * 34816);
#pragma unroll
                for (int u = 0; u < 2; ++u) { vbr[u][0] = vbn[u][0]; vbr[u][1] = vbn[u][1]; } }
        }
#undef B3_LOADS
#undef B3_STORE
        v4u ggp[8];
#pragma unroll
        for (int i = 0; i < 8; ++i) ggp[i] = *(const v4u*)(GHG + ((size_t)b * SEQ + seg * 256 + wave * 32 + 4 * i + kq) * 512 + h * 128 + 8 * lm);
        __syncthreads();
#pragma unroll
        for (int i = 0; i < 8; ++i) { const int tl = wave * 32 + 4 * i + kq; const size_t row = (size_t)b * SEQ + seg * 256 + tl;
            const v4u ov = *(const LAS v4u*)(ob + tl * 128 + 8 * lm);
            const f32x4 v0 = (f32x4){bflo(ov.x), bfhi(ov.x), bflo(ov.y), bfhi(ov.y)}, v1 = (f32x4){bflo(ov.z), bfhi(ov.z), bflo(ov.w), bfhi(ov.w)};
            const v4u gg = ggp[i];
            float s = (v0.x * v0.x + v0.y * v0.y) + (v0.z * v0.z + v0.w * v0.w) + (v1.x * v1.x + v1.y * v1.y) + (v1.z * v1.z + v1.w * v1.w);
            s += __shfl_xor(s, 1); s += __shfl_xor(s, 2); s += __shfl_xor(s, 4); s += __shfl_xor(s, 8);
            const float rs = rsqrtf(s * (1.0f / 128.0f) + EPS);
            v4u o; o.x = cvt_pk_bf16(v0.x * rs * bflo(gg.x), v0.y * rs * bfhi(gg.x)); o.y = cvt_pk_bf16(v0.z * rs * bflo(gg.y), v0.w * rs * bfhi(gg.y));
            o.z = cvt_pk_bf16(v1.x * rs * bflo(gg.z), v1.y * rs * bfhi(gg.z)); o.w = cvt_pk_bf16(v1.z * rs * bflo(gg.w), v1.w * rs * bfhi(gg.w));
            *(v4u*)(OHG + row * 512 + h * 128 + 8 * lm) = o; }
        __syncthreads();
    }
    PHASE_BAR();

    {
        MK_EPI(E, pg8::EM_C1A)
        pg8::Gemm g{ONA, WT_na, 2 * M, 2 * D, 512}; pg8::PairOrder S; S.init(M, D, G, vb);
        pg8::gemm_phase<pg8::EpiAll<pg8::EM_C1A>, pg8::PairOrder, true, true>(lds, g, S, E);
    }
    PHASE_BAR();
    {
        MK_EPI(E, pg8::EM_C2)
        pg8::Gemm g{MIX, WT_o, M, D, D}; pg8::StaticOrder S; S.init(M, D, G, vb);
        pg8::gemm_phase<pg8::EpiAll<pg8::EM_C2>, pg8::StaticOrder, true, true>(lds, g, S, E);
    }
    PHASE_BAR();
    {
        MK_EPI(E, pg8::EM_C3)
        pg8::Gemm g{H1B, WT_up, M, FF, D}; pg8::StaticOrder S; S.init(M, FF, G, vb);
        pg8::gemm_phase<pg8::EpiAll<pg8::EM_C3>, pg8::StaticOrder, true, true>(lds, g, S, E);
    }
    PHASE_BAR();
    {
        MK_EPI(E, pg8::EM_C4)
        pg8::Gemm g{U, WT_dn, M, D, FF}; pg8::StaticOrder S; S.init(M, D, G, vb);
        pg8::gemm_phase<pg8::EpiAll<pg8::EM_C4>, pg8::StaticOrder, true, true>(lds, g, S, E);
    }

}

extern "C" void kernel_launch(void* const* d_in, const int* in_sizes, int n_in, void* d_out, int out_size, void* d_ws, size_t ws_size, hipStream_t stream) {
    static int grid = 0;
    if (grid == 0) {
        if (n_in != 14 || in_sizes[0] != M * D || out_size != M * D || ws_size < WS_END) { fprintf(stderr, "kernel_launch: unexpected shapes / workspace (n_in %d, in0 %d, out %d, ws %zu)\n", n_in, n_in > 0 ? in_sizes[0] : -1, out_size, ws_size); grid = -1; return; }
        int dev = 0, cus = 0, per_cu = 0;
        if (hipGetDevice(&dev) != hipSuccess || hipDeviceGetAttribute(&cus, hipDeviceAttributeMultiprocessorCount, dev) != hipSuccess) { grid = -1; return; }
        if (hipFuncSetAttribute((const void*)mk_fwd, hipFuncAttributeMaxDynamicSharedMemorySize, LDS_BYTES) != hipSuccess) { fprintf(stderr, "kernel_launch: hipFuncSetAttribute failed\n"); grid = -1; return; }
        if (hipOccupancyMaxActiveBlocksPerMultiprocessor(&per_cu, (const void*)mk_fwd, NWAVES * 64, LDS_BYTES) != hipSuccess || per_cu < 1) { fprintf(stderr, "kernel_launch: occupancy query failed (%d)\n", per_cu); (void)hipGetLastError(); per_cu = 1; }
        if (cus != 256) fprintf(stderr, "kernel_launch: built for a 256-CU device (found %d)\n", cus);
        grid = 256;
    }
    if (grid < 0) return;
    Args a{};
    for (int i = 0; i < 14; ++i) a.in[i] = (const float*)d_in[i];
    a.out = (float*)d_out; a.ws = (unsigned char*)d_ws;
    if (hipMemsetAsync((char*)d_ws + WS_BAR, 0, BAR_BYTES, stream) != hipSuccess) { fprintf(stderr, "kernel_launch: memset failed\n"); return; }
    hipLaunchKernelGGL(mk_fwd, dim3(grid), dim3(NWAVES * 64), LDS_BYTES, stream, a);
    const hipError_t e = hipPeekAtLastError();
    if (e != hipSuccess) fprintf(stderr, "kernel_launch: launch failed: %s (grid %d)\n", hipGetErrorName(e), grid);
}
```

```cpp
#include <hip/hip_runtime.h>
#include <cstdio>
#include <cstdint>
constexpr int NWAVES = 8;
constexpr int NB = 8, SEQ = 2048, D = 1024, M = NB * SEQ, NIN = 6144, FF = 4096;
constexpr float EPS = 1e-6f;
constexpr size_t MiB = 1u << 20, KiB = 1024;
constexpr size_t WS_SSQ1 = 245 * MiB, WS_SSQ2 = 246 * MiB,
                WS_KNAM = 128 * KiB, WS_VTM = 144 * KiB, WS_KFTM = 160 * KiB, WS_VHTM = 176 * KiB, WS_GFM = 192 * KiB, WS_LB = 196 * KiB, WS_DSEG = 256 * KiB;
constexpr size_t WS_WIN = 1 * MiB, WS_WNA = 13 * MiB, WS_WHG = 14 * MiB, WS_WO = 15 * MiB, WS_WUP = 17 * MiB, WS_WDN = 237 * MiB;
constexpr size_t WS_XN = 25 * MiB;
constexpr size_t WS_QNA = 57 * MiB, WS_KNA = 73 * MiB, WS_VT = 89 * MiB, WS_QF = 105 * MiB, WS_QB = 121 * MiB, WS_KF = 137 * MiB, WS_KFT = 153 * MiB, WS_KB = 169 * MiB, WS_KBT = 185 * MiB,
                 WS_VHT = 201 * MiB, WS_GHG = 217 * MiB, WS_GF = 233 * MiB, WS_GB = 235 * MiB;
constexpr size_t WS_OHG = WS_KNA;
constexpr size_t WS_T = WS_VT, WS_MIX = WS_KF, WS_U = WS_QNA, WS_END = 247 * MiB;
constexpr int LDS_BYTES = 163840, LDS_CTL = 162816;
constexpr size_t WS_C4CNT = 768 * 1024 + 16 * 1024;

namespace pg8 {
#define PG8_LAS __attribute__((address_space(3)))
typedef unsigned short bf16_t;
typedef short bf16x8 __attribute__((ext_vector_type(8)));
typedef float f32x4 __attribute__((ext_vector_type(4)));
typedef unsigned u32x4 __attribute__((ext_vector_type(4)));
constexpr int BM = 256, BK = 64, HALF = 128, HTB = HALF * BK * 2  , STAGE_BYTES = 8 * HTB, NXCD = 8, WGM = 8;

__host__ __device__ __forceinline__ int lds_byte(int r, int c) { const int st = (r >> 4) * 2 + (c >> 5), rr = r & 15, cc = c & 31, ob = rr * 64 + cc * 2; return st * 1024 + (ob ^ (((ob >> 9) & 1) << 5)); }
__host__ __device__ __forceinline__ void stage_rc(int b, int& R, int& C) { const int st = b / 1024, sb = b % 1024, swz = sb ^ (((sb >> 9) & 1) << 5); R = (st >> 1) * 16 + swz / 64; C = (st & 1) * 32 + (swz % 64) / 2; }
__host__ __device__ __forceinline__ int perm32(int rho) { const int n = rho >> 4, i = rho & 15; return 8 * (i >> 2) + 4 * n + (i & 3); }

struct Unit { int pm, pn; };
struct Gemm { const bf16_t* A; const bf16_t* Bt; int M, N, K; };

struct StaticOrder {
    int nM, nN, nwg, G, c;
    __host__ __device__ void init(int M, int N, int G_, int c_) { nM = M / BM; nN = N / BM; nwg = nM * nN; G = G_; c = c_; }
    __host__ __device__ bool next(int i, Unit& u) const {
        const long L = (long)i * G + c; if (L >= nwg) return false;
        int wgid = (int)L; { const int q = nwg / NXCD, r = nwg % NXCD, xcd = wgid % NXCD, off = wgid / NXCD; wgid = (xcd < r ? xcd * (q + 1) : r * (q + 1) + (xcd - r) * q) + off; }
        const int nig = WGM * nN, gid = wgid / nig, fm = gid * WGM, gsz = (nM - fm) < WGM ? (nM - fm) : WGM;
        u.pm = fm + ((wgid % nig) % gsz); u.pn = (wgid % nig) / gsz; return true;
    }
    __device__ __forceinline__ void a_ready(const Unit&) const {}
    __device__ __forceinline__ void done(const Unit&) const {}
};


struct PairOrder {
    StaticOrder base; Unit u0;
    __host__ __device__ void init(int M_, int N_, int G_, int c_) { base.init(M_, N_, G_, c_); base.next(0, u0); }
    __host__ __device__ bool next(int i, Unit& u) const { if (i >= 2) return false; u.pm = u0.pm + 64 * i; u.pn = u0.pn + 4 * i; return true; }
    __device__ __forceinline__ void a_ready(const Unit&) const {}
    __device__ __forceinline__ void done(const Unit&) const {}
};

typedef float cvt_f32x2_t __attribute__((ext_vector_type(2)));
typedef __bf16 cvt_bf16x2_t __attribute__((ext_vector_type(2)));
__device__ __forceinline__ unsigned cvt_pk_bf16(float lo, float hi) { const cvt_f32x2_t v = {lo, hi}; const cvt_bf16x2_t b = __builtin_convertvector(v, cvt_bf16x2_t); return __builtin_bit_cast(unsigned, b); }
__device__ __forceinline__ unsigned short f2bf(float f) { unsigned u = __builtin_bit_cast(unsigned, f); return (unsigned short)((u + 0x7fffu + ((u >> 16) & 1u)) >> 16); }
__device__ __forceinline__ float bflo(unsigned w) { return __builtin_bit_cast(float, w << 16); }
__device__ __forceinline__ float bfhi(unsigned w) { return __builtin_bit_cast(float, w & 0xffff0000u); }
__device__ __forceinline__ float sigm(float x) { return __builtin_amdgcn_rcpf(1.0f + __expf(-x)); }
template <int CTRL> __device__ __forceinline__ float dpp_mov(float v) { return __builtin_bit_cast(float, __builtin_amdgcn_update_dpp(0, __builtin_bit_cast(int, v), CTRL, 0xf, 0xf, true)); }
__device__ __forceinline__ float row_prefix16(float v, int fr) {
    v += dpp_mov<0x111>(v); v += dpp_mov<0x112>(v); v += dpp_mov<0x114>(v); v += dpp_mov<0x118>(v); (void)fr;
    return v;
}
__device__ __forceinline__ float row_suffix16(float v, int fr) {
    v += dpp_mov<0x101>(v); v += dpp_mov<0x102>(v); v += dpp_mov<0x104>(v); v += dpp_mov<0x108>(v); (void)fr;
    return v;
}

enum EpiMode { EM_IN = 0, EM_C1A = 1, EM_C1B = 2, EM_C2 = 3, EM_C3 = 4, EM_C4 = 5 };
template <int MODE> struct EpiAll {
    static constexpr bool PERM = true, AFTER_DRAIN = false;
    static constexpr int mode = MODE; unsigned char* ws; float* out; const float* x; const float* gain; const float* gfin;
    __device__ __forceinline__ void operator()(const f32x4 (&acc)[2][2][4][2], const Unit& u, int wr, int wc, int fr, int fq) const {
        const int pn = u.pn;
        const int row0 = u.pm * BM + wr * 64 + fr;
#define EP_B(off) ((bf16_t*)(ws + (off)))
#define EP_F(off) ((float*)(ws + (off)))
        bf16_t* const QNA = EP_B(WS_QNA); bf16_t* const KNA = EP_B(WS_KNA); bf16_t* const VT = EP_B(WS_VT); bf16_t* const QF = EP_B(WS_QF); bf16_t* const QB = EP_B(WS_QB); bf16_t* const KF = EP_B(WS_KF); bf16_t* const KB = EP_B(WS_KB);
        bf16_t* const KFT = EP_B(WS_KFT); bf16_t* const KBT = EP_B(WS_KBT); bf16_t* const VHT = EP_B(WS_VHT); bf16_t* const GHG = EP_B(WS_GHG); float* const GF = EP_F(WS_GF); float* const GB = EP_F(WS_GB); const float* const LB = EP_F(WS_LB);
        bf16_t* const SNA = (bf16_t*)out; bf16_t* const SHG = (bf16_t*)out + (size_t)M * D;
        bf16_t* const T = EP_B(WS_T); bf16_t* const MIX = EP_B(WS_MIX); bf16_t* const H1B = EP_B(WS_XN); bf16_t* const U = EP_B(WS_U); float* const ssq1 = EP_F(WS_SSQ1); float* const ssq2 = EP_F(WS_SSQ2);
#undef EP_B
#undef EP_F
        const int cl0 = wc * 32 + 8 * fq;
        if (mode == EM_IN) {
            if (pn < 4) {
                bf16_t* base = (pn < 2) ? QNA : KNA; const float sc = (pn < 2) ? 0.125f : 1.0f; const int colt = (pn & 1) * 256 + cl0;
#pragma unroll
                for (int ai = 0; ai < 2; ++ai)
#pragma unroll
                    for (int m = 0; m < 4; ++m) { bf16_t* rowp = base + (size_t)(row0 + ai * HALF + m * 16) * 512 + colt;
#pragma unroll
                        for (int bj = 0; bj < 2; ++bj) { const f32x4 v0 = acc[ai][bj][m][0] * sc, v1 = acc[ai][bj][m][1] * sc; u32x4 w;
                            w.x = cvt_pk_bf16(v0[0], v0[1]); w.y = cvt_pk_bf16(v0[2], v0[3]); w.z = cvt_pk_bf16(v1[0], v1[1]); w.w = cvt_pk_bf16(v1[2], v1[3]);
                            *(u32x4*)(rowp + bj * HALF) = w; } }
            } else if (pn < 6) {
                const int colt = (pn - 4) * 256 + cl0;
#pragma unroll
                for (int ai = 0; ai < 2; ++ai)
#pragma unroll
                    for (int m = 0; m < 4; ++m) { const int row = row0 + ai * HALF + m * 16; const int b = row >> 11, t = row & 2047, r = t >> 6, c = t & 63;
#pragma unroll
                        for (int bj = 0; bj < 2; ++bj) { const int col = colt + bj * HALF; const int h = col >> 6, d0 = col & 63;
                            bf16_t* bp = VT + ((((size_t)(b * 8 + h) * 32 + r) * 64 + d0) * 64 + c);
#pragma unroll
                            for (int n = 0; n < 2; ++n)
#pragma unroll
                                for (int j = 0; j < 4; ++j) bp[(4 * n + j) * 64] = f2bf(acc[ai][bj][m][n][j]); } }
            } else if (pn < 14) {
                const int ch0 = (pn - 6) * 64 + wc * 16 + fq * 4;
                const f32x4 lbf = *(const f32x4*)(LB + ch0), lbb = *(const f32x4*)(LB + 512 + ch0);
#pragma unroll
                for (int ai = 0; ai < 2; ++ai)
#pragma unroll
                    for (int m = 0; m < 4; ++m) { const int row = row0 + ai * HALF + m * 16; const int chunk = row >> 4;
                        const f32x4 q = acc[ai][0][m][0], zf = acc[ai][0][m][1], zb = acc[ai][1][m][0], iv = acc[ai][1][m][1];
                        float qfv[4], kfv[4], qbv[4], kbv[4]; f32x4 gfv, gbv;
#pragma unroll
                        for (int j = 0; j < 4; ++j) {
                            const float qs = q[j] * sigm(q[j]);
                            const float ff = lbf[j] + (1.0f - lbf[j]) * sigm(zf[j]);
                            const float fb = lbb[j] + (1.0f - lbb[j]) * sigm(zb[j]);
                            const float bf_ = row_prefix16(__builtin_amdgcn_logf(ff) * 0.69314718056f, fr), bb_ = row_suffix16(__builtin_amdgcn_logf(fb) * 0.69314718056f, fr);
                            const float ef = __expf(bf_), eb = __expf(bb_);
                            qfv[j] = qs * ef; kfv[j] = (1.0f - ff) * __expf(-bf_);
                            qbv[j] = qs * eb; kbv[j] = (1.0f - fb) * __expf(-bb_);
                            gfv[j] = ef; gbv[j] = eb;
                        }
                        typedef unsigned u32x2 __attribute__((ext_vector_type(2)));
                        const size_t ro = (size_t)row * 512 + ch0;
                        u32x2 w;
                        w.x = cvt_pk_bf16(qfv[0], qfv[1]); w.y = cvt_pk_bf16(qfv[2], qfv[3]); *(u32x2*)(QF + ro) = w;
                        w.x = cvt_pk_bf16(qbv[0], qbv[1]); w.y = cvt_pk_bf16(qbv[2], qbv[3]); *(u32x2*)(QB + ro) = w;
                        w.x = cvt_pk_bf16(kfv[0], kfv[1]); w.y = cvt_pk_bf16(kfv[2], kfv[3]); *(u32x2*)(KF + ro) = w;
                        w.x = cvt_pk_bf16(kbv[0], kbv[1]); w.y = cvt_pk_bf16(kbv[2], kbv[3]); *(u32x2*)(KB + ro) = w;
                        const size_t to = ((size_t)chunk * 512 + ch0) * 16 + fr;
#pragma unroll
                        for (int j = 0; j < 4; ++j) { KFT[to + j * 16] = f2bf(kfv[j]); KBT[to + j * 16] = f2bf(kbv[j]); VHT[to + j * 16] = f2bf(iv[j]); }
                        if (fr == 15) *(f32x4*)(GF + (size_t)chunk * 512 + ch0) = gfv;
                        if (fr == 0)  *(f32x4*)(GB + (size_t)chunk * 512 + ch0) = gbv;
                    }
            } else if (pn < 16) {
                const int colt = (pn - 14) * 256 + cl0;
#pragma unroll
                for (int bj = 0; bj < 2; ++bj) { const f32x4 g0 = *(const f32x4*)(gain + colt + bj * HALF), g1 = *(const f32x4*)(gain + colt + bj * HALF + 4);
#pragma unroll
                    for (int ai = 0; ai < 2; ++ai)
#pragma unroll
                        for (int m = 0; m < 4; ++m) { f32x4 v0 = acc[ai][bj][m][0], v1 = acc[ai][bj][m][1];
#pragma unroll
                            for (int j = 0; j < 4; ++j) { v0[j] = v0[j] * sigm(v0[j]) * g0[j]; v1[j] = v1[j] * sigm(v1[j]) * g1[j]; }
                            u32x4 w; w.x = cvt_pk_bf16(v0[0], v0[1]); w.y = cvt_pk_bf16(v0[2], v0[3]); w.z = cvt_pk_bf16(v1[0], v1[1]); w.w = cvt_pk_bf16(v1[2], v1[3]);
                            *(u32x4*)(GHG + (size_t)(row0 + ai * HALF + m * 16) * 512 + colt + bj * HALF) = w; } }
            } else {
                bf16_t* base = (pn < 20) ? SNA : SHG; const int colt = ((pn - 16) & 3) * 256 + cl0;
#pragma unroll
                for (int ai = 0; ai < 2; ++ai)
#pragma unroll
                    for (int m = 0; m < 4; ++m)
#pragma unroll
                        for (int bj = 0; bj < 2; ++bj) { f32x4 v0 = acc[ai][bj][m][0], v1 = acc[ai][bj][m][1];
#pragma unroll
                            for (int j = 0; j < 4; ++j) { v0[j] = sigm(v0[j]); v1[j] = sigm(v1[j]); }
                            u32x4 w; w.x = cvt_pk_bf16(v0[0], v0[1]); w.y = cvt_pk_bf16(v0[2], v0[3]); w.z = cvt_pk_bf16(v1[0], v1[1]); w.w = cvt_pk_bf16(v1[2], v1[3]);
                            *(u32x4*)(base + (size_t)(row0 + ai * HALF + m * 16) * 1024 + colt + bj * HALF) = w; }
            }
            return;
        }
        const int colt = (mode == EM_C1A ? (pn & 3) : pn) * BM + cl0;
        if (mode == EM_C1A || mode == EM_C1B) {
            const bool second = (mode == EM_C1B) || (pn >= 4); const int row0c = (mode == EM_C1A) ? (row0 & (M - 1)) : row0;
            const bf16_t* gate = second ? SHG : SNA; bf16_t* dst = second ? MIX : T;
#pragma unroll
            for (int ai = 0; ai < 2; ++ai) {
                u32x4 gv[4][2], tv[4][2];
#pragma unroll
                for (int m = 0; m < 4; ++m)
#pragma unroll
                    for (int bj = 0; bj < 2; ++bj) { const size_t off = (size_t)(row0c + ai * HALF + m * 16) * 1024 + colt + bj * HALF;
                        gv[m][bj] = *(const u32x4*)(gate + off); if (second) tv[m][bj] = *(const u32x4*)(T + off); else tv[m][bj] = (u32x4){0u, 0u, 0u, 0u}; }
#pragma unroll
                for (int m = 0; m < 4; ++m)
#pragma unroll
                    for (int bj = 0; bj < 2; ++bj) { const size_t off = (size_t)(row0c + ai * HALF + m * 16) * 1024 + colt + bj * HALF;
                        const u32x4 g = gv[m][bj], tt = tv[m][bj]; const f32x4 a0 = acc[ai][bj][m][0], a1 = acc[ai][bj][m][1];
                        const float r0 = a0[0] * bflo(g.x) + bflo(tt.x), r1 = a0[1] * bfhi(g.x) + bfhi(tt.x), r2 = a0[2] * bflo(g.y) + bflo(tt.y), r3 = a0[3] * bfhi(g.y) + bfhi(tt.y);
                        const float r4 = a1[0] * bflo(g.z) + bflo(tt.z), r5 = a1[1] * bfhi(g.z) + bfhi(tt.z), r6 = a1[2] * bflo(g.w) + bflo(tt.w), r7 = a1[3] * bfhi(g.w) + bfhi(tt.w);
                        u32x4 w; w.x = cvt_pk_bf16(r0, r1); w.y = cvt_pk_bf16(r2, r3); w.z = cvt_pk_bf16(r4, r5); w.w = cvt_pk_bf16(r6, r7);
                        *(u32x4*)(dst + off) = w; }
            }
        } else if (mode == EM_C4) {
            f32x4 (&hacc)[2][2][4][2] = const_cast<f32x4 (&)[2][2][4][2]>(acc);
#pragma unroll
            for (int ai = 0; ai < 2; ++ai)
#pragma unroll
                for (int mp = 0; mp < 2; ++mp) {
                    f32x4 pre[2][2][2];
#pragma unroll
                    for (int mm = 0; mm < 2; ++mm)
#pragma unroll
                        for (int bj = 0; bj < 2; ++bj) { const size_t off = (size_t)(row0 + ai * HALF + (2 * mp + mm) * 16) * 1024 + colt + bj * HALF;
                            const u32x4 hb = *(const u32x4*)(H1B + off);
                            pre[mm][bj][0] = (f32x4){bflo(hb.x), bfhi(hb.x), bflo(hb.y), bfhi(hb.y)}; pre[mm][bj][1] = (f32x4){bflo(hb.z), bfhi(hb.z), bflo(hb.w), bfhi(hb.w)}; }
#pragma unroll
                    for (int mm = 0; mm < 2; ++mm) { const int m = 2 * mp + mm; const int row = row0 + ai * HALF + m * 16; float s = 0.f;
#pragma unroll
                        for (int bj = 0; bj < 2; ++bj) { const f32x4 h0 = pre[mm][bj][0] + acc[ai][bj][m][0], h1 = pre[mm][bj][1] + acc[ai][bj][m][1];
                            hacc[ai][bj][m][0] = h0; hacc[ai][bj][m][1] = h1;
                            s += (h0[0] * h0[0] + h0[1] * h0[1]) + (h0[2] * h0[2] + h0[3] * h0[3]) + (h1[0] * h1[0] + h1[1] * h1[1]) + (h1[2] * h1[2] + h1[3] * h1[3]); }
                        s += __shfl_xor(s, 16); s += __shfl_xor(s, 32);
                        if (fq == 0) ssq2[(size_t)row * 16 + pn * 4 + wc] = s; }
                    asm volatile("" ::: "memory");
                }
            asm volatile("s_waitcnt vmcnt(0)" ::: "memory");
            __builtin_amdgcn_s_barrier();
            if (threadIdx.x == 0) {
                unsigned* cnt = (unsigned*)(ws + WS_C4CNT) + 16 * u.pm;
                __builtin_amdgcn_fence(__ATOMIC_RELEASE, "agent");
                asm volatile("s_waitcnt vmcnt(0)" ::: "memory");
                __hip_atomic_fetch_add(cnt, 1u, __ATOMIC_RELAXED, __HIP_MEMORY_SCOPE_AGENT);
                unsigned spins = 0;
                while (__hip_atomic_load(cnt, __ATOMIC_RELAXED, __HIP_MEMORY_SCOPE_AGENT) < 4u) { __builtin_amdgcn_s_sleep(2); if (++spins > (1u << 22)) break; }
                __builtin_amdgcn_fence(__ATOMIC_ACQUIRE, "agent");
                asm volatile("s_waitcnt vmcnt(0)" ::: "memory");
            }
            __builtin_amdgcn_s_barrier();
            asm volatile("" ::: "memory");
            const f32x4 gA0 = *(const f32x4*)(gfin + colt), gA1 = *(const f32x4*)(gfin + colt + 4), gB0 = *(const f32x4*)(gfin + colt + HALF), gB1 = *(const f32x4*)(gfin + colt + HALF + 4);
#pragma unroll
            for (int ai = 0; ai < 2; ++ai)
#pragma unroll
                for (int mp = 0; mp < 2; ++mp) {
                    f32x4 pp[2][4];
#pragma unroll
                    for (int mm = 0; mm < 2; ++mm)
#pragma unroll
                        for (int q = 0; q < 4; ++q) pp[mm][q] = *(const f32x4*)(ssq2 + (size_t)(row0 + ai * HALF + (2 * mp + mm) * 16) * 16 + 4 * q);
#pragma unroll
                    for (int mm = 0; mm < 2; ++mm) { const int m = 2 * mp + mm; const int row = row0 + ai * HALF + m * 16; const size_t off = (size_t)row * 1024 + colt;
                        const f32x4 p0 = pp[mm][0], p1 = pp[mm][1], p2 = pp[mm][2], p3 = pp[mm][3];
                        const float rs = rsqrtf(((((p0[0] + p0[1]) + (p0[2] + p0[3])) + ((p1[0] + p1[1]) + (p1[2] + p1[3]))) + (((p2[0] + p2[1]) + (p2[2] + p2[3])) + ((p3[0] + p3[1]) + (p3[2] + p3[3])))) * (1.0f / 1024.0f) + 1e-6f);
                        *(f32x4*)(out + off) = acc[ai][0][m][0] * rs * gA0; *(f32x4*)(out + off + 4) = acc[ai][0][m][1] * rs * gA1;
                        *(f32x4*)(out + off + HALF) = acc[ai][1][m][0] * rs * gB0; *(f32x4*)(out + off + HALF + 4) = acc[ai][1][m][1] * rs * gB1; }
                    asm volatile("" ::: "memory");
                }
        } else if (mode == EM_C2) {
            const float* base = (mode == EM_C2) ? x : (const float*)out; float* ssq = (mode == EM_C2) ? ssq1 : ssq2;
#pragma unroll
            for (int ai = 0; ai < 2; ++ai) {
                f32x4 pre[4][2][2];
#pragma unroll
                for (int m = 0; m < 4; ++m)
#pragma unroll
                    for (int bj = 0; bj < 2; ++bj) { const size_t off = (size_t)(row0 + ai * HALF + m * 16) * 1024 + colt + bj * HALF;
                        pre[m][bj][0] = *(const f32x4*)(base + off); pre[m][bj][1] = *(const f32x4*)(base + off + 4); }
#pragma unroll
                for (int m = 0; m < 4; ++m) { const int row = row0 + ai * HALF + m * 16; float s = 0.f;
#pragma unroll
                    for (int bj = 0; bj < 2; ++bj) { const size_t off = (size_t)row * 1024 + colt + bj * HALF;
                        const f32x4 h0 = pre[m][bj][0] + acc[ai][bj][m][0], h1 = pre[m][bj][1] + acc[ai][bj][m][1];
                        s += (h0[0] * h0[0] + h0[1] * h0[1]) + (h0[2] * h0[2] + h0[3] * h0[3]) + (h1[0] * h1[0] + h1[1] * h1[1]) + (h1[2] * h1[2] + h1[3] * h1[3]);
                        if (mode == EM_C2) { u32x4 w; w.x = cvt_pk_bf16(h0[0], h0[1]); w.y = cvt_pk_bf16(h0[2], h0[3]); w.z = cvt_pk_bf16(h1[0], h1[1]); w.w = cvt_pk_bf16(h1[2], h1[3]);
                            *(u32x4*)(H1B + off) = w; } }
                    s += __shfl_xor(s, 16); s += __shfl_xor(s, 32);
                    if (fq == 0) ssq[(size_t)row * 16 + pn * 4 + wc] = s; }
            }
        } else {
#pragma unroll
            for (int ai = 0; ai < 2; ++ai) {
                f32x4 pp[4][4];
#pragma unroll
                for (int m = 0; m < 4; ++m)
#pragma unroll
                    for (int q = 0; q < 4; ++q) pp[m][q] = *(const f32x4*)(ssq1 + (size_t)(row0 + ai * HALF + m * 16) * 16 + 4 * q);
#pragma unroll
                for (int m = 0; m < 4; ++m) { const int row = row0 + ai * HALF + m * 16;
                    const f32x4 p0 = pp[m][0], p1 = pp[m][1], p2 = pp[m][2], p3 = pp[m][3];
                    const float rs = rsqrtf(((((p0[0] + p0[1]) + (p0[2] + p0[3])) + ((p1[0] + p1[1]) + (p1[2] + p1[3]))) + (((p2[0] + p2[1]) + (p2[2] + p2[3])) + ((p3[0] + p3[1]) + (p3[2] + p3[3])))) * (1.0f / 1024.0f) + 1e-6f);
#pragma unroll
                    for (int bj = 0; bj < 2; ++bj) { f32x4 v0 = acc[ai][bj][m][0] * rs, v1 = acc[ai][bj][m][1] * rs;
#pragma unroll
                        for (int j = 0; j < 4; ++j) { const float a = fmaxf(v0[j], 0.f), b = fmaxf(v1[j], 0.f); v0[j] = a * a; v1[j] = b * b; }
                        u32x4 w; w.x = cvt_pk_bf16(v0[0], v0[1]); w.y = cvt_pk_bf16(v0[2], v0[3]); w.z = cvt_pk_bf16(v1[0], v1[1]); w.w = cvt_pk_bf16(v1[2], v1[3]);
                        *(u32x4*)(U + (size_t)row * 4096 + colt + bj * HALF) = w; } }
            }
        }
    }
};

template <class Epi, class Sched, bool ALIGN_EPI = false, bool SP2 = false>
__device__ __forceinline__ void gemm_phase(PG8_LAS unsigned char* lds, const Gemm g, const Sched& S, const Epi& E) {
    int tid_ = threadIdx.x; asm volatile("" : "+v"(tid_));
    const int tid = tid_, wid = __builtin_amdgcn_readfirstlane(tid >> 6), lane = tid & 63, wr = wid >> 2, wc = wid & 3, fr = lane & 15, fq = lane >> 4;
    const int K = g.K, nt = K / BK;
    unsigned voffA[2], voffB[2];
#pragma unroll
    for (int i = 0; i < 2; ++i) { int R, C; stage_rc(tid * 16 + i * 8192, R, C); const int Rb = Epi::PERM ? ((R & ~31) + perm32(R & 31)) : R;
        voffA[i] = (unsigned)(R * K + C) * 2u; voffB[i] = (unsigned)(Rb * K + C) * 2u; }
    const size_t kstep = (size_t)(BK * 2);
    const size_t hstep = (size_t)HALF * K * 2;
    const size_t tstep = 2 * hstep;
    const unsigned ldsw = (unsigned)wid * 1024u;
    const int aoff = lds_byte(wr * 64 + fr, fq * 8), boff = lds_byte(wc * 32 + fr, fq * 8);
#define PG8_SA(b, h) (((b) * 2 + (h)) * HTB)
#define PG8_SB(b, h) ((4 + (b) * 2 + (h)) * HTB)
#define PG8_STAGE(bufoff, gbase, voff) do { _Pragma("unroll") for (int _i = 0; _i < 2; ++_i) \
        __builtin_amdgcn_global_load_lds((const unsigned*)((const char*)(gbase) + (voff)[_i]), (PG8_LAS unsigned*)(lds + (bufoff) + ldsw + _i * 8192), 16, 0, 0); } while (0)
#define PG8_LDA(dst, b, h) do { _Pragma("unroll") for (int m = 0; m < 4; ++m) _Pragma("unroll") for (int k = 0; k < 2; ++k) dst[m][k] = *(const PG8_LAS bf16x8*)(lds + PG8_SA(b, h) + aoff + m * 2048 + k * 1024); } while (0)
#define PG8_LDB(dst, b, h) do { _Pragma("unroll") for (int n = 0; n < 2; ++n) _Pragma("unroll") for (int k = 0; k < 2; ++k) dst[n][k] = *(const PG8_LAS bf16x8*)(lds + PG8_SB(b, h) + boff + n * 2048 + k * 1024); } while (0)
#define PG8_MMA(ai, bj, At, Bt) do { __builtin_amdgcn_s_setprio(1); _Pragma("unroll") for (int m = 0; m < 4; ++m) _Pragma("unroll") for (int n = 0; n < 2; ++n) _Pragma("unroll") for (int k = 0; k < 2; ++k) \
        acc[ai][bj][m][n] = __builtin_amdgcn_mfma_f32_16x16x32_bf16(Bt[n][k], At[m][k], acc[ai][bj][m][n], 0, 0, 0); __builtin_amdgcn_s_setprio(0); } while (0)
#define PG8_WAIT_V(n) asm volatile("s_waitcnt vmcnt(" #n ")" ::: "memory")
#define PG8_WAIT_L(n) asm volatile("s_waitcnt lgkmcnt(" #n ")" ::: "memory")
#define PG8_BAR __builtin_amdgcn_s_barrier()
#define PG8_SCHED __builtin_amdgcn_sched_barrier(0)
    Unit cur, nxt; int ui = 0;
    if (!S.next(0, cur)) return;
    f32x4 acc[2][2][4][2];
#pragma unroll
    for (int a = 0; a < 2; ++a)
#pragma unroll
        for (int b = 0; b < 2; ++b)
#pragma unroll
            for (int m = 0; m < 4; ++m)
#pragma unroll
                for (int n = 0; n < 2; ++n) acc[a][b][m][n] = (f32x4){0.f, 0.f, 0.f, 0.f};
    bf16x8 At[4][2], B0[2][2], B1[2][2];
    const char* cA = (const char*)g.A + (size_t)cur.pm * tstep; const char* cB = (const char*)g.Bt + (size_t)cur.pn * tstep;
    S.a_ready(cur);
    if constexpr (SP2) {
        PG8_STAGE(PG8_SB(0, 0), cB, voffB); PG8_STAGE(PG8_SB(0, 1), cB + hstep, voffB); PG8_STAGE(PG8_SA(0, 0), cA, voffA); PG8_STAGE(PG8_SA(0, 1), cA + hstep, voffA);
        if (wr == 1) PG8_BAR;
        PG8_WAIT_V(2); PG8_BAR;
        PG8_STAGE(PG8_SB(1, 0), cB + kstep, voffB); PG8_STAGE(PG8_SA(1, 0), cA + kstep, voffA); PG8_STAGE(PG8_SB(1, 1), cB + hstep + kstep, voffB);
        PG8_WAIT_V(6); PG8_BAR;
    } else {
        PG8_STAGE(PG8_SB(0, 0), cB, voffB); PG8_STAGE(PG8_SA(0, 0), cA, voffA); PG8_STAGE(PG8_SB(0, 1), cB + hstep, voffB); PG8_STAGE(PG8_SA(0, 1), cA + hstep, voffA);
        if (wr == 1) PG8_BAR;
        PG8_WAIT_V(4); PG8_BAR;
        PG8_STAGE(PG8_SB(1, 0), cB + kstep, voffB); PG8_STAGE(PG8_SA(1, 0), cA + kstep, voffA); PG8_STAGE(PG8_SB(1, 1), cB + hstep + kstep, voffB);
        PG8_WAIT_V(6); PG8_BAR;
    }
    for (;;) {
        const bool has_next = S.next(ui + 1, nxt);
        const char* nA = has_next ? (const char*)g.A + (size_t)nxt.pm * tstep : cA; const char* nB = has_next ? (const char*)g.Bt + (size_t)nxt.pn * tstep : cB;
        for (int t = 0; t < nt; t += 2) {
            const bool last = (t == nt - 2);
            const char* a1 = cA + (size_t)(t + 1) * kstep;
            const char* a2 = last ? nA : cA + (size_t)(t + 2) * kstep; const char* b2 = last ? nB : cB + (size_t)(t + 2) * kstep;
            const char* a3 = a2 + kstep; const char* b3 = b2 + kstep;
            if (last && has_next) S.a_ready(nxt);
            if constexpr (SP2) {
            PG8_LDB(B0, 0, 0); PG8_LDB(B1, 0, 1); PG8_SCHED; PG8_LDA(At, 0, 0); PG8_STAGE(PG8_SA(1, 1), a1 + hstep, voffA);
            PG8_WAIT_V(8); PG8_WAIT_L(0); PG8_BAR; PG8_MMA(0, 0, At, B0); PG8_MMA(0, 1, At, B1); PG8_BAR; PG8_SCHED;
            PG8_LDA(At, 0, 1); PG8_STAGE(PG8_SB(0, 0), b2, voffB); PG8_STAGE(PG8_SB(0, 1), b2 + hstep, voffB); PG8_STAGE(PG8_SA(0, 0), a2, voffA);
            PG8_WAIT_V(8); PG8_WAIT_L(0); PG8_BAR; PG8_MMA(1, 0, At, B0); PG8_MMA(1, 1, At, B1); PG8_BAR; PG8_SCHED;
            PG8_LDB(B0, 1, 0); PG8_LDB(B1, 1, 1); PG8_SCHED; PG8_LDA(At, 1, 0); PG8_STAGE(PG8_SA(0, 1), a2 + hstep, voffA);
            PG8_WAIT_V(8); PG8_WAIT_L(0); PG8_BAR; PG8_MMA(0, 0, At, B0); PG8_MMA(0, 1, At, B1); PG8_BAR; PG8_SCHED;
            PG8_LDA(At, 1, 1); PG8_STAGE(PG8_SB(1, 0), b3, voffB); PG8_STAGE(PG8_SB(1, 1), b3 + hstep, voffB); PG8_STAGE(PG8_SA(1, 0), a3, voffA);
            PG8_WAIT_V(8); PG8_WAIT_L(0); PG8_BAR; PG8_MMA(1, 0, At, B0); PG8_MMA(1, 1, At, B1); PG8_BAR; PG8_SCHED;
            } else {
            PG8_LDB(B0, 0, 0); PG8_SCHED; PG8_LDA(At, 0, 0); PG8_STAGE(PG8_SA(1, 1), a1 + hstep, voffA);
            PG8_WAIT_L(8); PG8_BAR; PG8_WAIT_L(0); PG8_MMA(0, 0, At, B0); PG8_BAR; PG8_SCHED;
            PG8_LDB(B1, 0, 1); PG8_STAGE(PG8_SB(0, 0), b2, voffB);
            PG8_BAR; PG8_WAIT_L(0); PG8_MMA(0, 1, At, B1); PG8_BAR;
            PG8_LDA(At, 0, 1); PG8_STAGE(PG8_SA(0, 0), a2, voffA);
            PG8_BAR; PG8_WAIT_L(0); PG8_MMA(1, 0, At, B0); PG8_BAR; PG8_SCHED;
            PG8_STAGE(PG8_SB(0, 1), b2 + hstep, voffB);
            PG8_WAIT_V(6); PG8_BAR; PG8_MMA(1, 1, At, B1); PG8_BAR;
            PG8_LDB(B0, 1, 0); PG8_SCHED; PG8_LDA(At, 1, 0); PG8_STAGE(PG8_SA(0, 1), a2 + hstep, voffA);
            PG8_WAIT_L(8); PG8_BAR; PG8_WAIT_L(0); PG8_MMA(0, 0, At, B0); PG8_BAR; PG8_SCHED;
            PG8_LDB(B1, 1, 1); PG8_STAGE(PG8_SB(1, 0), b3, voffB);
            PG8_BAR; PG8_WAIT_L(0); PG8_MMA(0, 1, At, B1); PG8_BAR;
            PG8_LDA(At, 1, 1); PG8_STAGE(PG8_SA(1, 0), a3, voffA);
            PG8_BAR; PG8_WAIT_L(0); PG8_MMA(1, 0, At, B0); PG8_BAR; PG8_SCHED;
            PG8_STAGE(PG8_SB(1, 1), b3 + hstep, voffB);
            PG8_WAIT_V(6); PG8_BAR; PG8_MMA(1, 1, At, B1); PG8_BAR;
            }
        }
        if constexpr (ALIGN_EPI) { if (wr == 0) PG8_BAR; }
        if constexpr (!Epi::AFTER_DRAIN) { E(acc, cur, wr, wc, fr, fq); S.done(cur); }
        if (!has_next) break;
#pragma unroll
        for (int a = 0; a < 2; ++a)
#pragma unroll
            for (int b = 0; b < 2; ++b)
#pragma unroll
                for (int m = 0; m < 4; ++m)
#pragma unroll
                    for (int n = 0; n < 2; ++n) acc[a][b][m][n] = (f32x4){0.f, 0.f, 0.f, 0.f};
        cur = nxt; cA = nA; cB = nB; ++ui;
        if constexpr (ALIGN_EPI) { if (wr == 1) PG8_BAR; }
    }
    PG8_WAIT_V(0);
    if constexpr (!ALIGN_EPI) { if (wr == 0) PG8_BAR; }
    PG8_BAR;
    if constexpr (Epi::AFTER_DRAIN) { E.fused(acc, cur, wr, wc, fr, fq, lds, wid, lane); S.done(cur); }
#undef PG8_SA
#undef PG8_SB
#undef PG8_STAGE
#undef PG8_LDA
#undef PG8_LDB
#undef PG8_MMA
#undef PG8_WAIT_V
#undef PG8_WAIT_L
#undef PG8_BAR
#undef PG8_SCHED
}
}

#define GAS __attribute__((address_space(1)))
#define LAS __attribute__((address_space(3)))
typedef unsigned short bf16;
typedef unsigned v4u __attribute__((ext_vector_type(4)));
typedef unsigned v2u __attribute__((ext_vector_type(2)));
typedef float f32x4 __attribute__((ext_vector_type(4)));
typedef float f32x2 __attribute__((ext_vector_type(2)));
typedef short bf16x8 __attribute__((ext_vector_type(8)));
typedef short s16x4 __attribute__((ext_vector_type(4)));
using pg8::f2bf; using pg8::cvt_pk_bf16; using pg8::bflo; using pg8::bfhi;


__device__ __forceinline__ float wave_sum(float v) {
#pragma unroll
    for (int o = 1; o < 64; o <<= 1) v += __shfl_xor(v, o);
    return v;
}
__device__ __forceinline__ unsigned pk2(float lo, float hi) { return (unsigned)f2bf(lo) | ((unsigned)f2bf(hi) << 16); }

#define XB_TMO      128
#define XB_XCNT(j)  (256  + 64 * (j))
#define XB_XSUB(j)  (1280 + 64 * (j))
#define XB_XGEN(j)  (2304 + 64 * (j))
#define XB_TOP      3328
#define XB_TOPGEN   3392
#define XCD_BAR_WORDS 3456
#define XB_SPIN_CAP (1u << 18)

__device__ __forceinline__ unsigned xb_ld(unsigned* p)              { return __hip_atomic_load(p, __ATOMIC_RELAXED, __HIP_MEMORY_SCOPE_AGENT); }
__device__ __forceinline__ unsigned xb_add(unsigned* p, unsigned v) { return __hip_atomic_fetch_add(p, v, __ATOMIC_RELAXED, __HIP_MEMORY_SCOPE_AGENT); }
__device__ __forceinline__ unsigned xb_xcc_id() { return (unsigned)__builtin_amdgcn_s_getreg((3 << 11) | 20) & 0xFu; }
#define XB_SPIN(cond, bar) do { unsigned _sp = 0; while (cond) { __builtin_amdgcn_s_sleep(1); \
    if ((++_sp & 255u) == 0u) { if (xb_ld(&(bar)[XB_TMO])) break; if (_sp > XB_SPIN_CAP) { atomicAdd(&(bar)[XB_TMO], 1u); break; } } } } while (0)

struct XcdBarrier {
    unsigned* bar; unsigned x;
    volatile LAS unsigned* st;
};

__device__ __forceinline__ XcdBarrier xcd_barrier_post(unsigned* bar, volatile LAS unsigned* st) {
    XcdBarrier b; b.bar = bar; b.x = xb_xcc_id(); b.st = st;
    if (threadIdx.x == 0) (void)xb_add(&bar[XB_XCNT(b.x)], 1u);
    return b;
}
__device__ __forceinline__ void xcd_barrier_complete(unsigned* bar, unsigned x, unsigned& nloc, unsigned& nx) {
    const unsigned G = gridDim.x * gridDim.y * gridDim.z;
    unsigned sum, cnt, mine, sp = 0u;
    for (;;) {
        sum = 0u; cnt = 0u; mine = 0u;
#pragma unroll
        for (unsigned j = 0; j < 16; ++j) { const unsigned c = xb_ld(&bar[XB_XCNT(j)]); sum += c; cnt += (c > 0u) ? 1u : 0u; mine = (j == x) ? c : mine; }
        if (sum == G) break;
        __builtin_amdgcn_s_sleep(1);
        if ((++sp & 255u) == 0u) { if (xb_ld(&bar[XB_TMO])) break; if (sp > XB_SPIN_CAP) { atomicAdd(&bar[XB_TMO], 1u); break; } }
    }
    nloc = mine > 0u ? mine : 1u; nx = cnt > 0u ? cnt : 1u;
}

__device__ __forceinline__ void xcd_barrier(const XcdBarrier& b) {
    asm volatile("s_waitcnt vmcnt(0)" ::: "memory");
    __syncthreads();
    if (threadIdx.x == 0) {
        unsigned* bar = b.bar;
        __builtin_amdgcn_s_waitcnt(0);
        unsigned nloc = b.st[0], nx = b.st[1];
        if (nloc == 0u) { xcd_barrier_complete(bar, b.x, nloc, nx); b.st[0] = nloc; b.st[1] = nx; }
        const unsigned old = xb_add(&bar[XB_XSUB(b.x)], 1u);
        const unsigned gen = old / nloc;
        if (old + 1u == (gen + 1u) * nloc) {
            __builtin_amdgcn_fence(__ATOMIC_RELEASE, "agent");
            asm volatile("s_waitcnt vmcnt(0)" ::: "memory");
            const unsigned og = xb_add(&bar[XB_TOP], 1u);
            const unsigned tg = og / nx;
            if (og + 1u == (tg + 1u) * nx) xb_add(&bar[XB_TOPGEN], 1u);
            else XB_SPIN(xb_ld(&bar[XB_TOPGEN]) == tg, bar);
            __builtin_amdgcn_fence(__ATOMIC_ACQUIRE, "agent");
            xb_add(&bar[XB_XGEN(b.x)], 1u);
            asm volatile("s_waitcnt vmcnt(0)" ::: "memory");
        } else {
            XB_SPIN(xb_ld(&bar[XB_XGEN(b.x)]) == gen, bar);
            __builtin_amdgcn_fence(__ATOMIC_ACQUIRE, "agent");
            asm volatile("s_waitcnt vmcnt(0)" ::: "memory");
        }
    }
    __syncthreads();
}

#define XL_SUB(j) (5120 + 64 * (j))
#define XL_GEN(j) (5632 + 64 * (j))
__device__ __forceinline__ void xcd_local_barrier(const XcdBarrier& b) {
    asm volatile("s_waitcnt vmcnt(0)" ::: "memory");
    __syncthreads();
    if (threadIdx.x == 0) {
        unsigned* bar = b.bar; const unsigned nloc = b.st[0];
        const unsigned old = xb_add(&bar[XL_SUB(b.x)], 1u), gen = old / nloc;
        if (old + 1u == (gen + 1u) * nloc) xb_add(&bar[XL_GEN(b.x)], 1u);
        else XB_SPIN(xb_ld(&bar[XL_GEN(b.x)]) == gen, bar);
        __builtin_amdgcn_fence(__ATOMIC_ACQUIRE, "agent");
        asm volatile("s_waitcnt vmcnt(0)" ::: "memory");
    }
    __syncthreads();
}
constexpr size_t WS_BAR = 768 * KiB, BAR_BYTES = 24 * KiB;
struct Args { const float* in[14]; float* out; unsigned char* ws; };

template <class CM>
__device__ __forceinline__ void tr_item(const float* W, int K, int N, bf16* WT, const float* kscale, LAS float* scr, int item, int lane, CM cmap) {
    const int nblk = N / 32, kb = item / nblk, nb = item % nblk, k0 = 64 * kb, n0 = 32 * nb;
    const int src = cmap(n0 + (lane & 31));
    float tv[32];
#pragma unroll
    for (int i = 0; i < 32; ++i) tv[i] = W[(size_t)(k0 + 2 * i + (lane >> 5)) * N + src];
#pragma unroll
    for (int i = 0; i < 32; ++i) { const int kk = 2 * i + (lane >> 5); float v = tv[i]; if (kscale) v *= kscale[k0 + kk]; scr[kk * 33 + (lane & 31)] = v; }
    asm volatile("s_waitcnt lgkmcnt(0)" ::: "memory");
    const int c = lane & 7;
#pragma unroll
    for (int j = 0; j < 4; ++j) { const int n = (lane >> 3) + 8 * j; const LAS float* s = scr + (8 * c) * 33 + n;
        v4u o; o.x = pk2(s[0 * 33], s[1 * 33]); o.y = pk2(s[2 * 33], s[3 * 33]); o.z = pk2(s[4 * 33], s[5 * 33]); o.w = pk2(s[6 * 33], s[7 * 33]);
        *(v4u*)(WT + (size_t)(n0 + n) * K + k0 + 8 * c) = o; }
    asm volatile("s_waitcnt lgkmcnt(0)" ::: "memory");
}
struct CmId { __device__ __forceinline__ int operator()(int n) const { return n; } };
struct CmIn {
    __device__ __forceinline__ int operator()(int n) const {
        if (n < 1536 || n >= 3584) return n;
        const int q = n - 1536, j = q >> 8, cl = q & 255;
        const int sel = 2 * (cl >> 7) + ((cl >> 2) & 1), ch = 64 * j + 16 * ((cl >> 5) & 3) + 4 * ((cl >> 3) & 3) + (cl & 3);
        return 1536 + 512 * sel + ch;
    }
};

struct HgOps { s16x4 vb[2]; s16x4 ka[8]; f32x4 g[8]; };
__device__ __forceinline__ void hg_load(HgOps& o, const bf16* KT, const bf16* VTt, const float* G, unsigned cb, int vq, int lm, int kq) {
#pragma unroll
    for (int vt = 0; vt < 2; ++vt) o.vb[vt] = *(const s16x4*)(VTt + (unsigned)((cb + 32 * vq + 16 * vt + lm) * 16 + 4 * kq));
#pragma unroll
    for (int kt = 0; kt < 8; ++kt) { o.ka[kt] = *(const s16x4*)(KT + (unsigned)((cb + 16 * kt + lm) * 16 + 4 * kq)); o.g[kt] = *(const f32x4*)(G + (unsigned)(cb + 16 * kt + 4 * kq)); }
}
template <bool TRACKD>
__device__ __forceinline__ void hg_apply(f32x4 (&S)[8][2], f32x4 (&Dp)[8], const HgOps& o) {
#pragma unroll
    for (int kt = 0; kt < 8; ++kt) {
#pragma unroll
        for (int vt = 0; vt < 2; ++vt) { S[kt][vt] = __builtin_amdgcn_mfma_f32_16x16x16bf16_1k(o.ka[kt], o.vb[vt], S[kt][vt], 0, 0, 0); S[kt][vt] = S[kt][vt] * o.g[kt]; }
        if (TRACKD) Dp[kt] = Dp[kt] * o.g[kt];
    }
}
template <bool TRACKD>
__device__ __forceinline__ void hg_update(f32x4 (&S)[8][2], f32x4 (&Dp)[8], const bf16* KT, const bf16* VTt, const float* G, unsigned cb, int vq, int lm, int kq) {
    HgOps o; hg_load(o, KT, VTt, G, cb, vq, lm, kq); hg_apply<TRACKD>(S, Dp, o);
}

__global__ void __launch_bounds__(NWAVES * 64, 2) mk_fwd(Args args) {
    extern __shared__ __attribute__((aligned(16))) unsigned char lds_raw[];
    LAS unsigned char* lds = (LAS unsigned char*)lds_raw;
    const int tid = threadIdx.x, lane = tid & 63, wave = __builtin_amdgcn_readfirstlane(tid >> 6);
    const int G = gridDim.x, bx = blockIdx.x;
    const int gw = bx * NWAVES + wave, NGW = G * NWAVES;
    const int lm = lane & 15, kq = lane >> 4;
    unsigned char* ws = args.ws;
    if (tid < 16) ((LAS unsigned*)(lds + LDS_CTL))[tid] = 0u;
    __syncthreads();
    const XcdBarrier bar = xcd_barrier_post((unsigned*)(ws + WS_BAR), (volatile LAS unsigned*)(lds + LDS_CTL + 32));
    if (tid == 0) ((LAS unsigned*)(lds + LDS_CTL))[0] = xb_add((unsigned*)(ws + WS_BAR) + 3520 + 64 * bar.x, 1u);
    __syncthreads();
    const unsigned my_rank = ((volatile LAS unsigned*)(lds + LDS_CTL))[0];
    const float* x = args.in[0]; const float* meta = args.in[1]; const float* w_in = args.in[2]; const float* w_na = args.in[3]; const float* w_hg = args.in[4];
    const float* w_o = args.in[5]; const float* w_up = args.in[6]; const float* w_dn = args.in[7]; const float* g_mix = args.in[8]; const float* g_mlp = args.in[9];
    const float* g_fin = args.in[10]; const float* hg_gain = args.in[11]; const float* rpb = args.in[12]; const float* lb_logits = args.in[13];
    float* out = args.out;
    float* ssq1 = (float*)(ws + WS_SSQ1); float* ssq2 = (float*)(ws + WS_SSQ2);
    bf16* KNAm = (bf16*)(ws + WS_KNAM); bf16* VTm = (bf16*)(ws + WS_VTM); bf16* KFTm = (bf16*)(ws + WS_KFTM); bf16* VHTm = (bf16*)(ws + WS_VHTM);
    float* GFm = (float*)(ws + WS_GFM); float* LB = (float*)(ws + WS_LB); float* DSEG = (float*)(ws + WS_DSEG);
    bf16* WT_in = (bf16*)(ws + WS_WIN); bf16* WT_na = (bf16*)(ws + WS_WNA); bf16* WT_hg = (bf16*)(ws + WS_WHG); bf16* WT_o = (bf16*)(ws + WS_WO); bf16* WT_up = (bf16*)(ws + WS_WUP); bf16* WT_dn = (bf16*)(ws + WS_WDN);
    bf16* XN = (bf16*)(ws + WS_XN); float* SBUF = (float*)(ws + WS_XN); bf16* H1B = (bf16*)(ws + WS_XN);
    bf16* QNA = (bf16*)(ws + WS_QNA); bf16* KNA = (bf16*)(ws + WS_KNA); bf16* VT = (bf16*)(ws + WS_VT); bf16* QF = (bf16*)(ws + WS_QF); bf16* QB = (bf16*)(ws + WS_QB);
    bf16* KF = (bf16*)(ws + WS_KF); bf16* KFT = (bf16*)(ws + WS_KFT); bf16* KB = (bf16*)(ws + WS_KB); bf16* KBT = (bf16*)(ws + WS_KBT); bf16* VHT = (bf16*)(ws + WS_VHT);
    bf16* GHG = (bf16*)(ws + WS_GHG); float* GF = (float*)(ws + WS_GF); float* GB = (float*)(ws + WS_GB);
    bf16* SNA = (bf16*)out; bf16* SHG = (bf16*)out + (size_t)M * D;
    bf16* ONA = QNA; bf16* OHG = (bf16*)(ws + WS_OHG); bf16* Tb = (bf16*)(ws + WS_T); bf16* MIX = (bf16*)(ws + WS_MIX); bf16* U = (bf16*)(ws + WS_U);

    {
        {
            LAS float* mT = (LAS float*)lds;
            LAS float* red = (LAS float*)(lds + 65536);
            LAS float* fin = (LAS float*)(lds + 65536 + 32768);
#pragma unroll
            for (int rr = 0; rr < 2; ++rr) { const int r = 2 * wave + rr; const float* mr = meta + (size_t)r * D;
                f32x4 v[4]; float s = 0.f;
#pragma unroll
                for (int j = 0; j < 4; ++j) { v[j] = *(const f32x4*)(mr + 4 * lane + 256 * j); s += (v[j].x * v[j].x + v[j].y * v[j].y) + (v[j].z * v[j].z + v[j].w * v[j].w); }
                const float rs = rsqrtf(wave_sum(s) * (1.0f / D) + EPS);
#pragma unroll
                for (int j = 0; j < 4; ++j) { const f32x4 g = *(const f32x4*)(g_mix + 4 * lane + 256 * j); const int k = 4 * lane + 256 * j;
                    mT[(k + 0) * 16 + r] = v[j].x * rs * g.x; mT[(k + 1) * 16 + r] = v[j].y * rs * g.y; mT[(k + 2) * 16 + r] = v[j].z * rs * g.z; mT[(k + 3) * 16 + r] = v[j].w * rs * g.w; } }
            __syncthreads();
            for (int cbk = bx; cbk < 256; cbk += G) {
                const int c = tid & 7, ks = tid >> 3, grp = cbk >> 6, cl0 = (cbk & 63) * 8;
                const int src = (grp == 0 ? 512 : grp == 1 ? 1024 : grp == 2 ? 2048 : 3072) + cl0 + c;
                float a[16];
#pragma unroll
                for (int r = 0; r < 16; ++r) a[r] = 0.f;
                float wv[16];
#pragma unroll
                for (int kk = 0; kk < 16; ++kk) wv[kk] = w_in[(size_t)(ks * 16 + kk) * NIN + src];
#pragma unroll
                for (int kk = 0; kk < 16; ++kk) { const int k = ks * 16 + kk; const float w = wv[kk];
                    const f32x4 m0 = *(const LAS f32x4*)(mT + k * 16), m1 = *(const LAS f32x4*)(mT + k * 16 + 4), m2 = *(const LAS f32x4*)(mT + k * 16 + 8), m3 = *(const LAS f32x4*)(mT + k * 16 + 12);
                    a[0] += w * m0.x; a[1] += w * m0.y; a[2] += w * m0.z; a[3] += w * m0.w; a[4] += w * m1.x; a[5] += w * m1.y; a[6] += w * m1.z; a[7] += w * m1.w;
                    a[8] += w * m2.x; a[9] += w * m2.y; a[10] += w * m2.z; a[11] += w * m2.w; a[12] += w * m3.x; a[13] += w * m3.y; a[14] += w * m3.z; a[15] += w * m3.w; }
#pragma unroll
                for (int r = 0; r < 16; ++r) red[(ks * 16 + r) * 8 + c] = a[r];
                __syncthreads();
                if (tid < 128) { float s = 0.f;
                    for (int q = 0; q < 64; ++q) s += red[q * 128 + tid];
                    fin[tid] = s; }
                __syncthreads();
                if (tid < 8) { const int cl = cl0 + tid;
#pragma unroll
                    for (int r = 0; r < 16; ++r) a[r] = fin[r * 8 + tid];
                    if (grp == 0) {
#pragma unroll
                        for (int r = 0; r < 16; ++r) KNAm[r * 512 + cl] = f2bf(a[r]);
                    } else if (grp == 1) { const int h = cl >> 6, d = cl & 63;
#pragma unroll
                        for (int r = 0; r < 16; ++r) VTm[(h * 64 + d) * 16 + r] = f2bf(a[r]);
                    } else if (grp == 2) {
                        const float l0 = lb_logits[cl], l1 = lb_logits[512 + cl]; const float lb = 1.0f / (1.0f + expf(l1 - l0));
                        float bsum = 0.f;
#pragma unroll
                        for (int r = 0; r < 16; ++r) { const float f = lb + (1.0f - lb) / (1.0f + expf(-a[r])); bsum += logf(f); KFTm[cl * 16 + r] = f2bf((1.0f - f) * expf(-bsum)); }
                        GFm[cl] = expf(bsum);
                    } else {
#pragma unroll
                        for (int r = 0; r < 16; ++r) VHTm[cl * 16 + r] = f2bf(a[r]);
                    }
                }
                __syncthreads();
            }
        }
        if (bx == 32 % G) {
            for (int i = tid; i < 1024; i += NWAVES * 64) { const int dir = i >> 9, c = i & 511; const float l0 = lb_logits[dir * 1024 + c], l1 = lb_logits[dir * 1024 + 512 + c]; LB[i] = 1.0f / (1.0f + expf(l1 - l0)); }
        }
        LAS float* scr = (LAS float*)(lds + wave * 16384);
        constexpr int I_IN = (D / 64) * (NIN / 32), I_NA = (512 / 64) * (D / 32), I_O = (D / 64) * (D / 32), I_UP = (D / 64) * (FF / 32), I_DN = (FF / 64) * (D / 32);
        constexpr int NITEMS = I_IN + 2 * I_NA + I_O + I_UP + I_DN;
        for (int it = gw; it < NITEMS; it += NGW) {
            int r = it;
            if (r < I_IN) { tr_item(w_in, D, NIN, WT_in, (const float*)nullptr, scr, r, lane, CmIn()); continue; } r -= I_IN;
            if (r < I_NA) { tr_item(w_na, 512, D, WT_na, (const float*)nullptr, scr, r, lane, CmId()); continue; } r -= I_NA;
            if (r < I_NA) { tr_item(w_hg, 512, D, WT_hg, (const float*)nullptr, scr, r, lane, CmId()); continue; } r -= I_NA;
            if (r < I_O) { tr_item(w_o, D, D, WT_o, (const float*)nullptr, scr, r, lane, CmId()); continue; } r -= I_O;
            if (r < I_UP) { tr_item(w_up, D, FF, WT_up, g_mlp, scr, r, lane, CmId()); continue; } r -= I_UP;
            tr_item(w_dn, FF, D, WT_dn, (const float*)nullptr, scr, r, lane, CmId());
        }
        for (int m0 = gw; m0 < M; m0 += 4 * NGW) {
            f32x4 v[4][4];
#pragma unroll
            for (int q = 0; q < 4; ++q)
#pragma unroll
                for (int j = 0; j < 4; ++j) v[q][j] = *(const f32x4*)(x + (size_t)(m0 + q * NGW) * D + 4 * lane + 256 * j);
#pragma unroll
            for (int q = 0; q < 4; ++q) { const int m = m0 + q * NGW; float s = 0.f;
#pragma unroll
                for (int j = 0; j < 4; ++j) s += (v[q][j].x * v[q][j].x + v[q][j].y * v[q][j].y) + (v[q][j].z * v[q][j].z + v[q][j].w * v[q][j].w);
                const float rs = rsqrtf(wave_sum(s) * (1.0f / D) + EPS);
#pragma unroll
                for (int j = 0; j < 4; ++j) { const f32x4 g = *(const f32x4*)(g_mix + 4 * lane + 256 * j);
                    v2u o; o.x = pk2(v[q][j].x * rs * g.x, v[q][j].y * rs * g.y); o.y = pk2(v[q][j].z * rs * g.z, v[q][j].w * rs * g.w);
                    *(v2u*)(XN + (size_t)m * D + 4 * lane + 256 * j) = o; } } }
    }
    xcd_barrier(bar);

    int vb = bx; bool xl = false;
    { const unsigned nloc = ((volatile LAS unsigned*)(lds + LDS_CTL + 32))[0], nx = ((volatile LAS unsigned*)(lds + LDS_CTL + 32))[1];
      bool even = (G == 256 && nloc == 32u && nx == 8u && bar.x < 8u && my_rank < 32u);
#pragma unroll
      for (int j = 0; j < 8; ++j) even = even && (xb_ld((unsigned*)(ws + WS_BAR) + XB_XCNT(j)) == 32u);
      if (even) { vb = (int)(my_rank * 8u + bar.x); xl = true; } }
    vb = __builtin_amdgcn_readfirstlane(vb);
#define PHASE_BAR() do { if (xl) xcd_local_barrier(bar); else xcd_barrier(bar); } while (0)
    const int xq = vb & 7, rk = vb >> 3, lw = rk * 8 + wave;
#define MK_EPI(NAME, MODE) pg8::EpiAll<MODE> NAME; NAME.ws = ws; NAME.out = out; NAME.x = x; NAME.gain = hg_gain; NAME.gfin = g_fin;
    {
        MK_EPI(E, pg8::EM_IN)
        pg8::Gemm g{XN, WT_in, M, NIN, D}; pg8::StaticOrder S; S.init(M, NIN, G, vb);
        pg8::gemm_phase<pg8::EpiAll<pg8::EM_IN>, pg8::StaticOrder, true, true>(lds, g, S, E);
    }
    PHASE_BAR();

    { const int wi = xq * 256 + lw;
        const int item = wi >> 2, vq = wi & 3, seg = item & 7, dir = (item >> 3) & 1, h = (item >> 4) & 3, b = item >> 6;
        f32x4 S[8][2], Dp[8];
#pragma unroll
        for (int kt = 0; kt < 8; ++kt) { S[kt][0] = (f32x4){0.f, 0.f, 0.f, 0.f}; S[kt][1] = (f32x4){0.f, 0.f, 0.f, 0.f}; Dp[kt] = (f32x4){1.f, 1.f, 1.f, 1.f}; }
        if (dir == 0 && seg == 0) hg_update<false>(S, Dp, KFTm, VHTm, GFm, (unsigned)(h * 128), vq, lm, kq);
        const bf16* KTp = dir ? KBT : KFT; const float* Gp = dir ? GB : GF;
        const int cstep = dir ? -512 : 512; const int cb0 = (b * 128 + seg * 16 + (dir ? 15 : 0)) * 512 + h * 128;
        {
            LAS unsigned char* stg0 = lds + (wave >> 2) * 9216;
            s16x4 kv[2][2], vbn[2][2], vbr[2][2]; v2u g8 = (v2u){0u, 0u};
#define B1_LOADS(IT) do { _Pragma("unroll") for (int u = 0; u < 2; ++u) { const unsigned cb_ = (unsigned)(cb0 + (2 * (IT) + u) * cstep); \
                _Pragma("unroll") for (int kk = 0; kk < 2; ++kk) kv[u][kk] = *(const s16x4*)(KTp + (unsigned)((cb_ + 16 * (2 * vq + kk) + lm) * 16 + 4 * kq)); \
                _Pragma("unroll") for (int vt = 0; vt < 2; ++vt) vbn[u][vt] = *(const s16x4*)(VHT + (unsigned)((cb_ + 32 * vq + 16 * vt + lm) * 16 + 4 * kq)); \
                if (vq == u) g8 = *(const v2u*)(Gp + cb_ + 2 * lane); } } while (0)
#define B1_STORE(STG) do { _Pragma("unroll") for (int u = 0; u < 2; ++u) { \
                _Pragma("unroll") for (int kk = 0; kk < 2; ++kk) *(LAS s16x4*)((STG) + (u * 8 + 2 * vq + kk) * 512 + lane * 8) = kv[u][kk]; \
                if (vq == u) *(LAS v2u*)((STG) + 8192 + u * 512 + lane * 8) = g8; } } while (0)
            __syncthreads();
            B1_LOADS(0);
            B1_STORE(stg0);
#pragma unroll
            for (int u = 0; u < 2; ++u) { vbr[u][0] = vbn[u][0]; vbr[u][1] = vbn[u][1]; }
            for (int it = 0; it < 8; ++it) {
                __syncthreads();
                LAS unsigned char* stg = stg0 + (it & 1) * 18432;
                if (it < 7) B1_LOADS(it + 1);
                __builtin_amdgcn_sched_barrier(0);
#pragma unroll
                for (int u = 0; u < 2; ++u)
#pragma unroll
                    for (int kt = 0; kt < 8; ++kt) { const s16x4 ka = *(const LAS s16x4*)(stg + (u * 8 + kt) * 512 + lane * 8); const f32x4 g = *(const LAS f32x4*)(stg + 8192 + u * 512 + (16 * kt + 4 * kq) * 4);
#pragma unroll
                        for (int vt = 0; vt < 2; ++vt) { S[kt][vt] = __builtin_amdgcn_mfma_f32_16x16x16bf16_1k(ka, vbr[u][vt], S[kt][vt], 0, 0, 0); S[kt][vt] = S[kt][vt] * g; } }
                __builtin_amdgcn_sched_barrier(0);
                if (it < 7) { B1_STORE(stg0 + ((it + 1) & 1) * 18432);
#pragma unroll
                    for (int u = 0; u < 2; ++u) { vbr[u][0] = vbn[u][0]; vbr[u][1] = vbn[u][1]; } }
            }
#undef B1_LOADS
#undef B1_STORE
        }
        float* sp = SBUF + ((size_t)(item * 4 + vq) * 16) * 256 + lane * 4;
#pragma unroll
        for (int kt = 0; kt < 8; ++kt) { *(f32x4*)(sp + (kt * 2 + 0) * 256) = S[kt][0]; *(f32x4*)(sp + (kt * 2 + 1) * 256) = S[kt][1]; }
        if (vq == 0) {
#pragma unroll
            for (int kt = 0; kt < 8; ++kt) Dp[kt] = (f32x4){1.f, 1.f, 1.f, 1.f};
            for (int i = 0; i < 16; ++i) { const float* gp = Gp + (unsigned)(cb0 + i * cstep + 4 * kq);
#pragma unroll
                for (int kt = 0; kt < 8; ++kt) Dp[kt] = Dp[kt] * *(const f32x4*)(gp + 16 * kt); }
            if (lm == 0) {
#pragma unroll
                for (int kt = 0; kt < 8; ++kt) *(f32x4*)(DSEG + item * 128 + 16 * kt + 4 * kq) = Dp[kt];
            }
        }
    }
    PHASE_BAR();

    for (int i2 = 0; i2 < 2; ++i2) { const int tl = rk * 512 + tid + 16384 * i2;
        const int bhd = xq * 8 + (tl >> 12), e4 = tl & 4095, dir = bhd & 1; const int kt = (e4 >> 7) & 7, ln = e4 & 63; const int k0 = 16 * kt + 4 * (ln >> 4);
        f32x4 carry = (f32x4){0.f, 0.f, 0.f, 0.f}, locv[8], dv[8];
#pragma unroll
        for (int s = 0; s < 8; ++s) { const int seg = dir ? 7 - s : s, item = bhd * 8 + seg;
            locv[s] = *(const f32x4*)(SBUF + (size_t)item * 16384 + e4 * 4); dv[s] = *(const f32x4*)(DSEG + item * 128 + k0); }
#pragma unroll
        for (int s = 0; s < 8; ++s) { const int seg = dir ? 7 - s : s, item = bhd * 8 + seg;
            *(f32x4*)(SBUF + (size_t)item * 16384 + e4 * 4) = carry; carry = dv[s] * carry + locv[s]; }
    }
    {
        LAS float* rp = (LAS float*)lds;
        __syncthreads();
        for (int i = tid; i < 8 * 465; i += NWAVES * 64) rp[i] = rpb[i];
        __syncthreads();
        LAS unsigned char* KS = lds + 15360; LAS unsigned char* VS = lds + 15360 + 73728;
        int prev_hi = -1;
        for (int i4 = 0; i4 < 4; ++i4) {
            const int hh = rk >> 2, rg = rk & 3, rpair = 8 * rg + 2 * i4;
            const int cq = wave & 3, r = rpair + (wave >> 2), h = hh, b = xq;
            const int lo = min(max(rpair - 4, 0), 24);
            __syncthreads();
            { const int c = tid >> 3, q = tid & 7;
              if (i4 == 0) {
                v4u kreg[9], vreg[9];
#pragma unroll
                for (int e9 = 0; e9 < 9; ++e9) { const int row = min(lo + e9, 31);
                    kreg[e9] = *(const v4u*)(KNA + ((size_t)b * SEQ + row * 64 + c) * 512 + h * 64 + q * 8);
                    vreg[e9] = *(const v4u*)(VT + ((((size_t)(b * 8 + h) * 32 + row) * 64 + c) * 64 + q * 8)); }
#pragma unroll
                for (int e9 = 0; e9 < 9; ++e9) { const int kk = ((lo + e9) % 9) * 64 + c;
                    *(LAS v4u*)(KS + kk * 128 + ((q ^ (kk & 7)) * 16)) = kreg[e9]; *(LAS v4u*)(VS + kk * 128 + ((q ^ (kk & 7)) * 16)) = vreg[e9]; }
              } else {
                v4u kreg[2], vreg[2];
#pragma unroll
                for (int e2 = 0; e2 < 2; ++e2) { const int row = min(prev_hi + 1 + e2, 31);
                    kreg[e2] = *(const v4u*)(KNA + ((size_t)b * SEQ + row * 64 + c) * 512 + h * 64 + q * 8);
                    vreg[e2] = *(const v4u*)(VT + ((((size_t)(b * 8 + h) * 32 + row) * 64 + c) * 64 + q * 8)); }
#pragma unroll
                for (int e2 = 0; e2 < 2; ++e2) { const int row = prev_hi + 1 + e2;
                    if (row <= lo + 8 && row < 32) { const int kk = (row % 9) * 64 + c;
                        *(LAS v4u*)(KS + kk * 128 + ((q ^ (kk & 7)) * 16)) = kreg[e2]; *(LAS v4u*)(VS + kk * 128 + ((q ^ (kk & 7)) * 16)) = vreg[e2]; } }
              }
            }
            prev_hi = lo + 8;
            __syncthreads();
            const int c0 = 16 * cq, kc0 = (cq == 0) ? 0 : (cq == 1) ? 8 : (cq == 2) ? 24 : 32;
            const int rs0 = min(max(r - 4, 0), 24);
            const size_t rowq = (size_t)b * SEQ + r * 64 + c0 + lm;
            bf16x8 qf[2], kmf[2]; s16x4 vmf[4];
#pragma unroll
            for (int ks = 0; ks < 2; ++ks) { qf[ks] = *(const bf16x8*)(QNA + rowq * 512 + h * 64 + 32 * ks + 8 * kq); kmf[ks] = *(const bf16x8*)(KNAm + lm * 512 + h * 64 + 32 * ks + 8 * kq); }
#pragma unroll
            for (int dt = 0; dt < 4; ++dt) vmf[dt] = *(const s16x4*)(VTm + (h * 64 + 16 * dt + lm) * 16 + 4 * kq);
            const int cqq = c0 + lm, cs = min(max(cqq - 8, 0), 48);
            f32x4 oa[4];
#pragma unroll
            for (int dt = 0; dt < 4; ++dt) oa[dt] = (f32x4){0.f, 0.f, 0.f, 0.f};
            float mrun = -3.0e38f, lsum = 0.f;
#pragma unroll
            for (int hf = 0; hf < 2; ++hf) {
                f32x4 sc[9]; bf16x8 vf[4][4];
                {   bf16x8 kf[4][2][2];
#pragma unroll
                    for (int j4 = 0; j4 < 4; ++j4)
#pragma unroll
                        for (int t = 0; t < 2; ++t) { const int kcol = kc0 + 8 * (lm >> 2) + 4 * t + (lm & 3); const size_t rowk = (size_t)b * SEQ + (rs0 + 4 * hf + j4) * 64 + kcol;
#pragma unroll
                            for (int ks = 0; ks < 2; ++ks) { const int kk = ((rs0 + 4 * hf + j4) % 9) * 64 + kcol; kf[j4][t][ks] = *(const LAS bf16x8*)(KS + kk * 128 + (((ks * 4 + kq) ^ (kk & 7)) * 16)); } (void)rowk; }
                    __builtin_amdgcn_sched_barrier(0);
#pragma unroll
                    for (int j4 = 0; j4 < 4; ++j4)
#pragma unroll
                        for (int t = 0; t < 2; ++t) { f32x4 a = (f32x4){0.f, 0.f, 0.f, 0.f};
#pragma unroll
                            for (int ks = 0; ks < 2; ++ks) a = __builtin_amdgcn_mfma_f32_16x16x32_bf16(kf[j4][t][ks], qf[ks], a, 0, 0, 0);
                            sc[2 * j4 + t] = a; }
                }
                __builtin_amdgcn_sched_barrier(0);
#pragma unroll
                for (int j4 = 0; j4 < 4; ++j4)
#pragma unroll
                    for (int dt = 0; dt < 4; ++dt) { const int vv = ((rs0 + 4 * hf + j4) % 9) * 64 + 16 * dt + lm; vf[j4][dt] = *(const LAS bf16x8*)(VS + vv * 128 + ((((kc0 >> 3) + kq) ^ (vv & 7)) * 16)); }
                __builtin_amdgcn_sched_barrier(0);
                if (hf == 1) { f32x4 a = (f32x4){0.f, 0.f, 0.f, 0.f};
#pragma unroll
                    for (int ks = 0; ks < 2; ++ks) a = __builtin_amdgcn_mfma_f32_16x16x32_bf16(kmf[ks], qf[ks], a, 0, 0, 0);
                    sc[8] = a; } else sc[8] = (f32x4){-1e30f, -1e30f, -1e30f, -1e30f};
                float mx = -3.0e38f;
#pragma unroll
                for (int j4 = 0; j4 < 4; ++j4)
#pragma unroll
                    for (int t = 0; t < 2; ++t)
#pragma unroll
                        for (int j = 0; j < 4; ++j) { const int kcol = kc0 + 8 * kq + 4 * t + j; const bool inw = (kcol >= cs) && (kcol < cs + 16);
                            const int dr = rs0 + 4 * hf + j4 - r, dc = min(max(kcol - cqq, -15), 15);
                            const float bias = rp[h * 465 + (dr + 7) * 31 + dc + 15];
                            const float s = inw ? sc[2 * j4 + t][j] + bias : -1e30f; sc[2 * j4 + t][j] = s; mx = fmaxf(mx, s); }
#pragma unroll
                for (int j = 0; j < 4; ++j) mx = fmaxf(mx, sc[8][j]);
                mx = fmaxf(mx, __shfl_xor(mx, 16)); mx = fmaxf(mx, __shfl_xor(mx, 32));
                const float mnew = fmaxf(mrun, mx), alpha = __expf(mrun - mnew);
                mrun = mnew; lsum *= alpha;
#pragma unroll
                for (int dt = 0; dt < 4; ++dt) oa[dt] = oa[dt] * alpha;
#pragma unroll
                for (int i = 0; i < 9; ++i)
#pragma unroll
                    for (int j = 0; j < 4; ++j) { const float p = __expf(sc[i][j] - mnew); sc[i][j] = p; lsum += p; }
#pragma unroll
                for (int j4 = 0; j4 < 4; ++j4) {
                    union { bf16x8 v; unsigned u[4]; } pf;
                    pf.u[0] = cvt_pk_bf16(sc[2 * j4][0], sc[2 * j4][1]); pf.u[1] = cvt_pk_bf16(sc[2 * j4][2], sc[2 * j4][3]);
                    pf.u[2] = cvt_pk_bf16(sc[2 * j4 + 1][0], sc[2 * j4 + 1][1]); pf.u[3] = cvt_pk_bf16(sc[2 * j4 + 1][2], sc[2 * j4 + 1][3]);
#pragma unroll
                    for (int dt = 0; dt < 4; ++dt) oa[dt] = __builtin_amdgcn_mfma_f32_16x16x32_bf16(vf[j4][dt], pf.v, oa[dt], 0, 0, 0); }
                if (hf == 1) { union { s16x4 v; unsigned u[2]; } pm; pm.u[0] = cvt_pk_bf16(sc[8][0], sc[8][1]); pm.u[1] = cvt_pk_bf16(sc[8][2], sc[8][3]);
#pragma unroll
                    for (int dt = 0; dt < 4; ++dt) oa[dt] = __builtin_amdgcn_mfma_f32_16x16x16bf16_1k(vmf[dt], pm.v, oa[dt], 0, 0, 0); }
            }
            lsum += __shfl_xor(lsum, 16); lsum += __shfl_xor(lsum, 32);
            const float inv = 1.0f / lsum;
#pragma unroll
            for (int dt = 0; dt < 4; ++dt) { v2u o; o.x = cvt_pk_bf16(oa[dt][0] * inv, oa[dt][1] * inv); o.y = cvt_pk_bf16(oa[dt][2] * inv, oa[dt][3] * inv);
                *(v2u*)(ONA + rowq * 512 + h * 64 + 16 * dt + 4 * kq) = o; }
        }
        __syncthreads();
    }
    PHASE_BAR();

    { const int it = xq * 32 + rk;
        const int seg = it & 7, h = (it >> 3) & 3, b = it >> 5;
        const int dir = wave >> 2, vq = wave & 3, sitem = ((b * 4 + h) * 2 + dir) * 8 + seg;
        LAS unsigned short* ob = (LAS unsigned short*)lds;
        LAS unsigned char* stg0 = lds + 65536 + dir * 17408;
        __syncthreads();
        f32x4 S[8][2], Dp[8];
        { const float* sp = SBUF + ((size_t)(sitem * 4 + vq) * 16) * 256 + lane * 4;
#pragma unroll
          for (int kt = 0; kt < 8; ++kt) { S[kt][0] = *(const f32x4*)(sp + (kt * 2 + 0) * 256); S[kt][1] = *(const f32x4*)(sp + (kt * 2 + 1) * 256); Dp[kt] = (f32x4){1.f, 1.f, 1.f, 1.f}; } }
        if (dir == 0 && seg == 0) hg_update<false>(S, Dp, KFTm, VHTm, GFm, (unsigned)(h * 128), vq, lm, kq);
        const bf16* Qn = dir ? QB : QF; const bf16* Kn = dir ? KB : KF; const bf16* KTp = dir ? KBT : KFT; const float* Gp = dir ? GB : GF;
        {
            LAS v2u* PA = (LAS v2u*)(lds + 135168);
            bf16x8 kn4[4][4], qn4[4][4];
#pragma unroll
            for (int q = 0; q < 4; ++q) { const size_t r0 = ((size_t)b * 128 + seg * 16 + vq + 4 * q) * 16;
#pragma unroll
                for (int ii = 0; ii < 4; ++ii) { const size_t o = (r0 + lm) * 512 + h * 128 + 32 * ii + 8 * kq; kn4[q][ii] = *(const bf16x8*)(Kn + o); qn4[q][ii] = *(const bf16x8*)(Qn + o); } }
#pragma unroll
            for (int q = 0; q < 4; ++q) { f32x4 at = (f32x4){0.f, 0.f, 0.f, 0.f};
#pragma unroll
                for (int ii = 0; ii < 4; ++ii) at = __builtin_amdgcn_mfma_f32_16x16x32_bf16(kn4[q][ii], qn4[q][ii], at, 0, 0, 0);
#pragma unroll
                for (int j = 0; j < 4; ++j) { const int s = 4 * kq + j; const bool keep = dir ? (s >= lm) : (s <= lm); at[j] = keep ? at[j] : 0.f; }
                v2u w; w.x = cvt_pk_bf16(at[0], at[1]); w.y = cvt_pk_bf16(at[2], at[3]);
                PA[(dir * 16 + vq + 4 * q) * 64 + lane] = w; }
        }
        __syncthreads();
        s16x4 qv[2][2], kv[2][2], vbn[2][2]; v2u g8 = (v2u){0u, 0u};
#define B3_LOADS(IT) do { _Pragma("unroll") for (int u = 0; u < 2; ++u) { const int cl_ = dir ? 15 - (2 * (IT) + u) : 2 * (IT) + u; const size_t cgi_ = (size_t)b * 128 + seg * 16 + cl_, row0_ = cgi_ * 16; const unsigned cb_ = (unsigned)(cgi_ * 512 + h * 128); \
            _Pragma("unroll") for (int kk = 0; kk < 2; ++kk) { const int kt_ = 2 * vq + kk; \
                qv[u][kk] = *(const s16x4*)(Qn + (row0_ + lm) * 512 + h * 128 + 16 * kt_ + 4 * kq); \
                kv[u][kk] = *(const s16x4*)(KTp + (unsigned)((cb_ + 16 * kt_ + lm) * 16 + 4 * kq)); } \
            _Pragma("unroll") for (int vt = 0; vt < 2; ++vt) vbn[u][vt] = *(const s16x4*)(VHT + (unsigned)((cb_ + 32 * vq + 16 * vt + lm) * 16 + 4 * kq)); \
            if (vq == u) g8 = *(const v2u*)(Gp + cb_ + 2 * lane); } } while (0)
#define B3_STORE(STG) do { _Pragma("unroll") for (int u = 0; u < 2; ++u) { \
            _Pragma("unroll") for (int kk = 0; kk < 2; ++kk) { const int f_ = u * 8 + 2 * vq + kk; \
                *(LAS s16x4*)((STG) + f_ * 512 + lane * 8) = qv[u][kk]; *(LAS s16x4*)((STG) + 8192 + f_ * 512 + lane * 8) = kv[u][kk]; } \
            if (vq == u) *(LAS v2u*)((STG) + 16384 + u * 512 + lane * 8) = g8; } } while (0)
        B3_LOADS(0);
        B3_STORE(stg0);
        s16x4 vbr[2][2];
#pragma unroll
        for (int u = 0; u < 2; ++u) { vbr[u][0] = vbn[u][0]; vbr[u][1] = vbn[u][1]; }
        for (int it = 0; it < 8; ++it) {
            __syncthreads();
            LAS unsigned char* stg = stg0 + (it & 1) * 34816;
            if (it < 7) B3_LOADS(it + 1);
            __builtin_amdgcn_sched_barrier(0);
#pragma unroll
            for (int u = 0; u < 2; ++u) { const int cl = dir ? 15 - (2 * it + u) : 2 * it + u;
                union { s16x4 v; v2u u2; } pa; pa.u2 = ((const LAS v2u*)(lds + 135168))[(dir * 16 + cl) * 64 + lane];
                f32x4 o2[2]; o2[0] = (f32x4){0.f, 0.f, 0.f, 0.f}; o2[1] = (f32x4){0.f, 0.f, 0.f, 0.f};
#pragma unroll
                for (int kt = 0; kt < 8; ++kt) { const s16x4 q4 = *(const LAS s16x4*)(stg + (u * 8 + kt) * 512 + lane * 8);
#pragma unroll
                    for (int vt = 0; vt < 2; ++vt) { union { s16x4 v; unsigned u[2]; } sb; sb.u[0] = cvt_pk_bf16(S[kt][vt][0], S[kt][vt][1]); sb.u[1] = cvt_pk_bf16(S[kt][vt][2], S[kt][vt][3]);
                        o2[vt] = __builtin_amdgcn_mfma_f32_16x16x16bf16_1k(q4, sb.v, o2[vt], 0, 0, 0); } }
#pragma unroll
                for (int vt = 0; vt < 2; ++vt) { o2[vt] = __builtin_amdgcn_mfma_f32_16x16x16bf16_1k(pa.v, vbr[u][vt], o2[vt], 0, 0, 0);
#pragma unroll
                    for (int j = 0; j < 4; ++j) { LAS unsigned short* op = ob + (16 * cl + 4 * kq + j) * 128 + 32 * vq + 16 * vt + lm;
                        const float val = (it < 4) ? o2[vt][j] : (bflo((unsigned)*op) + o2[vt][j]); *op = f2bf(val); } }
#pragma unroll
                for (int kt = 0; kt < 8; ++kt) { const s16x4 ka = *(const LAS s16x4*)(stg + 8192 + (u * 8 + kt) * 512 + lane * 8); const f32x4 g = *(const LAS f32x4*)(stg + 16384 + u * 512 + (16 * kt + 4 * kq) * 4);
#pragma unroll
                    for (int vt = 0; vt < 2; ++vt) { S[kt][vt] = __builtin_amdgcn_mfma_f32_16x16x16bf16_1k(ka, vbr[u][vt], S[kt][vt], 0, 0, 0); S[kt][vt] = S[kt][vt] * g; } }
            }
            __builtin_amdgcn_sched_barrier(0);
            if (it < 7) { B3_STORE(stg0 + ((it + 1) & 1) * 34816);
#pragma unroll
                for (int u = 0; u < 2; ++u) { vbr[u][0] = vbn[u][0]; vbr[u][1] = vbn[u][1]; } }
        }
#undef B3_LOADS
#undef B3_STORE
        v4u ggp[8];
#pragma unroll
        for (int i = 0; i < 8; ++i) ggp[i] = *(const v4u*)(GHG + ((size_t)b * SEQ + seg * 256 + wave * 32 + 4 * i + kq) * 512 + h * 128 + 8 * lm);
        __syncthreads();
#pragma unroll
        for (int i = 0; i < 8; ++i) { const int tl = wave * 32 + 4 * i + kq; const size_t row = (size_t)b * SEQ + seg * 256 + tl;
            const v4u ov = *(const LAS v4u*)(ob + tl * 128 + 8 * lm);
            const f32x4 v0 = (f32x4){bflo(ov.x), bfhi(ov.x), bflo(ov.y), bfhi(ov.y)}, v1 = (f32x4){bflo(ov.z), bfhi(ov.z), bflo(ov.w), bfhi(ov.w)};
            const v4u gg = ggp[i];
            float s = (v0.x * v0.x + v0.y * v0.y) + (v0.z * v0.z + v0.w * v0.w) + (v1.x * v1.x + v1.y * v1.y) + (v1.z * v1.z + v1.w * v1.w);
            s += __shfl_xor(s, 1); s += __shfl_xor(s, 2); s += __shfl_xor(s, 4); s += __shfl_xor(s, 8);
            const float rs = rsqrtf(s * (1.0f / 128.0f) + EPS);
            v4u o; o.x = cvt_pk_bf16(v0.x * rs * bflo(gg.x), v0.y * rs * bfhi(gg.x)); o.y = cvt_pk_bf16(v0.z * rs * bflo(gg.y), v0.w * rs * bfhi(gg.y));
            o.z = cvt_pk_bf16(v1.x * rs * bflo(gg.z), v1.y * rs * bfhi(gg.z)); o.w = cvt_pk_bf16(v1.z * rs * bflo(gg.w), v1.w * rs * bfhi(gg.w));
            *(v4u*)(OHG + row * 512 + h * 128 + 8 * lm) = o; }
        __syncthreads();
    }
    PHASE_BAR();

    {
        MK_EPI(E, pg8::EM_C1A)
        pg8::Gemm g{ONA, WT_na, 2 * M, 2 * D, 512}; pg8::PairOrder S; S.init(M, D, G, vb);
        pg8::gemm_phase<pg8::EpiAll<pg8::EM_C1A>, pg8::PairOrder, true, true>(lds, g, S, E);
    }
    PHASE_BAR();
    {
        MK_EPI(E, pg8::EM_C2)
        pg8::Gemm g{MIX, WT_o, M, D, D}; pg8::StaticOrder S; S.init(M, D, G, vb);
        pg8::gemm_phase<pg8::EpiAll<pg8::EM_C2>, pg8::StaticOrder, true, true>(lds, g, S, E);
    }
    PHASE_BAR();
    {
        MK_EPI(E, pg8::EM_C3)
        pg8::Gemm g{H1B, WT_up, M, FF, D}; pg8::StaticOrder S; S.init(M, FF, G, vb);
        pg8::gemm_phase<pg8::EpiAll<pg8::EM_C3>, pg8::StaticOrder, true, true>(lds, g, S, E);
    }
    PHASE_BAR();
    {
        MK_EPI(E, pg8::EM_C4)
        pg8::Gemm g{U, WT_dn, M, D, FF}; pg8::StaticOrder S; S.init(M, D, G, vb);
        pg8::gemm_phase<pg8::EpiAll<pg8::EM_C4>, pg8::StaticOrder, true, true>(lds, g, S, E);
    }

}

extern "C" void kernel_launch(void* const* d_in, const int* in_sizes, int n_in, void* d_out, int out_size, void* d_ws, size_t ws_size, hipStream_t stream) {
    static int grid = 0;
    if (grid == 0) {
        if (n_in != 14 || in_sizes[0] != M * D || out_size != M * D || ws_size < WS_END) { fprintf(stderr, "kernel_launch: unexpected shapes / workspace (n_in %d, in0 %d, out %d, ws %zu)\n", n_in, n_in > 0 ? in_sizes[0] : -1, out_size, ws_size); grid = -1; return; }
        int dev = 0, cus = 0, per_cu = 0;
        if (hipGetDevice(&dev) != hipSuccess || hipDeviceGetAttribute(&cus, hipDeviceAttributeMultiprocessorCount, dev) != hipSuccess) { grid = -1; return; }
        if (hipFuncSetAttribute((const void*)mk_fwd, hipFuncAttributeMaxDynamicSharedMemorySize, LDS_BYTES) != hipSuccess) { fprintf(stderr, "kernel_launch: hipFuncSetAttribute failed\n"); grid = -1; return; }
        if (hipOccupancyMaxActiveBlocksPerMultiprocessor(&per_cu, (const void*)mk_fwd, NWAVES * 64, LDS_BYTES) != hipSuccess || per_cu < 1) { fprintf(stderr, "kernel_launch: occupancy query failed (%d)\n", per_cu); (void)hipGetLastError(); per_cu = 1; }
        if (cus != 256) fprintf(stderr, "kernel_launch: built for a 256-CU device (found %d)\n", cus);
        grid = 256;
    }
    if (grid < 0) return;
    Args a{};
    for (int i = 0; i < 14; ++i) a.in[i] = (const float*)d_in[i];
    a.out = (float*)d_out; a.ws = (unsigned char*)d_ws;
    if (hipMemsetAsync((char*)d_ws + WS_BAR, 0, BAR_BYTES, stream) != hipSuccess) { fprintf(stderr, "kernel_launch: memset failed\n"); return; }
    hipLaunchKernelGGL(mk_fwd, dim3(grid), dim3(NWAVES * 64), LDS_BYTES, stream, a);
    const hipError_t e = hipPeekAtLastError();
    if (e != hipSuccess) fprintf(stderr, "kernel_launch: launch failed: %s (grid %d)\n", hipGetErrorName(e), grid);
}
```

```cpp
#include <hip/hip_runtime.h>
#include <cstdio>
#include <cstdint>
constexpr int NWAVES = 8;
constexpr int NB = 8, SEQ = 2048, D = 1024, M = NB * SEQ, NIN = 6144, FF = 4096;
constexpr float EPS = 1e-6f;
constexpr size_t MiB = 1u << 20, KiB = 1024;
constexpr size_t WS_SSQ1 = 245 * MiB, WS_SSQ2 = 246 * MiB,
                WS_KNAM = 128 * KiB, WS_VTM = 144 * KiB, WS_KFTM = 160 * KiB, WS_VHTM = 176 * KiB, WS_GFM = 192 * KiB, WS_LB = 196 * KiB, WS_DSEG = 256 * KiB;
constexpr size_t WS_WIN = 1 * MiB, WS_WNA = 13 * MiB, WS_WHG = 14 * MiB, WS_WO = 15 * MiB, WS_WUP = 17 * MiB, WS_WDN = 237 * MiB;
constexpr size_t WS_XN = 25 * MiB;
constexpr size_t WS_QNA = 57 * MiB, WS_KNA = 73 * MiB, WS_VT = 89 * MiB, WS_QF = 105 * MiB, WS_QB = 121 * MiB, WS_KF = 137 * MiB, WS_KFT = 153 * MiB, WS_KB = 169 * MiB, WS_KBT = 185 * MiB,
                 WS_VHT = 201 * MiB, WS_GHG = 217 * MiB, WS_GF = 233 * MiB, WS_GB = 235 * MiB;
constexpr size_t WS_OHG = WS_KNA;
constexpr size_t WS_T = WS_VT, WS_MIX = WS_KF, WS_U = WS_QNA, WS_END = 247 * MiB;
constexpr int LDS_BYTES = 163840, LDS_CTL = 162816;
constexpr size_t WS_C4CNT = 768 * 1024 + 16 * 1024;

namespace pg8 {
#define PG8_LAS __attribute__((address_space(3)))
typedef unsigned short bf16_t;
typedef short bf16x8 __attribute__((ext_vector_type(8)));
typedef float f32x4 __attribute__((ext_vector_type(4)));
typedef unsigned u32x4 __attribute__((ext_vector_type(4)));
constexpr int BM = 256, BK = 64, HALF = 128, HTB = HALF * BK * 2  , STAGE_BYTES = 8 * HTB, NXCD = 8, WGM = 8;

__host__ __device__ __forceinline__ int lds_byte(int r, int c) { const int st = (r >> 4) * 2 + (c >> 5), rr = r & 15, cc = c & 31, ob = rr * 64 + cc * 2; return st * 1024 + (ob ^ (((ob >> 9) & 1) << 5)); }
__host__ __device__ __forceinline__ void stage_rc(int b, int& R, int& C) { const int st = b / 1024, sb = b % 1024, swz = sb ^ (((sb >> 9) & 1) << 5); R = (st >> 1) * 16 + swz / 64; C = (st & 1) * 32 + (swz % 64) / 2; }
__host__ __device__ __forceinline__ int perm32(int rho) { const int n = rho >> 4, i = rho & 15; return 8 * (i >> 2) + 4 * n + (i & 3); }

struct Unit { int pm, pn; };
struct Gemm { const bf16_t* A; const bf16_t* Bt; int M, N, K; };

struct StaticOrder {
    int nM, nN, nwg, G, c;
    __host__ __device__ void init(int M, int N, int G_, int c_) { nM = M / BM; nN = N / BM; nwg = nM * nN; G = G_; c = c_; }
    __host__ __device__ bool next(int i, Unit& u) const {
        const long L = (long)i * G + c; if (L >= nwg) return false;
        int wgid = (int)L; { const int q = nwg / NXCD, r = nwg % NXCD, xcd = wgid % NXCD, off = wgid / NXCD; wgid = (xcd < r ? xcd * (q + 1) : r * (q + 1) + (xcd - r) * q) + off; }
        const int nig = WGM * nN, gid = wgid / nig, fm = gid * WGM, gsz = (nM - fm) < WGM ? (nM - fm) : WGM;
        u.pm = fm + ((wgid % nig) % gsz); u.pn = (wgid % nig) / gsz; return true;
    }
    __device__ __forceinline__ void a_ready(const Unit&) const {}
    __device__ __forceinline__ void done(const Unit&) const {}
};


struct PairOrder {
    StaticOrder base; Unit u0;
    __host__ __device__ void init(int M_, int N_, int G_, int c_) { base.init(M_, N_, G_, c_); base.next(0, u0); }
    __host__ __device__ bool next(int i, Unit& u) const { if (i >= 2) return false; u.pm = u0.pm + 64 * i; u.pn = u0.pn + 4 * i; return true; }
    __device__ __forceinline__ void a_ready(const Unit&) const {}
    __device__ __forceinline__ void done(const Unit&) const {}
};

typedef float cvt_f32x2_t __attribute__((ext_vector_type(2)));
typedef __bf16 cvt_bf16x2_t __attribute__((ext_vector_type(2)));
__device__ __forceinline__ unsigned cvt_pk_bf16(float lo, float hi) { const cvt_f32x2_t v = {lo, hi}; const cvt_bf16x2_t b = __builtin_convertvector(v, cvt_bf16x2_t); return __builtin_bit_cast(unsigned, b); }
__device__ __forceinline__ unsigned short f2bf(float f) { unsigned u = __builtin_bit_cast(unsigned, f); return (unsigned short)((u + 0x7fffu + ((u >> 16) & 1u)) >> 16); }
__device__ __forceinline__ float bflo(unsigned w) { return __builtin_bit_cast(float, w << 16); }
__device__ __forceinline__ float bfhi(unsigned w) { return __builtin_bit_cast(float, w & 0xffff0000u); }
__device__ __forceinline__ float sigm(float x) { return __builtin_amdgcn_rcpf(1.0f + __expf(-x)); }
template <int CTRL> __device__ __forceinline__ float dpp_mov(float v) { return __builtin_bit_cast(float, __builtin_amdgcn_update_dpp(0, __builtin_bit_cast(int, v), CTRL, 0xf, 0xf, true)); }
__device__ __forceinline__ float row_prefix16(float v, int fr) {
    v += dpp_mov<0x111>(v); v += dpp_mov<0x112>(v); v += dpp_mov<0x114>(v); v += dpp_mov<0x118>(v); (void)fr;
    return v;
}
__device__ __forceinline__ float row_suffix16(float v, int fr) {
    v += dpp_mov<0x101>(v); v += dpp_mov<0x102>(v); v += dpp_mov<0x104>(v); v += dpp_mov<0x108>(v); (void)fr;
    return v;
}

enum EpiMode { EM_IN = 0, EM_C1A = 1, EM_C1B = 2, EM_C2 = 3, EM_C3 = 4, EM_C4 = 5 };
template <int MODE> struct EpiAll {
    static constexpr bool PERM = true, AFTER_DRAIN = false;
    static constexpr int mode = MODE; unsigned char* ws; float* out; const float* x; const float* gain; const float* gfin;
    __device__ __forceinline__ void operator()(const f32x4 (&acc)[2][2][4][2], const Unit& u, int wr, int wc, int fr, int fq) const {
        const int pn = u.pn;
        const int row0 = u.pm * BM + wr * 64 + fr;
#define EP_B(off) ((bf16_t*)(ws + (off)))
#define EP_F(off) ((float*)(ws + (off)))
        bf16_t* const QNA = EP_B(WS_QNA); bf16_t* const KNA = EP_B(WS_KNA); bf16_t* const VT = EP_B(WS_VT); bf16_t* const QF = EP_B(WS_QF); bf16_t* const QB = EP_B(WS_QB); bf16_t* const KF = EP_B(WS_KF); bf16_t* const KB = EP_B(WS_KB);
        bf16_t* const KFT = EP_B(WS_KFT); bf16_t* const KBT = EP_B(WS_KBT); bf16_t* const VHT = EP_B(WS_VHT); bf16_t* const GHG = EP_B(WS_GHG); float* const GF = EP_F(WS_GF); float* const GB = EP_F(WS_GB); const float* const LB = EP_F(WS_LB);
        bf16_t* const SNA = (bf16_t*)out; bf16_t* const SHG = (bf16_t*)out + (size_t)M * D;
        bf16_t* const T = EP_B(WS_T); bf16_t* const MIX = EP_B(WS_MIX); bf16_t* const H1B = EP_B(WS_XN); bf16_t* const U = EP_B(WS_U); float* const ssq1 = EP_F(WS_SSQ1); float* const ssq2 = EP_F(WS_SSQ2);
#undef EP_B
#undef EP_F
        const int cl0 = wc * 32 + 8 * fq;
        if (mode == EM_IN) {
            if (pn < 4) {
                bf16_t* base = (pn < 2) ? QNA : KNA; const float sc = (pn < 2) ? 0.125f : 1.0f; const int colt = (pn & 1) * 256 + cl0;
#pragma unroll
                for (int ai = 0; ai < 2; ++ai)
#pragma unroll
                    for (int m = 0; m < 4; ++m) { bf16_t* rowp = base + (size_t)(row0 + ai * HALF + m * 16) * 512 + colt;
#pragma unroll
                        for (int bj = 0; bj < 2; ++bj) { const f32x4 v0 = acc[ai][bj][m][0] * sc, v1 = acc[ai][bj][m][1] * sc; u32x4 w;
                            w.x = cvt_pk_bf16(v0[0], v0[1]); w.y = cvt_pk_bf16(v0[2], v0[3]); w.z = cvt_pk_bf16(v1[0], v1[1]); w.w = cvt_pk_bf16(v1[2], v1[3]);
                            *(u32x4*)(rowp + bj * HALF) = w; } }
            } else if (pn < 6) {
                const int colt = (pn - 4) * 256 + cl0;
#pragma unroll
                for (int ai = 0; ai < 2; ++ai)
#pragma unroll
                    for (int m = 0; m < 4; ++m) { const int row = row0 + ai * HALF + m * 16; const int b = row >> 11, t = row & 2047, r = t >> 6, c = t & 63;
#pragma unroll
                        for (int bj = 0; bj < 2; ++bj) { const int col = colt + bj * HALF; const int h = col >> 6, d0 = col & 63;
                            bf16_t* bp = VT + ((((size_t)(b * 8 + h) * 32 + r) * 64 + d0) * 64 + c);
#pragma unroll
                            for (int n = 0; n < 2; ++n)
#pragma unroll
                                for (int j = 0; j < 4; ++j) bp[(4 * n + j) * 64] = f2bf(acc[ai][bj][m][n][j]); } }
            } else if (pn < 14) {
                const int ch0 = (pn - 6) * 64 + wc * 16 + fq * 4;
                const f32x4 lbf = *(const f32x4*)(LB + ch0), lbb = *(const f32x4*)(LB + 512 + ch0);
#pragma unroll
                for (int ai = 0; ai < 2; ++ai)
#pragma unroll
                    for (int m = 0; m < 4; ++m) { const int row = row0 + ai * HALF + m * 16; const int chunk = row >> 4;
                        const f32x4 q = acc[ai][0][m][0], zf = acc[ai][0][m][1], zb = acc[ai][1][m][0], iv = acc[ai][1][m][1];
                        float qfv[4], kfv[4], qbv[4], kbv[4]; f32x4 gfv, gbv;
#pragma unroll
                        for (int j = 0; j < 4; ++j) {
                            const float qs = q[j] * sigm(q[j]);
                            const float ff = lbf[j] + (1.0f - lbf[j]) * sigm(zf[j]);
                            const float fb = lbb[j] + (1.0f - lbb[j]) * sigm(zb[j]);
                            const float bf_ = row_prefix16(__builtin_amdgcn_logf(ff) * 0.69314718056f, fr), bb_ = row_suffix16(__builtin_amdgcn_logf(fb) * 0.69314718056f, fr);
                            const float ef = __expf(bf_), eb = __expf(bb_);
                            qfv[j] = qs * ef; kfv[j] = (1.0f - ff) * __expf(-bf_);
                            qbv[j] = qs * eb; kbv[j] = (1.0f - fb) * __expf(-bb_);
                            gfv[j] = ef; gbv[j] = eb;
                        }
                        typedef unsigned u32x2 __attribute__((ext_vector_type(2)));
                        const size_t ro = (size_t)row * 512 + ch0;
                        u32x2 w;
                        w.x = cvt_pk_bf16(qfv[0], qfv[1]); w.y = cvt_pk_bf16(qfv[2], qfv[3]); *(u32x2*)(QF + ro) = w;
                        w.x = cvt_pk_bf16(qbv[0], qbv[1]); w.y = cvt_pk_bf16(qbv[2], qbv[3]); *(u32x2*)(QB + ro) = w;
                        w.x = cvt_pk_bf16(kfv[0], kfv[1]); w.y = cvt_pk_bf16(kfv[2], kfv[3]); *(u32x2*)(KF + ro) = w;
                        w.x = cvt_pk_bf16(kbv[0], kbv[1]); w.y = cvt_pk_bf16(kbv[2], kbv[3]); *(u32x2*)(KB + ro) = w;
                        const size_t to = ((size_t)chunk * 512 + ch0) * 16 + fr;
#pragma unroll
                        for (int j = 0; j < 4; ++j) { KFT[to + j * 16] = f2bf(kfv[j]); KBT[to + j * 16] = f2bf(kbv[j]); VHT[to + j * 16] = f2bf(iv[j]); }
                        if (fr == 15) *(f32x4*)(GF + (size_t)chunk * 512 + ch0) = gfv;
                        if (fr == 0)  *(f32x4*)(GB + (size_t)chunk * 512 + ch0) = gbv;
                    }
            } else if (pn < 16) {
                const int colt = (pn - 14) * 256 + cl0;
#pragma unroll
                for (int bj = 0; bj < 2; ++bj) { const f32x4 g0 = *(const f32x4*)(gain + colt + bj * HALF), g1 = *(const f32x4*)(gain + colt + bj * HALF + 4);
#pragma unroll
                    for (int ai = 0; ai < 2; ++ai)
#pragma unroll
                        for (int m = 0; m < 4; ++m) { f32x4 v0 = acc[ai][bj][m][0], v1 = acc[ai][bj][m][1];
#pragma unroll
                            for (int j = 0; j < 4; ++j) { v0[j] = v0[j] * sigm(v0[j]) * g0[j]; v1[j] = v1[j] * sigm(v1[j]) * g1[j]; }
                            u32x4 w; w.x = cvt_pk_bf16(v0[0], v0[1]); w.y = cvt_pk_bf16(v0[2], v0[3]); w.z = cvt_pk_bf16(v1[0], v1[1]); w.w = cvt_pk_bf16(v1[2], v1[3]);
                            *(u32x4*)(GHG + (size_t)(row0 + ai * HALF + m * 16) * 512 + colt + bj * HALF) = w; } }
            } else {
                bf16_t* base = (pn < 20) ? SNA : SHG; const int colt = ((pn - 16) & 3) * 256 + cl0;
#pragma unroll
                for (int ai = 0; ai < 2; ++ai)
#pragma unroll
                    for (int m = 0; m < 4; ++m)
#pragma unroll
                        for (int bj = 0; bj < 2; ++bj) { f32x4 v0 = acc[ai][bj][m][0], v1 = acc[ai][bj][m][1];
#pragma unroll
                            for (int j = 0; j < 4; ++j) { v0[j] = sigm(v0[j]); v1[j] = sigm(v1[j]); }
                            u32x4 w; w.x = cvt_pk_bf16(v0[0], v0[1]); w.y = cvt_pk_bf16(v0[2], v0[3]); w.z = cvt_pk_bf16(v1[0], v1[1]); w.w = cvt_pk_bf16(v1[2], v1[3]);
                            *(u32x4*)(base + (size_t)(row0 + ai * HALF + m * 16) * 1024 + colt + bj * HALF) = w; }
            }
            return;
        }
        const int colt = (mode == EM_C1A ? (pn & 3) : pn) * BM + cl0;
        if (mode == EM_C1A || mode == EM_C1B) {
            const bool second = (mode == EM_C1B) || (pn >= 4); const int row0c = (mode == EM_C1A) ? (row0 & (M - 1)) : row0;
            const bf16_t* gate = second ? SHG : SNA; bf16_t* dst = second ? MIX : T;
#pragma unroll
            for (int ai = 0; ai < 2; ++ai) {
                u32x4 gv[4][2], tv[4][2];
#pragma unroll
                for (int m = 0; m < 4; ++m)
#pragma unroll
                    for (int bj = 0; bj < 2; ++bj) { const size_t off = (size_t)(row0c + ai * HALF + m * 16) * 1024 + colt + bj * HALF;
                        gv[m][bj] = *(const u32x4*)(gate + off); if (second) tv[m][bj] = *(const u32x4*)(T + off); else tv[m][bj] = (u32x4){0u, 0u, 0u, 0u}; }
#pragma unroll
                for (int m = 0; m < 4; ++m)
#pragma unroll
                    for (int bj = 0; bj < 2; ++bj) { const size_t off = (size_t)(row0c + ai * HALF + m * 16) * 1024 + colt + bj * HALF;
                        const u32x4 g = gv[m][bj], tt = tv[m][bj]; const f32x4 a0 = acc[ai][bj][m][0], a1 = acc[ai][bj][m][1];
                        const float r0 = a0[0] * bflo(g.x) + bflo(tt.x), r1 = a0[1] * bfhi(g.x) + bfhi(tt.x), r2 = a0[2] * bflo(g.y) + bflo(tt.y), r3 = a0[3] * bfhi(g.y) + bfhi(tt.y);
                        const float r4 = a1[0] * bflo(g.z) + bflo(tt.z), r5 = a1[1] * bfhi(g.z) + bfhi(tt.z), r6 = a1[2] * bflo(g.w) + bflo(tt.w), r7 = a1[3] * bfhi(g.w) + bfhi(tt.w);
                        u32x4 w; w.x = cvt_pk_bf16(r0, r1); w.y = cvt_pk_bf16(r2, r3); w.z = cvt_pk_bf16(r4, r5); w.w = cvt_pk_bf16(r6, r7);
                        *(u32x4*)(dst + off) = w; }
            }
        } else if (mode == EM_C4) {
            f32x4 (&hacc)[2][2][4][2] = const_cast<f32x4 (&)[2][2][4][2]>(acc);
#pragma unroll
            for (int ai = 0; ai < 2; ++ai)
#pragma unroll
                for (int mp = 0; mp < 2; ++mp) {
                    f32x4 pre[2][2][2];
#pragma unroll
                    for (int mm = 0; mm < 2; ++mm)
#pragma unroll
                        for (int bj = 0; bj < 2; ++bj) { const size_t off = (size_t)(row0 + ai * HALF + (2 * mp + mm) * 16) * 1024 + colt + bj * HALF;
                            const u32x4 hb = *(const u32x4*)(H1B + off);
                            pre[mm][bj][0] = (f32x4){bflo(hb.x), bfhi(hb.x), bflo(hb.y), bfhi(hb.y)}; pre[mm][bj][1] = (f32x4){bflo(hb.z), bfhi(hb.z), bflo(hb.w), bfhi(hb.w)}; }
#pragma unroll
                    for (int mm = 0; mm < 2; ++mm) { const int m = 2 * mp + mm; const int row = row0 + ai * HALF + m * 16; float s = 0.f;
#pragma unroll
                        for (int bj = 0; bj < 2; ++bj) { const f32x4 h0 = pre[mm][bj][0] + acc[ai][bj][m][0], h1 = pre[mm][bj][1] + acc[ai][bj][m][1];
                            hacc[ai][bj][m][0] = h0; hacc[ai][bj][m][1] = h1;
                            s += (h0[0] * h0[0] + h0[1] * h0[1]) + (h0[2] * h0[2] + h0[3] * h0[3]) + (h1[0] * h1[0] + h1[1] * h1[1]) + (h1[2] * h1[2] + h1[3] * h1[3]); }
                        s += __shfl_xor(s, 16); s += __shfl_xor(s, 32);
                        if (fq == 0) ssq2[(size_t)row * 16 + pn * 4 + wc] = s; }
                    asm volatile("" ::: "memory");
                }
            asm volatile("s_waitcnt vmcnt(0)" ::: "memory");
            __builtin_amdgcn_s_barrier();
            if (threadIdx.x == 0) {
                unsigned* cnt = (unsigned*)(ws + WS_C4CNT) + 16 * u.pm;
                __builtin_amdgcn_fence(__ATOMIC_RELEASE, "agent");
                asm volatile("s_waitcnt vmcnt(0)" ::: "memory");
                __hip_atomic_fetch_add(cnt, 1u, __ATOMIC_RELAXED, __HIP_MEMORY_SCOPE_AGENT);
                unsigned spins = 0;
                while (__hip_atomic_load(cnt, __ATOMIC_RELAXED, __HIP_MEMORY_SCOPE_AGENT) < 4u) { __builtin_amdgcn_s_sleep(2); if (++spins > (1u << 22)) break; }
                __builtin_amdgcn_fence(__ATOMIC_ACQUIRE, "agent");
                asm volatile("s_waitcnt vmcnt(0)" ::: "memory");
            }
            __builtin_amdgcn_s_barrier();
            asm volatile("" ::: "memory");
            const f32x4 gA0 = *(const f32x4*)(gfin + colt), gA1 = *(const f32x4*)(gfin + colt + 4), gB0 = *(const f32x4*)(gfin + colt + HALF), gB1 = *(const f32x4*)(gfin + colt + HALF + 4);
#pragma unroll
            for (int ai = 0; ai < 2; ++ai)
#pragma unroll
                for (int mp = 0; mp < 2; ++mp) {
                    f32x4 pp[2][4];
#pragma unroll
                    for (int mm = 0; mm < 2; ++mm)
#pragma unroll
                        for (int q = 0; q < 4; ++q) pp[mm][q] = *(const f32x4*)(ssq2 + (size_t)(row0 + ai * HALF + (2 * mp + mm) * 16) * 16 + 4 * q);
#pragma unroll
                    for (int mm = 0; mm < 2; ++mm) { const int m = 2 * mp + mm; const int row = row0 + ai * HALF + m * 16; const size_t off = (size_t)row * 1024 + colt;
                        const f32x4 p0 = pp[mm][0], p1 = pp[mm][1], p2 = pp[mm][2], p3 = pp[mm][3];
                        const float rs = rsqrtf(((((p0[0] + p0[1]) + (p0[2] + p0[3])) + ((p1[0] + p1[1]) + (p1[2] + p1[3]))) + (((p2[0] + p2[1]) + (p2[2] + p2[3])) + ((p3[0] + p3[1]) + (p3[2] + p3[3])))) * (1.0f / 1024.0f) + 1e-6f);
                        *(f32x4*)(out + off) = acc[ai][0][m][0] * rs * gA0; *(f32x4*)(out + off + 4) = acc[ai][0][m][1] * rs * gA1;
                        *(f32x4*)(out + off + HALF) = acc[ai][1][m][0] * rs * gB0; *(f32x4*)(out + off + HALF + 4) = acc[ai][1][m][1] * rs * gB1; }
                    asm volatile("" ::: "memory");
                }
        } else if (mode == EM_C2) {
            const float* base = (mode == EM_C2) ? x : (const float*)out; float* ssq = (mode == EM_C2) ? ssq1 : ssq2;
#pragma unroll
            for (int ai = 0; ai < 2; ++ai) {
                f32x4 pre[4][2][2];
#pragma unroll
                for (int m = 0; m < 4; ++m)
#pragma unroll
                    for (int bj = 0; bj < 2; ++bj) { const size_t off = (size_t)(row0 + ai * HALF + m * 16) * 1024 + colt + bj * HALF;
                        pre[m][bj][0] = *(const f32x4*)(base + off); pre[m][bj][1] = *(const f32x4*)(base + off + 4); }
#pragma unroll
                for (int m = 0; m < 4; ++m) { const int row = row0 + ai * HALF + m * 16; float s = 0.f;
#pragma unroll
                    for (int bj = 0; bj < 2; ++bj) { const size_t off = (size_t)row * 1024 + colt + bj * HALF;
                        const f32x4 h0 = pre[m][bj][0] + acc[ai][bj][m][0], h1 = pre[m][bj][1] + acc[ai][bj][m][1];
                        s += (h0[0] * h0[0] + h0[1] * h0[1]) + (h0[2] * h0[2] + h0[3] * h0[3]) + (h1[0] * h1[0] + h1[1] * h1[1]) + (h1[2] * h1[2] + h1[3] * h1[3]);
                        if (mode == EM_C2) { u32x4 w; w.x = cvt_pk_bf16(h0[0], h0[1]); w.y = cvt_pk_bf16(h0[2], h0[3]); w.z = cvt_pk_bf16(h1[0], h1[1]); w.w = cvt_pk_bf16(h1[2], h1[3]);
                            *(u32x4*)(H1B + off) = w; } }
                    s += __shfl_xor(s, 16); s += __shfl_xor(s, 32);
                    if (fq == 0) ssq[(size_t)row * 16 + pn * 4 + wc] = s; }
            }
        } else {
#pragma unroll
            for (int ai = 0; ai < 2; ++ai) {
                f32x4 pp[4][4];
#pragma unroll
                for (int m = 0; m < 4; ++m)
#pragma unroll
                    for (int q = 0; q < 4; ++q) pp[m][q] = *(const f32x4*)(ssq1 + (size_t)(row0 + ai * HALF + m * 16) * 16 + 4 * q);
#pragma unroll
                for (int m = 0; m < 4; ++m) { const int row = row0 + ai * HALF + m * 16;
                    const f32x4 p0 = pp[m][0], p1 = pp[m][1], p2 = pp[m][2], p3 = pp[m][3];
                    const float rs = rsqrtf(((((p0[0] + p0[1]) + (p0[2] + p0[3])) + ((p1[0] + p1[1]) + (p1[2] + p1[3]))) + (((p2[0] + p2[1]) + (p2[2] + p2[3])) + ((p3[0] + p3[1]) + (p3[2] + p3[3])))) * (1.0f / 1024.0f) + 1e-6f);
#pragma unroll
                    for (int bj = 0; bj < 2; ++bj) { f32x4 v0 = acc[ai][bj][m][0] * rs, v1 = acc[ai][bj][m][1] * rs;
#pragma unroll
                        for (int j = 0; j < 4; ++j) { const float a = fmaxf(v0[j], 0.f), b = fmaxf(v1[j], 0.f); v0[j] = a * a; v1[j] = b * b; }
                        u32x4 w; w.x = cvt_pk_bf16(v0[0], v0[1]); w.y = cvt_pk_bf16(v0[2], v0[3]); w.z = cvt_pk_bf16(v1[0], v1[1]); w.w = cvt_pk_bf16(v1[2], v1[3]);
                        *(u32x4*)(U + (size_t)row * 4096 + colt + bj * HALF) = w; } }
            }
        }
    }
};

template <class Epi, class Sched, bool ALIGN_EPI = false, bool SP2 = false>
__device__ __forceinline__ void gemm_phase(PG8_LAS unsigned char* lds, const Gemm g, const Sched& S, const Epi& E) {
    int tid_ = threadIdx.x; asm volatile("" : "+v"(tid_));
    const int tid = tid_, wid = __builtin_amdgcn_readfirstlane(tid >> 6), lane = tid & 63, wr = wid >> 2, wc = wid & 3, fr = lane & 15, fq = lane >> 4;
    const int K = g.K, nt = K / BK;
    unsigned voffA[2], voffB[2];
#pragma unroll
    for (int i = 0; i < 2; ++i) { int R, C; stage_rc(tid * 16 + i * 8192, R, C); const int Rb = Epi::PERM ? ((R & ~31) + perm32(R & 31)) : R;
        voffA[i] = (unsigned)(R * K + C) * 2u; voffB[i] = (unsigned)(Rb * K + C) * 2u; }
    const size_t kstep = (size_t)(BK * 2);
    const size_t hstep = (size_t)HALF * K * 2;
    const size_t tstep = 2 * hstep;
    const unsigned ldsw = (unsigned)wid * 1024u;
    const int aoff = lds_byte(wr * 64 + fr, fq * 8), boff = lds_byte(wc * 32 + fr, fq * 8);
#define PG8_SA(b, h) (((b) * 2 + (h)) * HTB)
#define PG8_SB(b, h) ((4 + (b) * 2 + (h)) * HTB)
#define PG8_STAGE(bufoff, gbase, voff) do { _Pragma("unroll") for (int _i = 0; _i < 2; ++_i) \
        __builtin_amdgcn_global_load_lds((const unsigned*)((const char*)(gbase) + (voff)[_i]), (PG8_LAS unsigned*)(lds + (bufoff) + ldsw + _i * 8192), 16, 0, 0); } while (0)
#define PG8_LDA(dst, b, h) do { _Pragma("unroll") for (int m = 0; m < 4; ++m) _Pragma("unroll") for (int k = 0; k < 2; ++k) dst[m][k] = *(const PG8_LAS bf16x8*)(lds + PG8_SA(b, h) + aoff + m * 2048 + k * 1024); } while (0)
#define PG8_LDB(dst, b, h) do { _Pragma("unroll") for (int n = 0; n < 2; ++n) _Pragma("unroll") for (int k = 0; k < 2; ++k) dst[n][k] = *(const PG8_LAS bf16x8*)(lds + PG8_SB(b, h) + boff + n * 2048 + k * 1024); } while (0)
#define PG8_MMA(ai, bj, At, Bt) do { __builtin_amdgcn_s_setprio(1); _Pragma("unroll") for (int m = 0; m < 4; ++m) _Pragma("unroll") for (int n = 0; n < 2; ++n) _Pragma("unroll") for (int k = 0; k < 2; ++k) \
        acc[ai][bj][m][n] = __builtin_amdgcn_mfma_f32_16x16x32_bf16(Bt[n][k], At[m][k], acc[ai][bj][m][n], 0, 0, 0); __builtin_amdgcn_s_setprio(0); } while (0)
#define PG8_WAIT_V(n) asm volatile("s_waitcnt vmcnt(" #n ")" ::: "memory")
#define PG8_WAIT_L(n) asm volatile("s_waitcnt lgkmcnt(" #n ")" ::: "memory")
#define PG8_BAR __builtin_amdgcn_s_barrier()
#define PG8_SCHED __builtin_amdgcn_sched_barrier(0)
    Unit cur, nxt; int ui = 0;
    if (!S.next(0, cur)) return;
    f32x4 acc[2][2][4][2];
#pragma unroll
    for (int a = 0; a < 2; ++a)
#pragma unroll
        for (int b = 0; b < 2; ++b)
#pragma unroll
            for (int m = 0; m < 4; ++m)
#pragma unroll
                for (int n = 0; n < 2; ++n) acc[a][b][m][n] = (f32x4){0.f, 0.f, 0.f, 0.f};
    bf16x8 At[4][2], B0[2][2], B1[2][2];
    const char* cA = (const char*)g.A + (size_t)cur.pm * tstep; const char* cB = (const char*)g.Bt + (size_t)cur.pn * tstep;
    S.a_ready(cur);
    if constexpr (SP2) {
        PG8_STAGE(PG8_SB(0, 0), cB, voffB); PG8_STAGE(PG8_SB(0, 1), cB + hstep, voffB); PG8_STAGE(PG8_SA(0, 0), cA, voffA); PG8_STAGE(PG8_SA(0, 1), cA + hstep, voffA);
        if (wr == 1) PG8_BAR;
        PG8_WAIT_V(2); PG8_BAR;
        PG8_STAGE(PG8_SB(1, 0), cB + kstep, voffB); PG8_STAGE(PG8_SA(1, 0), cA + kstep, voffA); PG8_STAGE(PG8_SB(1, 1), cB + hstep + kstep, voffB);
        PG8_WAIT_V(6); PG8_BAR;
    } else {
        PG8_STAGE(PG8_SB(0, 0), cB, voffB); PG8_STAGE(PG8_SA(0, 0), cA, voffA); PG8_STAGE(PG8_SB(0, 1), cB + hstep, voffB); PG8_STAGE(PG8_SA(0, 1), cA + hstep, voffA);
        if (wr == 1) PG8_BAR;
        PG8_WAIT_V(4); PG8_BAR;
        PG8_STAGE(PG8_SB(1, 0), cB + kstep, voffB); PG8_STAGE(PG8_SA(1, 0), cA + kstep, voffA); PG8_STAGE(PG8_SB(1, 1), cB + hstep + kstep, voffB);
        PG8_WAIT_V(6); PG8_BAR;
    }
    for (;;) {
        const bool has_next = S.next(ui + 1, nxt);
        const char* nA = has_next ? (const char*)g.A + (size_t)nxt.pm * tstep : cA; const char* nB = has_next ? (const char*)g.Bt + (size_t)nxt.pn * tstep : cB;
        for (int t = 0; t < nt; t += 2) {
            const bool last = (t == nt - 2);
            const char* a1 = cA + (size_t)(t + 1) * kstep;
            const char* a2 = last ? nA : cA + (size_t)(t + 2) * kstep; const char* b2 = last ? nB : cB + (size_t)(t + 2) * kstep;
            const char* a3 = a2 + kstep; const char* b3 = b2 + kstep;
            if (last && has_next) S.a_ready(nxt);
            if constexpr (SP2) {
            PG8_LDB(B0, 0, 0); PG8_LDB(B1, 0, 1); PG8_SCHED; PG8_LDA(At, 0, 0); PG8_STAGE(PG8_SA(1, 1), a1 + hstep, voffA);
            PG8_WAIT_V(8); PG8_WAIT_L(0); PG8_BAR; PG8_MMA(0, 0, At, B0); PG8_MMA(0, 1, At, B1); PG8_BAR; PG8_SCHED;
            PG8_LDA(At, 0, 1); PG8_STAGE(PG8_SB(0, 0), b2, voffB); PG8_STAGE(PG8_SB(0, 1), b2 + hstep, voffB); PG8_STAGE(PG8_SA(0, 0), a2, voffA);
            PG8_WAIT_V(8); PG8_WAIT_L(0); PG8_BAR; PG8_MMA(1, 0, At, B0); PG8_MMA(1, 1, At, B1); PG8_BAR; PG8_SCHED;
            PG8_LDB(B0, 1, 0); PG8_LDB(B1, 1, 1); PG8_SCHED; PG8_LDA(At, 1, 0); PG8_STAGE(PG8_SA(0, 1), a2 + hstep, voffA);
            PG8_WAIT_V(8); PG8_WAIT_L(0); PG8_BAR; PG8_MMA(0, 0, At, B0); PG8_MMA(0, 1, At, B1); PG8_BAR; PG8_SCHED;
            PG8_LDA(At, 1, 1); PG8_STAGE(PG8_SB(1, 0), b3, voffB); PG8_STAGE(PG8_SB(1, 1), b3 + hstep, voffB); PG8_STAGE(PG8_SA(1, 0), a3, voffA);
            PG8_WAIT_V(8); PG8_WAIT_L(0); PG8_BAR; PG8_MMA(1, 0, At, B0); PG8_MMA(1, 1, At, B1); PG8_BAR; PG8_SCHED;
            } else {
            PG8_LDB(B0, 0, 0); PG8_SCHED; PG8_LDA(At, 0, 0); PG8_STAGE(PG8_SA(1, 1), a1 + hstep, voffA);
            PG8_WAIT_L(8); PG8_BAR; PG8_WAIT_L(0); PG8_MMA(0, 0, At, B0); PG8_BAR; PG8_SCHED;
            PG8_LDB(B1, 0, 1); PG8_STAGE(PG8_SB(0, 0), b2, voffB);
            PG8_BAR; PG8_WAIT_L(0); PG8_MMA(0, 1, At, B1); PG8_BAR;
            PG8_LDA(At, 0, 1); PG8_STAGE(PG8_SA(0, 0), a2, voffA);
            PG8_BAR; PG8_WAIT_L(0); PG8_MMA(1, 0, At, B0); PG8_BAR; PG8_SCHED;
            PG8_STAGE(PG8_SB(0, 1), b2 + hstep, voffB);
            PG8_WAIT_V(6); PG8_BAR; PG8_MMA(1, 1, At, B1); PG8_BAR;
            PG8_LDB(B0, 1, 0); PG8_SCHED; PG8_LDA(At, 1, 0); PG8_STAGE(PG8_SA(0, 1), a2 + hstep, voffA);
            PG8_WAIT_L(8); PG8_BAR; PG8_WAIT_L(0); PG8_MMA(0, 0, At, B0); PG8_BAR; PG8_SCHED;
            PG8_LDB(B1, 1, 1); PG8_STAGE(PG8_SB(1, 0), b3, voffB);
            PG8_BAR; PG8_WAIT_L(0); PG8_MMA(0, 1, At, B1); PG8_BAR;
            PG8_LDA(At, 1, 1); PG8_STAGE(PG8_SA(1, 0), a3, voffA);
            PG8_BAR; PG8_WAIT_L(0); PG8_MMA(1, 0, At, B0); PG8_BAR; PG8_SCHED;
            PG8_STAGE(PG8_SB(1, 1), b3 + hstep, voffB);
            PG8_WAIT_V(6); PG8_BAR; PG8_MMA(1, 1, At, B1); PG8_BAR;
            }
        }
        if constexpr (ALIGN_EPI) { if (wr == 0) PG8_BAR; }
        if constexpr (!Epi::AFTER_DRAIN) { E(acc, cur, wr, wc, fr, fq); S.done(cur); }
        if (!has_next) break;
#pragma unroll
        for (int a = 0; a < 2; ++a)
#pragma unroll
            for (int b = 0; b < 2; ++b)
#pragma unroll
                for (int m = 0; m < 4; ++m)
#pragma unroll
                    for (int n = 0; n < 2; ++n) acc[a][b][m][n] = (f32x4){0.f, 0.f, 0.f, 0.f};
        cur = nxt; cA = nA; cB = nB; ++ui;
        if constexpr (ALIGN_EPI) { if (wr == 1) PG8_BAR; }
    }
    PG8_WAIT_V(0);
    if constexpr (!ALIGN_EPI) { if (wr == 0) PG8_BAR; }
    PG8_BAR;
    if constexpr (Epi::AFTER_DRAIN) { E.fused(acc, cur, wr, wc, fr, fq, lds, wid, lane); S.done(cur); }
#undef PG8_SA
#undef PG8_SB
#undef PG8_STAGE
#undef PG8_LDA
#undef PG8_LDB
#undef PG8_MMA
#undef PG8_WAIT_V
#undef PG8_WAIT_L
#undef PG8_BAR
#undef PG8_SCHED
}
}

#define GAS __attribute__((address_space(1)))
#define LAS __attribute__((address_space(3)))
typedef unsigned short bf16;
typedef unsigned v4u __attribute__((ext_vector_type(4)));
typedef unsigned v2u __attribute__((ext_vector_type(2)));
typedef float f32x4 __attribute__((ext_vector_type(4)));
typedef float f32x2 __attribute__((ext_vector_type(2)));
typedef short bf16x8 __attribute__((ext_vector_type(8)));
typedef short s16x4 __attribute__((ext_vector_type(4)));
using pg8::f2bf; using pg8::cvt_pk_bf16; using pg8::bflo; using pg8::bfhi;


__device__ __forceinline__ float wave_sum(float v) {
#pragma unroll
    for (int o = 1; o < 64; o <<= 1) v += __shfl_xor(v, o);
    return v;
}
__device__ __forceinline__ unsigned pk2(float lo, float hi) { return (unsigned)f2bf(lo) | ((unsigned)f2bf(hi) << 16); }

#define XB_TMO      128
#define XB_XCNT(j)  (256  + 64 * (j))
#define XB_XSUB(j)  (1280 + 64 * (j))
#define XB_XGEN(j)  (2304 + 64 * (j))
#define XB_TOP      3328
#define XB_TOPGEN   3392
#define XCD_BAR_WORDS 3456
#define XB_SPIN_CAP (1u << 18)

__device__ __forceinline__ unsigned xb_ld(unsigned* p)              { return __hip_atomic_load(p, __ATOMIC_RELAXED, __HIP_MEMORY_SCOPE_AGENT); }
__device__ __forceinline__ unsigned xb_add(unsigned* p, unsigned v) { return __hip_atomic_fetch_add(p, v, __ATOMIC_RELAXED, __HIP_MEMORY_SCOPE_AGENT); }
__device__ __forceinline__ unsigned xb_xcc_id() { return (unsigned)__builtin_amdgcn_s_getreg((3 << 11) | 20) & 0xFu; }
#define XB_SPIN(cond, bar) do { unsigned _sp = 0; while (cond) { __builtin_amdgcn_s_sleep(1); \
    if ((++_sp & 255u) == 0u) { if (xb_ld(&(bar)[XB_TMO])) break; if (_sp > XB_SPIN_CAP) { atomicAdd(&(bar)[XB_TMO], 1u); break; } } } } while (0)

struct XcdBarrier {
    unsigned* bar; unsigned x;
    volatile LAS unsigned* st;
};

__device__ __forceinline__ XcdBarrier xcd_barrier_post(unsigned* bar, volatile LAS unsigned* st) {
    XcdBarrier b; b.bar = bar; b.x = xb_xcc_id(); b.st = st;
    if (threadIdx.x == 0) (void)xb_add(&bar[XB_XCNT(b.x)], 1u);
    return b;
}
__device__ __forceinline__ void xcd_barrier_complete(unsigned* bar, unsigned x, unsigned& nloc, unsigned& nx) {
    const unsigned G = gridDim.x * gridDim.y * gridDim.z;
    unsigned sum, cnt, mine, sp = 0u;
    for (;;) {
        sum = 0u; cnt = 0u; mine = 0u;
#pragma unroll
        for (unsigned j = 0; j < 16; ++j) { const unsigned c = xb_ld(&bar[XB_XCNT(j)]); sum += c; cnt += (c > 0u) ? 1u : 0u; mine = (j == x) ? c : mine; }
        if (sum == G) break;
        __builtin_amdgcn_s_sleep(1);
        if ((++sp & 255u) == 0u) { if (xb_ld(&bar[XB_TMO])) break; if (sp > XB_SPIN_CAP) { atomicAdd(&bar[XB_TMO], 1u); break; } }
    }
    nloc = mine > 0u ? mine : 1u; nx = cnt > 0u ? cnt : 1u;
}

__device__ __forceinline__ void xcd_barrier(const XcdBarrier& b) {
    asm volatile("s_waitcnt vmcnt(0)" ::: "memory");
    __syncthreads();
    if (threadIdx.x == 0) {
        unsigned* bar = b.bar;
        __builtin_amdgcn_s_waitcnt(0);
        unsigned nloc = b.st[0], nx = b.st[1];
        if (nloc == 0u) { xcd_barrier_complete(bar, b.x, nloc, nx); b.st[0] = nloc; b.st[1] = nx; }
        const unsigned old = xb_add(&bar[XB_XSUB(b.x)], 1u);
        const unsigned gen = old / nloc;
        if (old + 1u == (gen + 1u) * nloc) {
            __builtin_amdgcn_fence(__ATOMIC_RELEASE, "agent");
            asm volatile("s_waitcnt vmcnt(0)" ::: "memory");
            const unsigned og = xb_add(&bar[XB_TOP], 1u);
            const unsigned tg = og / nx;
            if (og + 1u == (tg + 1u) * nx) xb_add(&bar[XB_TOPGEN], 1u);
            else XB_SPIN(xb_ld(&bar[XB_TOPGEN]) == tg, bar);
            __builtin_amdgcn_fence(__ATOMIC_ACQUIRE, "agent");
            xb_add(&bar[XB_XGEN(b.x)], 1u);
            asm volatile("s_waitcnt vmcnt(0)" ::: "memory");
        } else {
            XB_SPIN(xb_ld(&bar[XB_XGEN(b.x)]) == gen, bar);
            __builtin_amdgcn_fence(__ATOMIC_ACQUIRE, "agent");
            asm volatile("s_waitcnt vmcnt(0)" ::: "memory");
        }
    }
    __syncthreads();
}

#define XL_SUB(j) (5120 + 64 * (j))
#define XL_GEN(j) (5632 + 64 * (j))
__device__ __forceinline__ void xcd_local_barrier(const XcdBarrier& b) {
    asm volatile("s_waitcnt vmcnt(0)" ::: "memory");
    __syncthreads();
    if (threadIdx.x == 0) {
        unsigned* bar = b.bar; const unsigned nloc = b.st[0];
        const unsigned old = xb_add(&bar[XL_SUB(b.x)], 1u), gen = old / nloc;
        if (old + 1u == (gen + 1u) * nloc) xb_add(&bar[XL_GEN(b.x)], 1u);
        else XB_SPIN(xb_ld(&bar[XL_GEN(b.x)]) == gen, bar);
        __builtin_amdgcn_fence(__ATOMIC_ACQUIRE, "agent");
        asm volatile("s_waitcnt vmcnt(0)" ::: "memory");
    }
    __syncthreads();
}
constexpr size_t WS_BAR = 768 * KiB, BAR_BYTES = 24 * KiB;
struct Args { const float* in[14]; float* out; unsigned char* ws; };

template <class CM>
__device__ __forceinline__ void tr_item(const float* W, int K, int N, bf16* WT, const float* kscale, LAS float* scr, int item, int lane, CM cmap) {
    const int nblk = N / 32, kb = item / nblk, nb = item % nblk, k0 = 64 * kb, n0 = 32 * nb;
    const int src = cmap(n0 + (lane & 31));
    float tv[32];
#pragma unroll
    for (int i = 0; i < 32; ++i) tv[i] = W[(size_t)(k0 + 2 * i + (lane >> 5)) * N + src];
#pragma unroll
    for (int i = 0; i < 32; ++i) { const int kk = 2 * i + (lane >> 5); float v = tv[i]; if (kscale) v *= kscale[k0 + kk]; scr[kk * 33 + (lane & 31)] = v; }
    asm volatile("s_waitcnt lgkmcnt(0)" ::: "memory");
    const int c = lane & 7;
#pragma unroll
    for (int j = 0; j < 4; ++j) { const int n = (lane >> 3) + 8 * j; const LAS float* s = scr + (8 * c) * 33 + n;
        v4u o; o.x = pk2(s[0 * 33], s[1 * 33]); o.y = pk2(s[2 * 33], s[3 * 33]); o.z = pk2(s[4 * 33], s[5 * 33]); o.w = pk2(s[6 * 33], s[7 * 33]);
        *(v4u*)(WT + (size_t)(n0 + n) * K + k0 + 8 * c) = o; }
    asm volatile("s_waitcnt lgkmcnt(0)" ::: "memory");
}
struct CmId { __device__ __forceinline__ int operator()(int n) const { return n; } };
struct CmIn {
    __device__ __forceinline__ int operator()(int n) const {
        if (n < 1536 || n >= 3584) return n;
        const int q = n - 1536, j = q >> 8, cl = q & 255;
        const int sel = 2 * (cl >> 7) + ((cl >> 2) & 1), ch = 64 * j + 16 * ((cl >> 5) & 3) + 4 * ((cl >> 3) & 3) + (cl & 3);
        return 1536 + 512 * sel + ch;
    }
};

struct HgOps { s16x4 vb[2]; s16x4 ka[8]; f32x4 g[8]; };
__device__ __forceinline__ void hg_load(HgOps& o, const bf16* KT, const bf16* VTt, const float* G, unsigned cb, int vq, int lm, int kq) {
#pragma unroll
    for (int vt = 0; vt < 2; ++vt) o.vb[vt] = *(const s16x4*)(VTt + (unsigned)((cb + 32 * vq + 16 * vt + lm) * 16 + 4 * kq));
#pragma unroll
    for (int kt = 0; kt < 8; ++kt) { o.ka[kt] = *(const s16x4*)(KT + (unsigned)((cb + 16 * kt + lm) * 16 + 4 * kq)); o.g[kt] = *(const f32x4*)(G + (unsigned)(cb + 16 * kt + 4 * kq)); }
}
template <bool TRACKD>
__device__ __forceinline__ void hg_apply(f32x4 (&S)[8][2], f32x4 (&Dp)[8], const HgOps& o) {
#pragma unroll
    for (int kt = 0; kt < 8; ++kt) {
#pragma unroll
        for (int vt = 0; vt < 2; ++vt) { S[kt][vt] = __builtin_amdgcn_mfma_f32_16x16x16bf16_1k(o.ka[kt], o.vb[vt], S[kt][vt], 0, 0, 0); S[kt][vt] = S[kt][vt] * o.g[kt]; }
        if (TRACKD) Dp[kt] = Dp[kt] * o.g[kt];
    }
}
template <bool TRACKD>
__device__ __forceinline__ void hg_update(f32x4 (&S)[8][2], f32x4 (&Dp)[8], const bf16* KT, const bf16* VTt, const float* G, unsigned cb, int vq, int lm, int kq) {
    HgOps o; hg_load(o, KT, VTt, G, cb, vq, lm, kq); hg_apply<TRACKD>(S, Dp, o);
}

__global__ void __launch_bounds__(NWAVES * 64, 2) mk_fwd(Args args) {
    extern __shared__ __attribute__((aligned(16))) unsigned char lds_raw[];
    LAS unsigned char* lds = (LAS unsigned char*)lds_raw;
    const int tid = threadIdx.x, lane = tid & 63, wave = __builtin_amdgcn_readfirstlane(tid >> 6);
    const int G = gridDim.x, bx = blockIdx.x;
    const int gw = bx * NWAVES + wave, NGW = G * NWAVES;
    const int lm = lane & 15, kq = lane >> 4;
    unsigned char* ws = args.ws;
    if (tid < 16) ((LAS unsigned*)(lds + LDS_CTL))[tid] = 0u;
    __syncthreads();
    const XcdBarrier bar = xcd_barrier_post((unsigned*)(ws + WS_BAR), (volatile LAS unsigned*)(lds + LDS_CTL + 32));
    if (tid == 0) ((LAS unsigned*)(lds + LDS_CTL))[0] = xb_add((unsigned*)(ws + WS_BAR) + 3520 + 64 * bar.x, 1u);
    __syncthreads();
    const unsigned my_rank = ((volatile LAS unsigned*)(lds + LDS_CTL))[0];
    const float* x = args.in[0]; const float* meta = args.in[1]; const float* w_in = args.in[2]; const float* w_na = args.in[3]; const float* w_hg = args.in[4];
    const float* w_o = args.in[5]; const float* w_up = args.in[6]; const float* w_dn = args.in[7]; const float* g_mix = args.in[8]; const float* g_mlp = args.in[9];
    const float* g_fin = args.in[10]; const float* hg_gain = args.in[11]; const float* rpb = args.in[12]; const float* lb_logits = args.in[13];
    float* out = args.out;
    float* ssq1 = (float*)(ws + WS_SSQ1); float* ssq2 = (float*)(ws + WS_SSQ2);
    bf16* KNAm = (bf16*)(ws + WS_KNAM); bf16* VTm = (bf16*)(ws + WS_VTM); bf16* KFTm = (bf16*)(ws + WS_KFTM); bf16* VHTm = (bf16*)(ws + WS_VHTM);
    float* GFm = (float*)(ws + WS_GFM); float* LB = (float*)(ws + WS_LB); float* DSEG = (float*)(ws + WS_DSEG);
    bf16* WT_in = (bf16*)(ws + WS_WIN); bf16* WT_na = (bf16*)(ws + WS_WNA); bf16* WT_hg = (bf16*)(ws + WS_WHG); bf16* WT_o = (bf16*)(ws + WS_WO); bf16* WT_up = (bf16*)(ws + WS_WUP); bf16* WT_dn = (bf16*)(ws + WS_WDN);
    bf16* XN = (bf16*)(ws + WS_XN); float* SBUF = (float*)(ws + WS_XN); bf16* H1B = (bf16*)(ws + WS_XN);
    bf16* QNA = (bf16*)(ws + WS_QNA); bf16* KNA = (bf16*)(ws + WS_KNA); bf16* VT = (bf16*)(ws + WS_VT); bf16* QF = (bf16*)(ws + WS_QF); bf16* QB = (bf16*)(ws + WS_QB);
    bf16* KF = (bf16*)(ws + WS_KF); bf16* KFT = (bf16*)(ws + WS_KFT); bf16* KB = (bf16*)(ws + WS_KB); bf16* KBT = (bf16*)(ws + WS_KBT); bf16* VHT = (bf16*)(ws + WS_VHT);
    bf16* GHG = (bf16*)(ws + WS_GHG); float* GF = (float*)(ws + WS_GF); float* GB = (float*)(ws + WS_GB);
    bf16* SNA = (bf16*)out; bf16* SHG = (bf16*)out + (size_t)M * D;
    bf16* ONA = QNA; bf16* OHG = (bf16*)(ws + WS_OHG); bf16* Tb = (bf16*)(ws + WS_T); bf16* MIX = (bf16*)(ws + WS_MIX); bf16* U = (bf16*)(ws + WS_U);

    {
        f32x4 xv0[4][4];
#pragma unroll
        for (int q = 0; q < 4; ++q)
#pragma unroll
            for (int j = 0; j < 4; ++j) xv0[q][j] = *(const f32x4*)(x + (size_t)(gw + q * NGW) * D + 4 * lane + 256 * j);
        {
            LAS float* mT = (LAS float*)lds;
            LAS float* red = (LAS float*)(lds + 65536);
            LAS float* fin = (LAS float*)(lds + 65536 + 32768);
#pragma unroll
            for (int rr = 0; rr < 2; ++rr) { const int r = 2 * wave + rr; const float* mr = meta + (size_t)r * D;
                f32x4 v[4]; float s = 0.f;
#pragma unroll
                for (int j = 0; j < 4; ++j) { v[j] = *(const f32x4*)(mr + 4 * lane + 256 * j); s += (v[j].x * v[j].x + v[j].y * v[j].y) + (v[j].z * v[j].z + v[j].w * v[j].w); }
                const float rs = rsqrtf(wave_sum(s) * (1.0f / D) + EPS);
#pragma unroll
                for (int j = 0; j < 4; ++j) { const f32x4 g = *(const f32x4*)(g_mix + 4 * lane + 256 * j); const int k = 4 * lane + 256 * j;
                    mT[(k + 0) * 16 + r] = v[j].x * rs * g.x; mT[(k + 1) * 16 + r] = v[j].y * rs * g.y; mT[(k + 2) * 16 + r] = v[j].z * rs * g.z; mT[(k + 3) * 16 + r] = v[j].w * rs * g.w; } }
            __syncthreads();
            for (int cbk = bx; cbk < 256; cbk += G) {
                const int c = tid & 7, ks = tid >> 3, grp = cbk >> 6, cl0 = (cbk & 63) * 8;
                const int src = (grp == 0 ? 512 : grp == 1 ? 1024 : grp == 2 ? 2048 : 3072) + cl0 + c;
                float a[16];
#pragma unroll
                for (int r = 0; r < 16; ++r) a[r] = 0.f;
                float wv[16];
#pragma unroll
                for (int kk = 0; kk < 16; ++kk) wv[kk] = w_in[(size_t)(ks * 16 + kk) * NIN + src];
#pragma unroll
                for (int kk = 0; kk < 16; ++kk) { const int k = ks * 16 + kk; const float w = wv[kk];
                    const f32x4 m0 = *(const LAS f32x4*)(mT + k * 16), m1 = *(const LAS f32x4*)(mT + k * 16 + 4), m2 = *(const LAS f32x4*)(mT + k * 16 + 8), m3 = *(const LAS f32x4*)(mT + k * 16 + 12);
                    a[0] += w * m0.x; a[1] += w * m0.y; a[2] += w * m0.z; a[3] += w * m0.w; a[4] += w * m1.x; a[5] += w * m1.y; a[6] += w * m1.z; a[7] += w * m1.w;
                    a[8] += w * m2.x; a[9] += w * m2.y; a[10] += w * m2.z; a[11] += w * m2.w; a[12] += w * m3.x; a[13] += w * m3.y; a[14] += w * m3.z; a[15] += w * m3.w; }
#pragma unroll
                for (int r = 0; r < 16; ++r) red[(ks * 16 + r) * 8 + c] = a[r];
                __syncthreads();
                if (tid < 128) { float s = 0.f;
                    for (int q = 0; q < 64; ++q) s += red[q * 128 + tid];
                    fin[tid] = s; }
                __syncthreads();
                if (tid < 8) { const int cl = cl0 + tid;
#pragma unroll
                    for (int r = 0; r < 16; ++r) a[r] = fin[r * 8 + tid];
                    if (grp == 0) {
#pragma unroll
                        for (int r = 0; r < 16; ++r) KNAm[r * 512 + cl] = f2bf(a[r]);
                    } else if (grp == 1) { const int h = cl >> 6, d = cl & 63;
#pragma unroll
                        for (int r = 0; r < 16; ++r) VTm[(h * 64 + d) * 16 + r] = f2bf(a[r]);
                    } else if (grp == 2) {
                        const float l0 = lb_logits[cl], l1 = lb_logits[512 + cl]; const float lb = 1.0f / (1.0f + expf(l1 - l0));
                        float bsum = 0.f;
#pragma unroll
                        for (int r = 0; r < 16; ++r) { const float f = lb + (1.0f - lb) / (1.0f + expf(-a[r])); bsum += logf(f); KFTm[cl * 16 + r] = f2bf((1.0f - f) * expf(-bsum)); }
                        GFm[cl] = expf(bsum);
                    } else {
#pragma unroll
                        for (int r = 0; r < 16; ++r) VHTm[cl * 16 + r] = f2bf(a[r]);
                    }
                }
                __syncthreads();
            }
        }
        if (bx == 32 % G) {
            for (int i = tid; i < 1024; i += NWAVES * 64) { const int dir = i >> 9, c = i & 511; const float l0 = lb_logits[dir * 1024 + c], l1 = lb_logits[dir * 1024 + 512 + c]; LB[i] = 1.0f / (1.0f + expf(l1 - l0)); }
        }
        LAS float* scr = (LAS float*)(lds + wave * 16384);
        constexpr int I_IN = (D / 64) * (NIN / 32), I_NA = (512 / 64) * (D / 32), I_O = (D / 64) * (D / 32), I_UP = (D / 64) * (FF / 32), I_DN = (FF / 64) * (D / 32);
        constexpr int NITEMS = I_IN + 2 * I_NA + I_O + I_UP + I_DN;
        for (int it = gw; it < NITEMS; it += NGW) {
            int r = it;
            if (r < I_IN) { tr_item(w_in, D, NIN, WT_in, (const float*)nullptr, scr, r, lane, CmIn()); continue; } r -= I_IN;
            if (r < I_NA) { tr_item(w_na, 512, D, WT_na, (const float*)nullptr, scr, r, lane, CmId()); continue; } r -= I_NA;
            if (r < I_NA) { tr_item(w_hg, 512, D, WT_hg, (const float*)nullptr, scr, r, lane, CmId()); continue; } r -= I_NA;
            if (r < I_O) { tr_item(w_o, D, D, WT_o, (const float*)nullptr, scr, r, lane, CmId()); continue; } r -= I_O;
            if (r < I_UP) { tr_item(w_up, D, FF, WT_up, g_mlp, scr, r, lane, CmId()); continue; } r -= I_UP;
            tr_item(w_dn, FF, D, WT_dn, (const float*)nullptr, scr, r, lane, CmId());
        }
        for (int m0 = gw; m0 < M; m0 += 4 * NGW) {
            f32x4 v[4][4];
            if (m0 == gw) {
#pragma unroll
                for (int q = 0; q < 4; ++q)
#pragma unroll
                    for (int j = 0; j < 4; ++j) v[q][j] = xv0[q][j];
            } else {
#pragma unroll
                for (int q = 0; q < 4; ++q)
#pragma unroll
                    for (int j = 0; j < 4; ++j) v[q][j] = *(const f32x4*)(x + (size_t)(m0 + q * NGW) * D + 4 * lane + 256 * j);
            }
#pragma unroll
            for (int q = 0; q < 4; ++q) { const int m = m0 + q * NGW; float s = 0.f;
#pragma unroll
                for (int j = 0; j < 4; ++j) s += (v[q][j].x * v[q][j].x + v[q][j].y * v[q][j].y) + (v[q][j].z * v[q][j].z + v[q][j].w * v[q][j].w);
                const float rs = rsqrtf(wave_sum(s) * (1.0f / D) + EPS);
#pragma unroll
                for (int j = 0; j < 4; ++j) { const f32x4 g = *(const f32x4*)(g_mix + 4 * lane + 256 * j);
                    v2u o; o.x = pk2(v[q][j].x * rs * g.x, v[q][j].y * rs * g.y); o.y = pk2(v[q][j].z * rs * g.z, v[q][j].w * rs * g.w);
                    *(v2u*)(XN + (size_t)m * D + 4 * lane + 256 * j) = o; } } }
    }
    xcd_barrier(bar);

    int vb = bx; bool xl = false;
    { const unsigned nloc = ((volatile LAS unsigned*)(lds + LDS_CTL + 32))[0], nx = ((volatile LAS unsigned*)(lds + LDS_CTL + 32))[1];
      bool even = (G == 256 && nloc == 32u && nx == 8u && bar.x < 8u && my_rank < 32u);
#pragma unroll
      for (int j = 0; j < 8; ++j) even = even && (xb_ld((unsigned*)(ws + WS_BAR) + XB_XCNT(j)) == 32u);
      if (even) { vb = (int)(my_rank * 8u + bar.x); xl = true; } }
    vb = __builtin_amdgcn_readfirstlane(vb);
#define PHASE_BAR() do { if (xl) xcd_local_barrier(bar); else xcd_barrier(bar); } while (0)
    const int xq = vb & 7, rk = vb >> 3, lw = rk * 8 + wave;
#define MK_EPI(NAME, MODE) pg8::EpiAll<MODE> NAME; NAME.ws = ws; NAME.out = out; NAME.x = x; NAME.gain = hg_gain; NAME.gfin = g_fin;
    {
        MK_EPI(E, pg8::EM_IN)
        pg8::Gemm g{XN, WT_in, M, NIN, D}; pg8::StaticOrder S; S.init(M, NIN, G, vb);
        pg8::gemm_phase<pg8::EpiAll<pg8::EM_IN>, pg8::StaticOrder, true, true>(lds, g, S, E);
    }
    PHASE_BAR();

    { const int wi = xq * 256 + lw;
        const int item = wi >> 2, vq = wi & 3, seg = item & 7, dir = (item >> 3) & 1, h = (item >> 4) & 3, b = item >> 6;
        f32x4 S[8][2], Dp[8];
#pragma unroll
        for (int kt = 0; kt < 8; ++kt) { S[kt][0] = (f32x4){0.f, 0.f, 0.f, 0.f}; S[kt][1] = (f32x4){0.f, 0.f, 0.f, 0.f}; Dp[kt] = (f32x4){1.f, 1.f, 1.f, 1.f}; }
        if (dir == 0 && seg == 0) hg_update<false>(S, Dp, KFTm, VHTm, GFm, (unsigned)(h * 128), vq, lm, kq);
        const bf16* KTp = dir ? KBT : KFT; const float* Gp = dir ? GB : GF;
        const int cstep = dir ? -512 : 512; const int cb0 = (b * 128 + seg * 16 + (dir ? 15 : 0)) * 512 + h * 128;
        {
            LAS unsigned char* stg0 = lds + (wave >> 2) * 9216;
            s16x4 kv[2][2], vbn[2][2], vbr[2][2]; v2u g8 = (v2u){0u, 0u};
#define B1_LOADS(IT) do { _Pragma("unroll") for (int u = 0; u < 2; ++u) { const unsigned cb_ = (unsigned)(cb0 + (2 * (IT) + u) * cstep); \
                _Pragma("unroll") for (int kk = 0; kk < 2; ++kk) kv[u][kk] = *(const s16x4*)(KTp + (unsigned)((cb_ + 16 * (2 * vq + kk) + lm) * 16 + 4 * kq)); \
                _Pragma("unroll") for (int vt = 0; vt < 2; ++vt) vbn[u][vt] = *(const s16x4*)(VHT + (unsigned)((cb_ + 32 * vq + 16 * vt + lm) * 16 + 4 * kq)); \
                if (vq == u) g8 = *(const v2u*)(Gp + cb_ + 2 * lane); } } while (0)
#define B1_STORE(STG) do { _Pragma("unroll") for (int u = 0; u < 2; ++u) { \
                _Pragma("unroll") for (int kk = 0; kk < 2; ++kk) *(LAS s16x4*)((STG) + (u * 8 + 2 * vq + kk) * 512 + lane * 8) = kv[u][kk]; \
                if (vq == u) *(LAS v2u*)((STG) + 8192 + u * 512 + lane * 8) = g8; } } while (0)
            __syncthreads();
            B1_LOADS(0);
            B1_STORE(stg0);
#pragma unroll
            for (int u = 0; u < 2; ++u) { vbr[u][0] = vbn[u][0]; vbr[u][1] = vbn[u][1]; }
            for (int it = 0; it < 8; ++it) {
                __syncthreads();
                LAS unsigned char* stg = stg0 + (it & 1) * 18432;
                if (it < 7) B1_LOADS(it + 1);
                __builtin_amdgcn_sched_barrier(0);
#pragma unroll
                for (int u = 0; u < 2; ++u)
#pragma unroll
                    for (int kt = 0; kt < 8; ++kt) { const s16x4 ka = *(const LAS s16x4*)(stg + (u * 8 + kt) * 512 + lane * 8); const f32x4 g = *(const LAS f32x4*)(stg + 8192 + u * 512 + (16 * kt + 4 * kq) * 4);
#pragma unroll
                        for (int vt = 0; vt < 2; ++vt) { S[kt][vt] = __builtin_amdgcn_mfma_f32_16x16x16bf16_1k(ka, vbr[u][vt], S[kt][vt], 0, 0, 0); S[kt][vt] = S[kt][vt] * g; }
                        Dp[kt] = Dp[kt] * g; }
                __builtin_amdgcn_sched_barrier(0);
                if (it < 7) { B1_STORE(stg0 + ((it + 1) & 1) * 18432);
#pragma unroll
                    for (int u = 0; u < 2; ++u) { vbr[u][0] = vbn[u][0]; vbr[u][1] = vbn[u][1]; } }
            }
#undef B1_LOADS
#undef B1_STORE
        }
        float* sp = SBUF + ((size_t)(item * 4 + vq) * 16) * 256 + lane * 4;
#pragma unroll
        for (int kt = 0; kt < 8; ++kt) { *(f32x4*)(sp + (kt * 2 + 0) * 256) = S[kt][0]; *(f32x4*)(sp + (kt * 2 + 1) * 256) = S[kt][1]; }
        if (vq == 0 && lm == 0) {
#pragma unroll
            for (int kt = 0; kt < 8; ++kt) *(f32x4*)(DSEG + item * 128 + 16 * kt + 4 * kq) = Dp[kt];
        }
    }
    PHASE_BAR();

    for (int i2 = 0; i2 < 2; ++i2) { const int tl = rk * 512 + tid + 16384 * i2;
        const int bhd = xq * 8 + (tl >> 12), e4 = tl & 4095, dir = bhd & 1; const int kt = (e4 >> 7) & 7, ln = e4 & 63; const int k0 = 16 * kt + 4 * (ln >> 4);
        f32x4 carry = (f32x4){0.f, 0.f, 0.f, 0.f}, locv[8], dv[8];
#pragma unroll
        for (int s = 0; s < 8; ++s) { const int seg = dir ? 7 - s : s, item = bhd * 8 + seg;
            locv[s] = *(const f32x4*)(SBUF + (size_t)item * 16384 + e4 * 4); dv[s] = *(const f32x4*)(DSEG + item * 128 + k0); }
#pragma unroll
        for (int s = 0; s < 8; ++s) { const int seg = dir ? 7 - s : s, item = bhd * 8 + seg;
            *(f32x4*)(SBUF + (size_t)item * 16384 + e4 * 4) = carry; carry = dv[s] * carry + locv[s]; }
    }
    {
        LAS float* rp = (LAS float*)lds;
        __syncthreads();
        for (int i = tid; i < 8 * 465; i += NWAVES * 64) rp[i] = rpb[i];
        __syncthreads();
        LAS unsigned char* KS = lds + 15360; LAS unsigned char* VS = lds + 15360 + 73728;
        int prev_hi = -1;
        for (int i4 = 0; i4 < 4; ++i4) {
            const int hh = rk >> 2, rg = rk & 3, rpair = 8 * rg + 2 * i4;
            const int cq = wave & 3, r = rpair + (wave >> 2), h = hh, b = xq;
            const int lo = min(max(rpair - 4, 0), 24);
            __syncthreads();
            { const int c = tid >> 3, q = tid & 7;
              if (i4 == 0) {
                v4u kreg[9], vreg[9];
#pragma unroll
                for (int e9 = 0; e9 < 9; ++e9) { const int row = min(lo + e9, 31);
                    kreg[e9] = *(const v4u*)(KNA + ((size_t)b * SEQ + row * 64 + c) * 512 + h * 64 + q * 8);
                    vreg[e9] = *(const v4u*)(VT + ((((size_t)(b * 8 + h) * 32 + row) * 64 + c) * 64 + q * 8)); }
#pragma unroll
                for (int e9 = 0; e9 < 9; ++e9) { const int kk = ((lo + e9) % 9) * 64 + c;
                    *(LAS v4u*)(KS + kk * 128 + ((q ^ (kk & 7)) * 16)) = kreg[e9]; *(LAS v4u*)(VS + kk * 128 + ((q ^ (kk & 7)) * 16)) = vreg[e9]; }
              } else {
                v4u kreg[2], vreg[2];
#pragma unroll
                for (int e2 = 0; e2 < 2; ++e2) { const int row = min(prev_hi + 1 + e2, 31);
                    kreg[e2] = *(const v4u*)(KNA + ((size_t)b * SEQ + row * 64 + c) * 512 + h * 64 + q * 8);
                    vreg[e2] = *(const v4u*)(VT + ((((size_t)(b * 8 + h) * 32 + row) * 64 + c) * 64 + q * 8)); }
#pragma unroll
                for (int e2 = 0; e2 < 2; ++e2) { const int row = prev_hi + 1 + e2;
                    if (row <= lo + 8 && row < 32) { const int kk = (row % 9) * 64 + c;
                        *(LAS v4u*)(KS + kk * 128 + ((q ^ (kk & 7)) * 16)) = kreg[e2]; *(LAS v4u*)(VS + kk * 128 + ((q ^ (kk & 7)) * 16)) = vreg[e2]; } }
              }
            }
            prev_hi = lo + 8;
            __syncthreads();
            const int c0 = 16 * cq, kc0 = (cq == 0) ? 0 : (cq == 1) ? 8 : (cq == 2) ? 24 : 32;
            const int rs0 = min(max(r - 4, 0), 24);
            const size_t rowq = (size_t)b * SEQ + r * 64 + c0 + lm;
            bf16x8 qf[2], kmf[2]; s16x4 vmf[4];
#pragma unroll
            for (int ks = 0; ks < 2; ++ks) { qf[ks] = *(const bf16x8*)(QNA + rowq * 512 + h * 64 + 32 * ks + 8 * kq); kmf[ks] = *(const bf16x8*)(KNAm + lm * 512 + h * 64 + 32 * ks + 8 * kq); }
#pragma unroll
            for (int dt = 0; dt < 4; ++dt) vmf[dt] = *(const s16x4*)(VTm + (h * 64 + 16 * dt + lm) * 16 + 4 * kq);
            const int cqq = c0 + lm, cs = min(max(cqq - 8, 0), 48);
            f32x4 oa[4];
#pragma unroll
            for (int dt = 0; dt < 4; ++dt) oa[dt] = (f32x4){0.f, 0.f, 0.f, 0.f};
            float mrun = -3.0e38f, lsum = 0.f;
#pragma unroll
            for (int hf = 0; hf < 2; ++hf) {
                f32x4 sc[9]; bf16x8 vf[4][4];
                {   bf16x8 kf[4][2][2];
#pragma unroll
                    for (int j4 = 0; j4 < 4; ++j4)
#pragma unroll
                        for (int t = 0; t < 2; ++t) { const int kcol = kc0 + 8 * (lm >> 2) + 4 * t + (lm & 3); const size_t rowk = (size_t)b * SEQ + (rs0 + 4 * hf + j4) * 64 + kcol;
#pragma unroll
                            for (int ks = 0; ks < 2; ++ks) { const int kk = ((rs0 + 4 * hf + j4) % 9) * 64 + kcol; kf[j4][t][ks] = *(const LAS bf16x8*)(KS + kk * 128 + (((ks * 4 + kq) ^ (kk & 7)) * 16)); } (void)rowk; }
                    __builtin_amdgcn_sched_barrier(0);
#pragma unroll
                    for (int j4 = 0; j4 < 4; ++j4)
#pragma unroll
                        for (int t = 0; t < 2; ++t) { f32x4 a = (f32x4){0.f, 0.f, 0.f, 0.f};
#pragma unroll
                            for (int ks = 0; ks < 2; ++ks) a = __builtin_amdgcn_mfma_f32_16x16x32_bf16(kf[j4][t][ks], qf[ks], a, 0, 0, 0);
                            sc[2 * j4 + t] = a; }
                }
                __builtin_amdgcn_sched_barrier(0);
#pragma unroll
                for (int j4 = 0; j4 < 4; ++j4)
#pragma unroll
                    for (int dt = 0; dt < 4; ++dt) { const int vv = ((rs0 + 4 * hf + j4) % 9) * 64 + 16 * dt + lm; vf[j4][dt] = *(const LAS bf16x8*)(VS + vv * 128 + ((((kc0 >> 3) + kq) ^ (vv & 7)) * 16)); }
                __builtin_amdgcn_sched_barrier(0);
                if (hf == 1) { f32x4 a = (f32x4){0.f, 0.f, 0.f, 0.f};
#pragma unroll
                    for (int ks = 0; ks < 2; ++ks) a = __builtin_amdgcn_mfma_f32_16x16x32_bf16(kmf[ks], qf[ks], a, 0, 0, 0);
                    sc[8] = a; } else sc[8] = (f32x4){-1e30f, -1e30f, -1e30f, -1e30f};
                float mx = -3.0e38f;
#pragma unroll
                for (int j4 = 0; j4 < 4; ++j4)
#pragma unroll
                    for (int t = 0; t < 2; ++t)
#pragma unroll
                        for (int j = 0; j < 4; ++j) { const int kcol = kc0 + 8 * kq + 4 * t + j; const bool inw = (kcol >= cs) && (kcol < cs + 16);
                            const int dr = rs0 + 4 * hf + j4 - r, dc = min(max(kcol - cqq, -15), 15);
                            const float bias = rp[h * 465 + (dr + 7) * 31 + dc + 15];
                            const float s = inw ? sc[2 * j4 + t][j] + bias : -1e30f; sc[2 * j4 + t][j] = s; mx = fmaxf(mx, s); }
#pragma unroll
                for (int j = 0; j < 4; ++j) mx = fmaxf(mx, sc[8][j]);
                mx = fmaxf(mx, __shfl_xor(mx, 16)); mx = fmaxf(mx, __shfl_xor(mx, 32));
                const float mnew = fmaxf(mrun, mx), alpha = __expf(mrun - mnew);
                mrun = mnew; lsum *= alpha;
#pragma unroll
                for (int dt = 0; dt < 4; ++dt) oa[dt] = oa[dt] * alpha;
#pragma unroll
                for (int i = 0; i < 9; ++i)
#pragma unroll
                    for (int j = 0; j < 4; ++j) { const float p = __expf(sc[i][j] - mnew); sc[i][j] = p; lsum += p; }
#pragma unroll
                for (int j4 = 0; j4 < 4; ++j4) {
                    union { bf16x8 v; unsigned u[4]; } pf;
                    pf.u[0] = cvt_pk_bf16(sc[2 * j4][0], sc[2 * j4][1]); pf.u[1] = cvt_pk_bf16(sc[2 * j4][2], sc[2 * j4][3]);
                    pf.u[2] = cvt_pk_bf16(sc[2 * j4 + 1][0], sc[2 * j4 + 1][1]); pf.u[3] = cvt_pk_bf16(sc[2 * j4 + 1][2], sc[2 * j4 + 1][3]);
#pragma unroll
                    for (int dt = 0; dt < 4; ++dt) oa[dt] = __builtin_amdgcn_mfma_f32_16x16x32_bf16(vf[j4][dt], pf.v, oa[dt], 0, 0, 0); }
                if (hf == 1) { union { s16x4 v; unsigned u[2]; } pm; pm.u[0] = cvt_pk_bf16(sc[8][0], sc[8][1]); pm.u[1] = cvt_pk_bf16(sc[8][2], sc[8][3]);
#pragma unroll
                    for (int dt = 0; dt < 4; ++dt) oa[dt] = __builtin_amdgcn_mfma_f32_16x16x16bf16_1k(vmf[dt], pm.v, oa[dt], 0, 0, 0); }
            }
            lsum += __shfl_xor(lsum, 16); lsum += __shfl_xor(lsum, 32);
            const float inv = 1.0f / lsum;
#pragma unroll
            for (int dt = 0; dt < 4; ++dt) { v2u o; o.x = cvt_pk_bf16(oa[dt][0] * inv, oa[dt][1] * inv); o.y = cvt_pk_bf16(oa[dt][2] * inv, oa[dt][3] * inv);
                *(v2u*)(ONA + rowq * 512 + h * 64 + 16 * dt + 4 * kq) = o; }
        }
        __syncthreads();
    }
    PHASE_BAR();

    { const int it = xq * 32 + rk;
        const int seg = it & 7, h = (it >> 3) & 3, b = it >> 5;
        const int dir = wave >> 2, vq = wave & 3, sitem = ((b * 4 + h) * 2 + dir) * 8 + seg;
        LAS unsigned short* ob = (LAS unsigned short*)lds;
        LAS unsigned char* stg0 = lds + 65536 + dir * 17408;
        __syncthreads();
        f32x4 S[8][2], Dp[8];
        { const float* sp = SBUF + ((size_t)(sitem * 4 + vq) * 16) * 256 + lane * 4;
#pragma unroll
          for (int kt = 0; kt < 8; ++kt) { S[kt][0] = *(const f32x4*)(sp + (kt * 2 + 0) * 256); S[kt][1] = *(const f32x4*)(sp + (kt * 2 + 1) * 256); Dp[kt] = (f32x4){1.f, 1.f, 1.f, 1.f}; } }
        if (dir == 0 && seg == 0) hg_update<false>(S, Dp, KFTm, VHTm, GFm, (unsigned)(h * 128), vq, lm, kq);
        const bf16* Qn = dir ? QB : QF; const bf16* Kn = dir ? KB : KF; const bf16* KTp = dir ? KBT : KFT; const float* Gp = dir ? GB : GF;
        {
            LAS v2u* PA = (LAS v2u*)(lds + 135168);
            bf16x8 kn4[4][4], qn4[4][4];
#pragma unroll
            for (int q = 0; q < 4; ++q) { const size_t r0 = ((size_t)b * 128 + seg * 16 + vq + 4 * q) * 16;
#pragma unroll
                for (int ii = 0; ii < 4; ++ii) { const size_t o = (r0 + lm) * 512 + h * 128 + 32 * ii + 8 * kq; kn4[q][ii] = *(const bf16x8*)(Kn + o); qn4[q][ii] = *(const bf16x8*)(Qn + o); } }
#pragma unroll
            for (int q = 0; q < 4; ++q) { f32x4 at = (f32x4){0.f, 0.f, 0.f, 0.f};
#pragma unroll
                for (int ii = 0; ii < 4; ++ii) at = __builtin_amdgcn_mfma_f32_16x16x32_bf16(kn4[q][ii], qn4[q][ii], at, 0, 0, 0);
#pragma unroll
                for (int j = 0; j < 4; ++j) { const int s = 4 * kq + j; const bool keep = dir ? (s >= lm) : (s <= lm); at[j] = keep ? at[j] : 0.f; }
                v2u w; w.x = cvt_pk_bf16(at[0], at[1]); w.y = cvt_pk_bf16(at[2], at[3]);
                PA[(dir * 16 + vq + 4 * q) * 64 + lane] = w; }
        }
        __syncthreads();
        s16x4 qv[2][2], kv[2][2], vbn[2][2]; v2u g8 = (v2u){0u, 0u};
#define B3_LOADS(IT) do { _Pragma("unroll") for (int u = 0; u < 2; ++u) { const int cl_ = dir ? 15 - (2 * (IT) + u) : 2 * (IT) + u; const size_t cgi_ = (size_t)b * 128 + seg * 16 + cl_, row0_ = cgi_ * 16; const unsigned cb_ = (unsigned)(cgi_ * 512 + h * 128); \
            _Pragma("unroll") for (int kk = 0; kk < 2; ++kk) { const int kt_ = 2 * vq + kk; \
                qv[u][kk] = *(const s16x4*)(Qn + (row0_ + lm) * 512 + h * 128 + 16 * kt_ + 4 * kq); \
                kv[u][kk] = *(const s16x4*)(KTp + (unsigned)((cb_ + 16 * kt_ + lm) * 16 + 4 * kq)); } \
            _Pragma("unroll") for (int vt = 0; vt < 2; ++vt) vbn[u][vt] = *(const s16x4*)(VHT + (unsigned)((cb_ + 32 * vq + 16 * vt + lm) * 16 + 4 * kq)); \
            if (vq == u) g8 = *(const v2u*)(Gp + cb_ + 2 * lane); } } while (0)
#define B3_STORE(STG) do { _Pragma("unroll") for (int u = 0; u < 2; ++u) { \
            _Pragma("unroll") for (int kk = 0; kk < 2; ++kk) { const int f_ = u * 8 + 2 * vq + kk; \
                *(LAS s16x4*)((STG) + f_ * 512 + lane * 8) = qv[u][kk]; *(LAS s16x4*)((STG) + 8192 + f_ * 512 + lane * 8) = kv[u][kk]; } \
            if (vq == u) *(LAS v2u*)((STG) + 16384 + u * 512 + lane * 8) = g8; } } while (0)
        B3_LOADS(0);
        B3_STORE(stg0);
        s16x4 vbr[2][2];
#pragma unroll
        for (int u = 0; u < 2; ++u) { vbr[u][0] = vbn[u][0]; vbr[u][1] = vbn[u][1]; }
        for (int it = 0; it < 8; ++it) {
            __syncthreads();
            LAS unsigned char* stg = stg0 + (it & 1) * 34816;
            if (it < 7) B3_LOADS(it + 1);
            __builtin_amdgcn_sched_barrier(0);
#pragma unroll
            for (int u = 0; u < 2; ++u) { const int cl = dir ? 15 - (2 * it + u) : 2 * it + u;
                union { s16x4 v; v2u u2; } pa; pa.u2 = ((const LAS v2u*)(lds + 135168))[(dir * 16 + cl) * 64 + lane];
                f32x4 o2[2]; o2[0] = (f32x4){0.f, 0.f, 0.f, 0.f}; o2[1] = (f32x4){0.f, 0.f, 0.f, 0.f};
#pragma unroll
                for (int kt = 0; kt < 8; ++kt) { const s16x4 q4 = *(const LAS s16x4*)(stg + (u * 8 + kt) * 512 + lane * 8);
#pragma unroll
                    for (int vt = 0; vt < 2; ++vt) { union { s16x4 v; unsigned u[2]; } sb; sb.u[0] = cvt_pk_bf16(S[kt][vt][0], S[kt][vt][1]); sb.u[1] = cvt_pk_bf16(S[kt][vt][2], S[kt][vt][3]);
                        o2[vt] = __builtin_amdgcn_mfma_f32_16x16x16bf16_1k(q4, sb.v, o2[vt], 0, 0, 0); } }
#pragma unroll
                for (int vt = 0; vt < 2; ++vt) { o2[vt] = __builtin_amdgcn_mfma_f32_16x16x16bf16_1k(pa.v, vbr[u][vt], o2[vt], 0, 0, 0);
#pragma unroll
                    for (int j = 0; j < 4; ++j) { LAS unsigned short* op = ob + (16 * cl + 4 * kq + j) * 128 + 32 * vq + 16 * vt + lm;
                        const float val = (it < 4) ? o2[vt][j] : (bflo((unsigned)*op) + o2[vt][j]); *op = f2bf(val); } }
#pragma unroll
                for (int kt = 0; kt < 8; ++kt) { const s16x4 ka = *(const LAS s16x4*)(stg + 8192 + (u * 8 + kt) * 512 + lane * 8); const f32x4 g = *(const LAS f32x4*)(stg + 16384 + u * 512 + (16 * kt + 4 * kq) * 4);
#pragma unroll
                    for (int vt = 0; vt < 2; ++vt) { S[kt][vt] = __builtin_amdgcn_mfma_f32_16x16x16bf16_1k(ka, vbr[u][vt], S[kt][vt], 0, 0, 0); S[kt][vt] = S[kt][vt] * g; } }
            }
            __builtin_amdgcn_sched_barrier(0);
            if (it < 7) { B3_STORE(stg0 + ((it + 1) & 1) * 34816);
#pragma unroll
                for (int u = 0; u < 2; ++u) { vbr[u][0] = vbn[u][0]; vbr[u][1] = vbn[u][1]; } }
        }
#undef B3_LOADS
#undef B3_STORE
        v4u ggp[8];
#pragma unroll
        for (int i = 0; i < 8; ++i) ggp[i] = *(const v4u*)(GHG + ((size_t)b * SEQ + seg * 256 + wave * 32 + 4 * i + kq) * 512 + h * 128 + 8 * lm);
        __syncthreads();
#pragma unroll
        for (int i = 0; i < 8; ++i) { const int tl = wave * 32 + 4 * i + kq; const size_t row = (size_t)b * SEQ + seg * 256 + tl;
            const v4u ov = *(const LAS v4u*)(ob + tl * 128 + 8 * lm);
            const f32x4 v0 = (f32x4){bflo(ov.x), bfhi(ov.x), bflo(ov.y), bfhi(ov.y)}, v1 = (f32x4){bflo(ov.z), bfhi(ov.z), bflo(ov.w), bfhi(ov.w)};
            const v4u gg = ggp[i];
            float s = (v0.x * v0.x + v0.y * v0.y) + (v0.z * v0.z + v0.w * v0.w) + (v1.x * v1.x + v1.y * v1.y) + (v1.z * v1.z + v1.w * v1.w);
            s += __shfl_xor(s, 1); s += __shfl_xor(s, 2); s += __shfl_xor(s, 4); s += __shfl_xor(s, 8);
            const float rs = rsqrtf(s * (1.0f / 128.0f) + EPS);
            v4u o; o.x = cvt_pk_bf16(v0.x * rs * bflo(gg.x), v0.y * rs * bfhi(gg.x)); o.y = cvt_pk_bf16(v0.z * rs * bflo(gg.y), v0.w * rs * bfhi(gg.y));
            o.z = cvt_pk_bf16(v1.x * rs * bflo(gg.z), v1.y * rs * bfhi(gg.z)); o.w = cvt_pk_bf16(v1.z * rs * bflo(gg.w), v1.w * rs * bfhi(gg.w));
            *(v4u*)(OHG + row * 512 + h * 128 + 8 * lm) = o; }
        __syncthreads();
    }
    PHASE_BAR();

    {
        MK_EPI(E, pg8::EM_C1A)
        pg8::Gemm g{ONA, WT_na, 2 * M, 2 * D, 512}; pg8::PairOrder S; S.init(M, D, G, vb);
        pg8::gemm_phase<pg8::EpiAll<pg8::EM_C1A>, pg8::PairOrder, true, true>(lds, g, S, E);
    }
    PHASE_BAR();
    {
        MK_EPI(E, pg8::EM_C2)
        pg8::Gemm g{MIX, WT_o, M, D, D}; pg8::StaticOrder S; S.init(M, D, G, vb);
        pg8::gemm_phase<pg8::EpiAll<pg8::EM_C2>, pg8::StaticOrder, true, true>(lds, g, S, E);
    }
    PHASE_BAR();
    {
        MK_EPI(E, pg8::EM_C3)
        pg8::Gemm g{H1B, WT_up, M, FF, D}; pg8::StaticOrder S; S.init(M, FF, G, vb);
        pg8::gemm_phase<pg8::EpiAll<pg8::EM_C3>, pg8::StaticOrder, true, true>(lds, g, S, E);
    }
    PHASE_BAR();
    {
        MK_EPI(E, pg8::EM_C4)
        pg8::Gemm g{U, WT_dn, M, D, FF}; pg8::StaticOrder S; S.init(M, D, G, vb);
        pg8::gemm_phase<pg8::EpiAll<pg8::EM_C4>, pg8::StaticOrder, true, true>(lds, g, S, E);
    }

}

extern "C" void kernel_launch(void* const* d_in, const int* in_sizes, int n_in, void* d_out, int out_size, void* d_ws, size_t ws_size, hipStream_t stream) {
    static int grid = 0;
    if (grid == 0) {
        if (n_in != 14 || in_sizes[0] != M * D || out_size != M * D || ws_size < WS_END) { fprintf(stderr, "kernel_launch: unexpected shapes / workspace (n_in %d, in0 %d, out %d, ws %zu)\n", n_in, n_in > 0 ? in_sizes[0] : -1, out_size, ws_size); grid = -1; return; }
        int dev = 0, cus = 0, per_cu = 0;
        if (hipGetDevice(&dev) != hipSuccess || hipDeviceGetAttribute(&cus, hipDeviceAttributeMultiprocessorCount, dev) != hipSuccess) { grid = -1; return; }
        if (hipFuncSetAttribute((const void*)mk_fwd, hipFuncAttributeMaxDynamicSharedMemorySize, LDS_BYTES) != hipSuccess) { fprintf(stderr, "kernel_launch: hipFuncSetAttribute failed\n"); grid = -1; return; }
        if (hipOccupancyMaxActiveBlocksPerMultiprocessor(&per_cu, (const void*)mk_fwd, NWAVES * 64, LDS_BYTES) != hipSuccess || per_cu < 1) { fprintf(stderr, "kernel_launch: occupancy query failed (%d)\n", per_cu); (void)hipGetLastError(); per_cu = 1; }
        if (cus != 256) fprintf(stderr, "kernel_launch: built for a 256-CU device (found %d)\n", cus);
        grid = 256;
    }
    if (grid < 0) return;
    Args a{};
    for (int i = 0; i < 14; ++i) a.in[i] = (const float*)d_in[i];
    a.out = (float*)d_out; a.ws = (unsigned char*)d_ws;
    if (hipMemsetAsync((char*)d_ws + WS_BAR, 0, BAR_BYTES, stream) != hipSuccess) { fprintf(stderr, "kernel_launch: memset failed\n"); return; }
    hipLaunchKernelGGL(mk_fwd, dim3(grid), dim3(NWAVES * 64), LDS_BYTES, stream, a);
    const hipError_t e = hipPeekAtLastError();
    if (e != hipSuccess) fprintf(stderr, "kernel_launch: launch failed: %s (grid %d)\n", hipGetErrorName(e), grid);
}
```

```cpp
#include <hip/hip_runtime.h>
#include <cstdio>
#include <cstdint>
constexpr int NWAVES = 8;
constexpr int NB = 8, SEQ = 2048, D = 1024, M = NB * SEQ, NIN = 6144, FF = 4096;
constexpr float EPS = 1e-6f;
constexpr size_t MiB = 1u << 20, KiB = 1024;
constexpr size_t WS_SSQ1 = 245 * MiB, WS_SSQ2 = 246 * MiB,
                WS_KNAM = 128 * KiB, WS_VTM = 144 * KiB, WS_KFTM = 160 * KiB, WS_VHTM = 176 * KiB, WS_GFM = 192 * KiB, WS_LB = 196 * KiB, WS_DSEG = 256 * KiB;
constexpr size_t WS_WIN = 1 * MiB, WS_WNA = 13 * MiB, WS_WHG = 14 * MiB, WS_WO = 15 * MiB, WS_WUP = 17 * MiB, WS_WDN = 237 * MiB;
constexpr size_t WS_XN = 25 * MiB;
constexpr size_t WS_QNA = 57 * MiB, WS_KNA = 73 * MiB, WS_VT = 89 * MiB, WS_QF = 105 * MiB, WS_QB = 121 * MiB, WS_KF = 137 * MiB, WS_KFT = 153 * MiB, WS_KB = 169 * MiB, WS_KBT = 185 * MiB,
                 WS_VHT = 201 * MiB, WS_GHG = 217 * MiB, WS_GF = 233 * MiB, WS_GB = 235 * MiB;
constexpr size_t WS_OHG = WS_KNA;
constexpr size_t WS_T = WS_VT, WS_MIX = WS_KF, WS_U = WS_QNA, WS_END = 247 * MiB;
constexpr int LDS_BYTES = 163840, LDS_CTL = 162816;
constexpr size_t WS_C4CNT = 768 * 1024 + 16 * 1024;

namespace pg8 {
#define PG8_LAS __attribute__((address_space(3)))
typedef unsigned short bf16_t;
typedef short bf16x8 __attribute__((ext_vector_type(8)));
typedef float f32x4 __attribute__((ext_vector_type(4)));
typedef unsigned u32x4 __attribute__((ext_vector_type(4)));
constexpr int BM = 256, BK = 64, HALF = 128, HTB = HALF * BK * 2  , STAGE_BYTES = 8 * HTB, NXCD = 8, WGM = 8;

__host__ __device__ __forceinline__ int lds_byte(int r, int c) { const int st = (r >> 4) * 2 + (c >> 5), rr = r & 15, cc = c & 31, ob = rr * 64 + cc * 2; return st * 1024 + (ob ^ (((ob >> 9) & 1) << 5)); }
__host__ __device__ __forceinline__ void stage_rc(int b, int& R, int& C) { const int st = b / 1024, sb = b % 1024, swz = sb ^ (((sb >> 9) & 1) << 5); R = (st >> 1) * 16 + swz / 64; C = (st & 1) * 32 + (swz % 64) / 2; }
__host__ __device__ __forceinline__ int perm32(int rho) { const int n = rho >> 4, i = rho & 15; return 8 * (i >> 2) + 4 * n + (i & 3); }

struct Unit { int pm, pn; };
struct Gemm { const bf16_t* A; const bf16_t* Bt; int M, N, K; };

struct StaticOrder {
    int nM, nN, nwg, G, c;
    __host__ __device__ void init(int M, int N, int G_, int c_) { nM = M / BM; nN = N / BM; nwg = nM * nN; G = G_; c = c_; }
    __host__ __device__ bool next(int i, Unit& u) const {
        const long L = (long)i * G + c; if (L >= nwg) return false;
        int wgid = (int)L; { const int q = nwg / NXCD, r = nwg % NXCD, xcd = wgid % NXCD, off = wgid / NXCD; wgid = (xcd < r ? xcd * (q + 1) : r * (q + 1) + (xcd - r) * q) + off; }
        const int nig = WGM * nN, gid = wgid / nig, fm = gid * WGM, gsz = (nM - fm) < WGM ? (nM - fm) : WGM;
        u.pm = fm + ((wgid % nig) % gsz); u.pn = (wgid % nig) / gsz; return true;
    }
    __device__ __forceinline__ void a_ready(const Unit&) const {}
    __device__ __forceinline__ void done(const Unit&) const {}
};


struct PairOrder {
    StaticOrder base; Unit u0;
    __host__ __device__ void init(int M_, int N_, int G_, int c_) { base.init(M_, N_, G_, c_); base.next(0, u0); }
    __host__ __device__ bool next(int i, Unit& u) const { if (i >= 2) return false; u.pm = u0.pm + 64 * i; u.pn = u0.pn + 4 * i; return true; }
    __device__ __forceinline__ void a_ready(const Unit&) const {}
    __device__ __forceinline__ void done(const Unit&) const {}
};

typedef float cvt_f32x2_t __attribute__((ext_vector_type(2)));
typedef __bf16 cvt_bf16x2_t __attribute__((ext_vector_type(2)));
__device__ __forceinline__ unsigned cvt_pk_bf16(float lo, float hi) { const cvt_f32x2_t v = {lo, hi}; const cvt_bf16x2_t b = __builtin_convertvector(v, cvt_bf16x2_t); return __builtin_bit_cast(unsigned, b); }
__device__ __forceinline__ unsigned short f2bf(float f) { unsigned u = __builtin_bit_cast(unsigned, f); return (unsigned short)((u + 0x7fffu + ((u >> 16) & 1u)) >> 16); }
__device__ __forceinline__ float bflo(unsigned w) { return __builtin_bit_cast(float, w << 16); }
__device__ __forceinline__ float bfhi(unsigned w) { return __builtin_bit_cast(float, w & 0xffff0000u); }
__device__ __forceinline__ float sigm(float x) { return __builtin_amdgcn_rcpf(1.0f + __expf(-x)); }
template <int CTRL> __device__ __forceinline__ float dpp_mov(float v) { return __builtin_bit_cast(float, __builtin_amdgcn_update_dpp(0, __builtin_bit_cast(int, v), CTRL, 0xf, 0xf, true)); }
__device__ __forceinline__ float row_prefix16(float v, int fr) {
    v += dpp_mov<0x111>(v); v += dpp_mov<0x112>(v); v += dpp_mov<0x114>(v); v += dpp_mov<0x118>(v); (void)fr;
    return v;
}
__device__ __forceinline__ float row_suffix16(float v, int fr) {
    v += dpp_mov<0x101>(v); v += dpp_mov<0x102>(v); v += dpp_mov<0x104>(v); v += dpp_mov<0x108>(v); (void)fr;
    return v;
}

enum EpiMode { EM_IN = 0, EM_C1A = 1, EM_C1B = 2, EM_C2 = 3, EM_C3 = 4, EM_C4 = 5 };
template <int MODE> struct EpiAll {
    static constexpr bool PERM = true, AFTER_DRAIN = false;
    static constexpr int mode = MODE; unsigned char* ws; float* out; const float* x; const float* gain; const float* gfin;
    __device__ __forceinline__ void operator()(const f32x4 (&acc)[2][2][4][2], const Unit& u, int wr, int wc, int fr, int fq) const {
        const int pn = u.pn;
        const int row0 = u.pm * BM + wr * 64 + fr;
#define EP_B(off) ((bf16_t*)(ws + (off)))
#define EP_F(off) ((float*)(ws + (off)))
        bf16_t* const QNA = EP_B(WS_QNA); bf16_t* const KNA = EP_B(WS_KNA); bf16_t* const VT = EP_B(WS_VT); bf16_t* const QF = EP_B(WS_QF); bf16_t* const QB = EP_B(WS_QB); bf16_t* const KF = EP_B(WS_KF); bf16_t* const KB = EP_B(WS_KB);
        bf16_t* const KFT = EP_B(WS_KFT); bf16_t* const KBT = EP_B(WS_KBT); bf16_t* const VHT = EP_B(WS_VHT); bf16_t* const GHG = EP_B(WS_GHG); float* const GF = EP_F(WS_GF); float* const GB = EP_F(WS_GB); const float* const LB = EP_F(WS_LB);
        bf16_t* const SNA = (bf16_t*)out; bf16_t* const SHG = (bf16_t*)out + (size_t)M * D;
        bf16_t* const T = EP_B(WS_T); bf16_t* const MIX = EP_B(WS_MIX); bf16_t* const H1B = EP_B(WS_XN); bf16_t* const U = EP_B(WS_U); float* const ssq1 = EP_F(WS_SSQ1); float* const ssq2 = EP_F(WS_SSQ2);
#undef EP_B
#undef EP_F
        const int cl0 = wc * 32 + 8 * fq;
        if (mode == EM_IN) {
            if (pn < 4) {
                bf16_t* base = (pn < 2) ? QNA : KNA; const float sc = (pn < 2) ? 0.125f : 1.0f; const int colt = (pn & 1) * 256 + cl0;
#pragma unroll
                for (int ai = 0; ai < 2; ++ai)
#pragma unroll
                    for (int m = 0; m < 4; ++m) { bf16_t* rowp = base + (size_t)(row0 + ai * HALF + m * 16) * 512 + colt;
#pragma unroll
                        for (int bj = 0; bj < 2; ++bj) { const f32x4 v0 = acc[ai][bj][m][0] * sc, v1 = acc[ai][bj][m][1] * sc; u32x4 w;
                            w.x = cvt_pk_bf16(v0[0], v0[1]); w.y = cvt_pk_bf16(v0[2], v0[3]); w.z = cvt_pk_bf16(v1[0], v1[1]); w.w = cvt_pk_bf16(v1[2], v1[3]);
                            *(u32x4*)(rowp + bj * HALF) = w; } }
            } else if (pn < 6) {
                const int colt = (pn - 4) * 256 + cl0;
#pragma unroll
                for (int ai = 0; ai < 2; ++ai)
#pragma unroll
                    for (int m = 0; m < 4; ++m) { const int row = row0 + ai * HALF + m * 16; const int b = row >> 11, t = row & 2047, r = t >> 6, c = t & 63;
#pragma unroll
                        for (int bj = 0; bj < 2; ++bj) { const int col = colt + bj * HALF; const int h = col >> 6, d0 = col & 63;
                            bf16_t* bp = VT + ((((size_t)(b * 8 + h) * 32 + r) * 64 + d0) * 64 + c);
#pragma unroll
                            for (int n = 0; n < 2; ++n)
#pragma unroll
                                for (int j = 0; j < 4; ++j) bp[(4 * n + j) * 64] = f2bf(acc[ai][bj][m][n][j]); } }
            } else if (pn < 14) {
                const int ch0 = (pn - 6) * 64 + wc * 16 + fq * 4;
                const f32x4 lbf = *(const f32x4*)(LB + ch0), lbb = *(const f32x4*)(LB + 512 + ch0);
#pragma unroll
                for (int ai = 0; ai < 2; ++ai)
#pragma unroll
                    for (int m = 0; m < 4; ++m) { const int row = row0 + ai * HALF + m * 16; const int chunk = row >> 4;
                        const f32x4 q = acc[ai][0][m][0], zf = acc[ai][0][m][1], zb = acc[ai][1][m][0], iv = acc[ai][1][m][1];
                        float qfv[4], kfv[4], qbv[4], kbv[4]; f32x4 gfv, gbv;
#pragma unroll
                        for (int j = 0; j < 4; ++j) {
                            const float qs = q[j] * sigm(q[j]);
                            const float ff = lbf[j] + (1.0f - lbf[j]) * sigm(zf[j]);
                            const float fb = lbb[j] + (1.0f - lbb[j]) * sigm(zb[j]);
                            const float bf_ = row_prefix16(__builtin_amdgcn_logf(ff) * 0.69314718056f, fr), bb_ = row_suffix16(__builtin_amdgcn_logf(fb) * 0.69314718056f, fr);
                            const float ef = __expf(bf_), eb = __expf(bb_);
                            qfv[j] = qs * ef; kfv[j] = (1.0f - ff) * __expf(-bf_);
                            qbv[j] = qs * eb; kbv[j] = (1.0f - fb) * __expf(-bb_);
                            gfv[j] = ef; gbv[j] = eb;
                        }
                        typedef unsigned u32x2 __attribute__((ext_vector_type(2)));
                        const size_t ro = (size_t)row * 512 + ch0;
                        u32x2 w;
                        w.x = cvt_pk_bf16(qfv[0], qfv[1]); w.y = cvt_pk_bf16(qfv[2], qfv[3]); *(u32x2*)(QF + ro) = w;
                        w.x = cvt_pk_bf16(qbv[0], qbv[1]); w.y = cvt_pk_bf16(qbv[2], qbv[3]); *(u32x2*)(QB + ro) = w;
                        w.x = cvt_pk_bf16(kfv[0], kfv[1]); w.y = cvt_pk_bf16(kfv[2], kfv[3]); *(u32x2*)(KF + ro) = w;
                        w.x = cvt_pk_bf16(kbv[0], kbv[1]); w.y = cvt_pk_bf16(kbv[2], kbv[3]); *(u32x2*)(KB + ro) = w;
                        const size_t to = ((size_t)chunk * 512 + ch0) * 16 + fr;
#pragma unroll
                        for (int j = 0; j < 4; ++j) { KFT[to + j * 16] = f2bf(kfv[j]); KBT[to + j * 16] = f2bf(kbv[j]); VHT[to + j * 16] = f2bf(iv[j]); }
                        if (fr == 15) *(f32x4*)(GF + (size_t)chunk * 512 + ch0) = gfv;
                        if (fr == 0)  *(f32x4*)(GB + (size_t)chunk * 512 + ch0) = gbv;
                    }
            } else if (pn < 16) {
                const int colt = (pn - 14) * 256 + cl0;
#pragma unroll
                for (int bj = 0; bj < 2; ++bj) { const f32x4 g0 = *(const f32x4*)(gain + colt + bj * HALF), g1 = *(const f32x4*)(gain + colt + bj * HALF + 4);
#pragma unroll
                    for (int ai = 0; ai < 2; ++ai)
#pragma unroll
                        for (int m = 0; m < 4; ++m) { f32x4 v0 = acc[ai][bj][m][0], v1 = acc[ai][bj][m][1];
#pragma unroll
                            for (int j = 0; j < 4; ++j) { v0[j] = v0[j] * sigm(v0[j]) * g0[j]; v1[j] = v1[j] * sigm(v1[j]) * g1[j]; }
                            u32x4 w; w.x = cvt_pk_bf16(v0[0], v0[1]); w.y = cvt_pk_bf16(v0[2], v0[3]); w.z = cvt_pk_bf16(v1[0], v1[1]); w.w = cvt_pk_bf16(v1[2], v1[3]);
                            *(u32x4*)(GHG + (size_t)(row0 + ai * HALF + m * 16) * 512 + colt + bj * HALF) = w; } }
            } else {
                bf16_t* base = (pn < 20) ? SNA : SHG; const int colt = ((pn - 16) & 3) * 256 + cl0;
#pragma unroll
                for (int ai = 0; ai < 2; ++ai)
#pragma unroll
                    for (int m = 0; m < 4; ++m)
#pragma unroll
                        for (int bj = 0; bj < 2; ++bj) { f32x4 v0 = acc[ai][bj][m][0], v1 = acc[ai][bj][m][1];
#pragma unroll
                            for (int j = 0; j < 4; ++j) { v0[j] = sigm(v0[j]); v1[j] = sigm(v1[j]); }
                            u32x4 w; w.x = cvt_pk_bf16(v0[0], v0[1]); w.y = cvt_pk_bf16(v0[2], v0[3]); w.z = cvt_pk_bf16(v1[0], v1[1]); w.w = cvt_pk_bf16(v1[2], v1[3]);
                            *(u32x4*)(base + (size_t)(row0 + ai * HALF + m * 16) * 1024 + colt + bj * HALF) = w; }
            }
            return;
        }
        const int colt = (mode == EM_C1A ? (pn & 3) : pn) * BM + cl0;
        if (mode == EM_C1A || mode == EM_C1B) {
            const bool second = (mode == EM_C1B) || (pn >= 4); const int row0c = (mode == EM_C1A) ? (row0 & (M - 1)) : row0;
            const bf16_t* gate = second ? SHG : SNA; bf16_t* dst = second ? MIX : T;
#pragma unroll
            for (int ai = 0; ai < 2; ++ai) {
                u32x4 gv[4][2], tv[4][2];
#pragma unroll
                for (int m = 0; m < 4; ++m)
#pragma unroll
                    for (int bj = 0; bj < 2; ++bj) { const size_t off = (size_t)(row0c + ai * HALF + m * 16) * 1024 + colt + bj * HALF;
                        gv[m][bj] = *(const u32x4*)(gate + off); if (second) tv[m][bj] = *(const u32x4*)(T + off); else tv[m][bj] = (u32x4){0u, 0u, 0u, 0u}; }
#pragma unroll
                for (int m = 0; m < 4; ++m)
#pragma unroll
                    for (int bj = 0; bj < 2; ++bj) { const size_t off = (size_t)(row0c + ai * HALF + m * 16) * 1024 + colt + bj * HALF;
                        const u32x4 g = gv[m][bj], tt = tv[m][bj]; const f32x4 a0 = acc[ai][bj][m][0], a1 = acc[ai][bj][m][1];
                        const float r0 = a0[0] * bflo(g.x) + bflo(tt.x), r1 = a0[1] * bfhi(g.x) + bfhi(tt.x), r2 = a0[2] * bflo(g.y) + bflo(tt.y), r3 = a0[3] * bfhi(g.y) + bfhi(tt.y);
                        const float r4 = a1[0] * bflo(g.z) + bflo(tt.z), r5 = a1[1] * bfhi(g.z) + bfhi(tt.z), r6 = a1[2] * bflo(g.w) + bflo(tt.w), r7 = a1[3] * bfhi(g.w) + bfhi(tt.w);
                        u32x4 w; w.x = cvt_pk_bf16(r0, r1); w.y = cvt_pk_bf16(r2, r3); w.z = cvt_pk_bf16(r4, r5); w.w = cvt_pk_bf16(r6, r7);
                        *(u32x4*)(dst + off) = w; }
            }
        } else if (mode == EM_C4) {
            f32x4 (&hacc)[2][2][4][2] = const_cast<f32x4 (&)[2][2][4][2]>(acc);
#pragma unroll
            for (int ai = 0; ai < 2; ++ai)
#pragma unroll
                for (int mp = 0; mp < 2; ++mp) {
                    f32x4 pre[2][2][2];
#pragma unroll
                    for (int mm = 0; mm < 2; ++mm)
#pragma unroll
                        for (int bj = 0; bj < 2; ++bj) { const size_t off = (size_t)(row0 + ai * HALF + (2 * mp + mm) * 16) * 1024 + colt + bj * HALF;
                            const u32x4 hb = *(const u32x4*)(H1B + off);
                            pre[mm][bj][0] = (f32x4){bflo(hb.x), bfhi(hb.x), bflo(hb.y), bfhi(hb.y)}; pre[mm][bj][1] = (f32x4){bflo(hb.z), bfhi(hb.z), bflo(hb.w), bfhi(hb.w)}; }
#pragma unroll
                    for (int mm = 0; mm < 2; ++mm) { const int m = 2 * mp + mm; const int row = row0 + ai * HALF + m * 16; float s = 0.f;
#pragma unroll
                        for (int bj = 0; bj < 2; ++bj) { const f32x4 h0 = pre[mm][bj][0] + acc[ai][bj][m][0], h1 = pre[mm][bj][1] + acc[ai][bj][m][1];
                            hacc[ai][bj][m][0] = h0; hacc[ai][bj][m][1] = h1;
                            s += (h0[0] * h0[0] + h0[1] * h0[1]) + (h0[2] * h0[2] + h0[3] * h0[3]) + (h1[0] * h1[0] + h1[1] * h1[1]) + (h1[2] * h1[2] + h1[3] * h1[3]); }
                        s += __shfl_xor(s, 16); s += __shfl_xor(s, 32);
                        if (fq == 0) ssq2[(size_t)row * 16 + pn * 4 + wc] = s; }
                    asm volatile("" ::: "memory");
                }
            asm volatile("s_waitcnt vmcnt(0)" ::: "memory");
            __builtin_amdgcn_s_barrier();
            if (threadIdx.x == 0) {
                unsigned* cnt = (unsigned*)(ws + WS_C4CNT) + 16 * u.pm;
                __builtin_amdgcn_fence(__ATOMIC_RELEASE, "agent");
                asm volatile("s_waitcnt vmcnt(0)" ::: "memory");
                __hip_atomic_fetch_add(cnt, 1u, __ATOMIC_RELAXED, __HIP_MEMORY_SCOPE_AGENT);
                unsigned spins = 0;
                while (__hip_atomic_load(cnt, __ATOMIC_RELAXED, __HIP_MEMORY_SCOPE_AGENT) < 4u) { __builtin_amdgcn_s_sleep(2); if (++spins > (1u << 22)) break; }
                __builtin_amdgcn_fence(__ATOMIC_ACQUIRE, "agent");
                asm volatile("s_waitcnt vmcnt(0)" ::: "memory");
            }
            __builtin_amdgcn_s_barrier();
            asm volatile("" ::: "memory");
            const f32x4 gA0 = *(const f32x4*)(gfin + colt), gA1 = *(const f32x4*)(gfin + colt + 4), gB0 = *(const f32x4*)(gfin + colt + HALF), gB1 = *(const f32x4*)(gfin + colt + HALF + 4);
#pragma unroll
            for (int ai = 0; ai < 2; ++ai)
#pragma unroll
                for (int mp = 0; mp < 2; ++mp) {
                    f32x4 pp[2][4];
#pragma unroll
                    for (int mm = 0; mm < 2; ++mm)
#pragma unroll
                        for (int q = 0; q < 4; ++q) pp[mm][q] = *(const f32x4*)(ssq2 + (size_t)(row0 + ai * HALF + (2 * mp + mm) * 16) * 16 + 4 * q);
#pragma unroll
                    for (int mm = 0; mm < 2; ++mm) { const int m = 2 * mp + mm; const int row = row0 + ai * HALF + m * 16; const size_t off = (size_t)row * 1024 + colt;
                        const f32x4 p0 = pp[mm][0], p1 = pp[mm][1], p2 = pp[mm][2], p3 = pp[mm][3];
                        const float rs = rsqrtf(((((p0[0] + p0[1]) + (p0[2] + p0[3])) + ((p1[0] + p1[1]) + (p1[2] + p1[3]))) + (((p2[0] + p2[1]) + (p2[2] + p2[3])) + ((p3[0] + p3[1]) + (p3[2] + p3[3])))) * (1.0f / 1024.0f) + 1e-6f);
                        *(f32x4*)(out + off) = acc[ai][0][m][0] * rs * gA0; *(f32x4*)(out + off + 4) = acc[ai][0][m][1] * rs * gA1;
                        *(f32x4*)(out + off + HALF) = acc[ai][1][m][0] * rs * gB0; *(f32x4*)(out + off + HALF + 4) = acc[ai][1][m][1] * rs * gB1; }
                    asm volatile("" ::: "memory");
                }
        } else if (mode == EM_C2) {
            const float* base = (mode == EM_C2) ? x : (const float*)out; float* ssq = (mode == EM_C2) ? ssq1 : ssq2;
#pragma unroll
            for (int ai = 0; ai < 2; ++ai) {
                f32x4 pre[4][2][2];
#pragma unroll
                for (int m = 0; m < 4; ++m)
#pragma unroll
                    for (int bj = 0; bj < 2; ++bj) { const size_t off = (size_t)(row0 + ai * HALF + m * 16) * 1024 + colt + bj * HALF;
                        pre[m][bj][0] = *(const f32x4*)(base + off); pre[m][bj][1] = *(const f32x4*)(base + off + 4); }
#pragma unroll
                for (int m = 0; m < 4; ++m) { const int row = row0 + ai * HALF + m * 16; float s = 0.f;
#pragma unroll
                    for (int bj = 0; bj < 2; ++bj) { const size_t off = (size_t)row * 1024 + colt + bj * HALF;
                        const f32x4 h0 = pre[m][bj][0] + acc[ai][bj][m][0], h1 = pre[m][bj][1] + acc[ai][bj][m][1];
                        s += (h0[0] * h0[0] + h0[1] * h0[1]) + (h0[2] * h0[2] + h0[3] * h0[3]) + (h1[0] * h1[0] + h1[1] * h1[1]) + (h1[2] * h1[2] + h1[3] * h1[3]);
                        if (mode == EM_C2) { u32x4 w; w.x = cvt_pk_bf16(h0[0], h0[1]); w.y = cvt_pk_bf16(h0[2], h0[3]); w.z = cvt_pk_bf16(h1[0], h1[1]); w.w = cvt_pk_bf16(h1[2], h1[3]);
                            *(u32x4*)(H1B + off) = w; } }
                    s += __shfl_xor(s, 16); s += __shfl_xor(s, 32);
                    if (fq == 0) ssq[(size_t)row * 16 + pn * 4 + wc] = s; }
            }
        } else {
#pragma unroll
            for (int ai = 0; ai < 2; ++ai) {
                f32x4 pp[4][4];
#pragma unroll
                for (int m = 0; m < 4; ++m)
#pragma unroll
                    for (int q = 0; q < 4; ++q) pp[m][q] = *(const f32x4*)(ssq1 + (size_t)(row0 + ai * HALF + m * 16) * 16 + 4 * q);
#pragma unroll
                for (int m = 0; m < 4; ++m) { const int row = row0 + ai * HALF + m * 16;
                    const f32x4 p0 = pp[m][0], p1 = pp[m][1], p2 = pp[m][2], p3 = pp[m][3];
                    const float rs = rsqrtf(((((p0[0] + p0[1]) + (p0[2] + p0[3])) + ((p1[0] + p1[1]) + (p1[2] + p1[3]))) + (((p2[0] + p2[1]) + (p2[2] + p2[3])) + ((p3[0] + p3[1]) + (p3[2] + p3[3])))) * (1.0f / 1024.0f) + 1e-6f);
#pragma unroll
                    for (int bj = 0; bj < 2; ++bj) { f32x4 v0 = acc[ai][bj][m][0] * rs, v1 = acc[ai][bj][m][1] * rs;
#pragma unroll
                        for (int j = 0; j < 4; ++j) { const float a = fmaxf(v0[j], 0.f), b = fmaxf(v1[j], 0.f); v0[j] = a * a; v1[j] = b * b; }
                        u32x4 w; w.x = cvt_pk_bf16(v0[0], v0[1]); w.y = cvt_pk_bf16(v0[2], v0[3]); w.z = cvt_pk_bf16(v1[0], v1[1]); w.w = cvt_pk_bf16(v1[2], v1[3]);
                        *(u32x4*)(U + (size_t)row * 4096 + colt + bj * HALF) = w; } }
            }
        }
    }
};

template <class Epi, class Sched, bool ALIGN_EPI = false, bool SP2 = false>
__device__ __forceinline__ void gemm_phase(PG8_LAS unsigned char* lds, const Gemm g, const Sched& S, const Epi& E) {
    int tid_ = threadIdx.x; asm volatile("" : "+v"(tid_));
    const int tid = tid_, wid = __builtin_amdgcn_readfirstlane(tid >> 6), lane = tid & 63, wr = wid >> 2, wc = wid & 3, fr = lane & 15, fq = lane >> 4;
    const int K = g.K, nt = K / BK;
    unsigned voffA[2], voffB[2];
#pragma unroll
    for (int i = 0; i < 2; ++i) { int R, C; stage_rc(tid * 16 + i * 8192, R, C); const int Rb = Epi::PERM ? ((R & ~31) + perm32(R & 31)) : R;
        voffA[i] = (unsigned)(R * K + C) * 2u; voffB[i] = (unsigned)(Rb * K + C) * 2u; }
    const size_t kstep = (size_t)(BK * 2);
    const size_t hstep = (size_t)HALF * K * 2;
    const size_t tstep = 2 * hstep;
    const unsigned ldsw = (unsigned)wid * 1024u;
    const int aoff = lds_byte(wr * 64 + fr, fq * 8), boff = lds_byte(wc * 32 + fr, fq * 8);
#define PG8_SA(b, h) (((b) * 2 + (h)) * HTB)
#define PG8_SB(b, h) ((4 + (b) * 2 + (h)) * HTB)
#define PG8_STAGE(bufoff, gbase, voff) do { _Pragma("unroll") for (int _i = 0; _i < 2; ++_i) \
        __builtin_amdgcn_global_load_lds((const unsigned*)((const char*)(gbase) + (voff)[_i]), (PG8_LAS unsigned*)(lds + (bufoff) + ldsw + _i * 8192), 16, 0, 0); } while (0)
#define PG8_LDA(dst, b, h) do { _Pragma("unroll") for (int m = 0; m < 4; ++m) _Pragma("unroll") for (int k = 0; k < 2; ++k) dst[m][k] = *(const PG8_LAS bf16x8*)(lds + PG8_SA(b, h) + aoff + m * 2048 + k * 1024); } while (0)
#define PG8_LDB(dst, b, h) do { _Pragma("unroll") for (int n = 0; n < 2; ++n) _Pragma("unroll") for (int k = 0; k < 2; ++k) dst[n][k] = *(const PG8_LAS bf16x8*)(lds + PG8_SB(b, h) + boff + n * 2048 + k * 1024); } while (0)
#define PG8_MMA(ai, bj, At, Bt) do { __builtin_amdgcn_s_setprio(1); _Pragma("unroll") for (int m = 0; m < 4; ++m) _Pragma("unroll") for (int n = 0; n < 2; ++n) _Pragma("unroll") for (int k = 0; k < 2; ++k) \
        acc[ai][bj][m][n] = __builtin_amdgcn_mfma_f32_16x16x32_bf16(Bt[n][k], At[m][k], acc[ai][bj][m][n], 0, 0, 0); __builtin_amdgcn_s_setprio(0); } while (0)
#define PG8_WAIT_V(n) asm volatile("s_waitcnt vmcnt(" #n ")" ::: "memory")
#define PG8_WAIT_L(n) asm volatile("s_waitcnt lgkmcnt(" #n ")" ::: "memory")
#define PG8_BAR __builtin_amdgcn_s_barrier()
#define PG8_SCHED __builtin_amdgcn_sched_barrier(0)
    Unit cur, nxt; int ui = 0;
    if (!S.next(0, cur)) return;
    f32x4 acc[2][2][4][2];
#pragma unroll
    for (int a = 0; a < 2; ++a)
#pragma unroll
        for (int b = 0; b < 2; ++b)
#pragma unroll
            for (int m = 0; m < 4; ++m)
#pragma unroll
                for (int n = 0; n < 2; ++n) acc[a][b][m][n] = (f32x4){0.f, 0.f, 0.f, 0.f};
    bf16x8 At[4][2], B0[2][2], B1[2][2];
    const char* cA = (const char*)g.A + (size_t)cur.pm * tstep; const char* cB = (const char*)g.Bt + (size_t)cur.pn * tstep;
    S.a_ready(cur);
    if constexpr (SP2) {
        PG8_STAGE(PG8_SB(0, 0), cB, voffB); PG8_STAGE(PG8_SB(0, 1), cB + hstep, voffB); PG8_STAGE(PG8_SA(0, 0), cA, voffA); PG8_STAGE(PG8_SA(0, 1), cA + hstep, voffA);
        if (wr == 1) PG8_BAR;
        PG8_WAIT_V(2); PG8_BAR;
        PG8_STAGE(PG8_SB(1, 0), cB + kstep, voffB); PG8_STAGE(PG8_SA(1, 0), cA + kstep, voffA); PG8_STAGE(PG8_SB(1, 1), cB + hstep + kstep, voffB);
        PG8_WAIT_V(6); PG8_BAR;
    } else {
        PG8_STAGE(PG8_SB(0, 0), cB, voffB); PG8_STAGE(PG8_SA(0, 0), cA, voffA); PG8_STAGE(PG8_SB(0, 1), cB + hstep, voffB); PG8_STAGE(PG8_SA(0, 1), cA + hstep, voffA);
        if (wr == 1) PG8_BAR;
        PG8_WAIT_V(4); PG8_BAR;
        PG8_STAGE(PG8_SB(1, 0), cB + kstep, voffB); PG8_STAGE(PG8_SA(1, 0), cA + kstep, voffA); PG8_STAGE(PG8_SB(1, 1), cB + hstep + kstep, voffB);
        PG8_WAIT_V(6); PG8_BAR;
    }
    for (;;) {
        const bool has_next = S.next(ui + 1, nxt);
        const char* nA = has_next ? (const char*)g.A + (size_t)nxt.pm * tstep : cA; const char* nB = has_next ? (const char*)g.Bt + (size_t)nxt.pn * tstep : cB;
        for (int t = 0; t < nt; t += 2) {
            const bool last = (t == nt - 2);
            const char* a1 = cA + (size_t)(t + 1) * kstep;
            const char* a2 = last ? nA : cA + (size_t)(t + 2) * kstep; const char* b2 = last ? nB : cB + (size_t)(t + 2) * kstep;
            const char* a3 = a2 + kstep; const char* b3 = b2 + kstep;
            if (last && has_next) S.a_ready(nxt);
            if constexpr (SP2) {
            PG8_LDB(B0, 0, 0); PG8_LDB(B1, 0, 1); PG8_SCHED; PG8_LDA(At, 0, 0); PG8_STAGE(PG8_SA(1, 1), a1 + hstep, voffA);
            PG8_WAIT_V(8); PG8_WAIT_L(0); PG8_BAR; PG8_MMA(0, 0, At, B0); PG8_MMA(0, 1, At, B1); PG8_BAR; PG8_SCHED;
            PG8_LDA(At, 0, 1); PG8_STAGE(PG8_SB(0, 0), b2, voffB); PG8_STAGE(PG8_SB(0, 1), b2 + hstep, voffB); PG8_STAGE(PG8_SA(0, 0), a2, voffA);
            PG8_WAIT_V(8); PG8_WAIT_L(0); PG8_BAR; PG8_MMA(1, 0, At, B0); PG8_MMA(1, 1, At, B1); PG8_BAR; PG8_SCHED;
            PG8_LDB(B0, 1, 0); PG8_LDB(B1, 1, 1); PG8_SCHED; PG8_LDA(At, 1, 0); PG8_STAGE(PG8_SA(0, 1), a2 + hstep, voffA);
            PG8_WAIT_V(8); PG8_WAIT_L(0); PG8_BAR; PG8_MMA(0, 0, At, B0); PG8_MMA(0, 1, At, B1); PG8_BAR; PG8_SCHED;
            PG8_LDA(At, 1, 1); PG8_STAGE(PG8_SB(1, 0), b3, voffB); PG8_STAGE(PG8_SB(1, 1), b3 + hstep, voffB); PG8_STAGE(PG8_SA(1, 0), a3, voffA);
            PG8_WAIT_V(8); PG8_WAIT_L(0); PG8_BAR; PG8_MMA(1, 0, At, B0); PG8_MMA(1, 1, At, B1); PG8_BAR; PG8_SCHED;
            } else {
            PG8_LDB(B0, 0, 0); PG8_SCHED; PG8_LDA(At, 0, 0); PG8_STAGE(PG8_SA(1, 1), a1 + hstep, voffA);
            PG8_WAIT_L(8); PG8_BAR; PG8_WAIT_L(0); PG8_MMA(0, 0, At, B0); PG8_BAR; PG8_SCHED;
            PG8_LDB(B1, 0, 1); PG8_STAGE(PG8_SB(0, 0), b2, voffB);
            PG8_BAR; PG8_WAIT_L(0); PG8_MMA(0, 1, At, B1); PG8_BAR;
            PG8_LDA(At, 0, 1); PG8_STAGE(PG8_SA(0, 0), a2, voffA);
            PG8_BAR; PG8_WAIT_L(0); PG8_MMA(1, 0, At, B0); PG8_BAR; PG8_SCHED;
            PG8_STAGE(PG8_SB(0, 1), b2 + hstep, voffB);
            PG8_WAIT_V(6); PG8_BAR; PG8_MMA(1, 1, At, B1); PG8_BAR;
            PG8_LDB(B0, 1, 0); PG8_SCHED; PG8_LDA(At, 1, 0); PG8_STAGE(PG8_SA(0, 1), a2 + hstep, voffA);
            PG8_WAIT_L(8); PG8_BAR; PG8_WAIT_L(0); PG8_MMA(0, 0, At, B0); PG8_BAR; PG8_SCHED;
            PG8_LDB(B1, 1, 1); PG8_STAGE(PG8_SB(1, 0), b3, voffB);
            PG8_BAR; PG8_WAIT_L(0); PG8_MMA(0, 1, At, B1); PG8_BAR;
            PG8_LDA(At, 1, 1); PG8_STAGE(PG8_SA(1, 0), a3, voffA);
            PG8_BAR; PG8_WAIT_L(0); PG8_MMA(1, 0, At, B0); PG8_BAR; PG8_SCHED;
            PG8_STAGE(PG8_SB(1, 1), b3 + hstep, voffB);
            PG8_WAIT_V(6); PG8_BAR; PG8_MMA(1, 1, At, B1); PG8_BAR;
            }
        }
        if constexpr (ALIGN_EPI) { if (wr == 0) PG8_BAR; }
        if constexpr (!Epi::AFTER_DRAIN) { E(acc, cur, wr, wc, fr, fq); S.done(cur); }
        if (!has_next) break;
#pragma unroll
        for (int a = 0; a < 2; ++a)
#pragma unroll
            for (int b = 0; b < 2; ++b)
#pragma unroll
                for (int m = 0; m < 4; ++m)
#pragma unroll
                    for (int n = 0; n < 2; ++n) acc[a][b][m][n] = (f32x4){0.f, 0.f, 0.f, 0.f};
        cur = nxt; cA = nA; cB = nB; ++ui;
        if constexpr (ALIGN_EPI) { if (wr == 1) PG8_BAR; }
    }
    PG8_WAIT_V(0);
    if constexpr (!ALIGN_EPI) { if (wr == 0) PG8_BAR; }
    PG8_BAR;
    if constexpr (Epi::AFTER_DRAIN) { E.fused(acc, cur, wr, wc, fr, fq, lds, wid, lane); S.done(cur); }
#undef PG8_SA
#undef PG8_SB
#undef PG8_STAGE
#undef PG8_LDA
#undef PG8_LDB
#undef PG8_MMA
#undef PG8_WAIT_V
#undef PG8_WAIT_L
#undef PG8_BAR
#undef PG8_SCHED
}
}

#define GAS __attribute__((address_space(1)))
#define LAS __attribute__((address_space(3)))
typedef unsigned short bf16;
typedef unsigned v4u __attribute__((ext_vector_type(4)));
typedef unsigned v2u __attribute__((ext_vector_type(2)));
typedef float f32x4 __attribute__((ext_vector_type(4)));
typedef float f32x2 __attribute__((ext_vector_type(2)));
typedef short bf16x8 __attribute__((ext_vector_type(8)));
typedef short s16x4 __attribute__((ext_vector_type(4)));
using pg8::f2bf; using pg8::cvt_pk_bf16; using pg8::bflo; using pg8::bfhi;


__device__ __forceinline__ float wave_sum(float v) {
#pragma unroll
    for (int o = 1; o < 64; o <<= 1) v += __shfl_xor(v, o);
    return v;
}
__device__ __forceinline__ unsigned pk2(float lo, float hi) { return (unsigned)f2bf(lo) | ((unsigned)f2bf(hi) << 16); }

#define XB_TMO      128
#define XB_XCNT(j)  (256  + 64 * (j))
#define XB_XSUB(j)  (1280 + 64 * (j))
#define XB_XGEN(j)  (2304 + 64 * (j))
#define XB_TOP      3328
#define XB_TOPGEN   3392
#define XCD_BAR_WORDS 3456
#define XB_SPIN_CAP (1u << 18)

__device__ __forceinline__ unsigned xb_ld(unsigned* p)              { return __hip_atomic_load(p, __ATOMIC_RELAXED, __HIP_MEMORY_SCOPE_AGENT); }
__device__ __forceinline__ unsigned xb_add(unsigned* p, unsigned v) { return __hip_atomic_fetch_add(p, v, __ATOMIC_RELAXED, __HIP_MEMORY_SCOPE_AGENT); }
__device__ __forceinline__ unsigned xb_xcc_id() { return (unsigned)__builtin_amdgcn_s_getreg((3 << 11) | 20) & 0xFu; }
#define XB_SPIN(cond, bar) do { unsigned _sp = 0; while (cond) { __builtin_amdgcn_s_sleep(1); \
    if ((++_sp & 255u) == 0u) { if (xb_ld(&(bar)[XB_TMO])) break; if (_sp > XB_SPIN_CAP) { atomicAdd(&(bar)[XB_TMO], 1u); break; } } } } while (0)

struct XcdBarrier {
    unsigned* bar; unsigned x;
    volatile LAS unsigned* st;
};

__device__ __forceinline__ XcdBarrier xcd_barrier_post(unsigned* bar, volatile LAS unsigned* st) {
    XcdBarrier b; b.bar = bar; b.x = xb_xcc_id(); b.st = st;
    if (threadIdx.x == 0) (void)xb_add(&bar[XB_XCNT(b.x)], 1u);
    return b;
}
__device__ __forceinline__ void xcd_barrier_complete(unsigned* bar, unsigned x, unsigned& nloc, unsigned& nx) {
    const unsigned G = gridDim.x * gridDim.y * gridDim.z;
    unsigned sum, cnt, mine, sp = 0u;
    for (;;) {
        sum = 0u; cnt = 0u; mine = 0u;
#pragma unroll
        for (unsigned j = 0; j < 16; ++j) { const unsigned c = xb_ld(&bar[XB_XCNT(j)]); sum += c; cnt += (c > 0u) ? 1u : 0u; mine = (j == x) ? c : mine; }
        if (sum == G) break;
        __builtin_amdgcn_s_sleep(1);
        if ((++sp & 255u) == 0u) { if (xb_ld(&bar[XB_TMO])) break; if (sp > XB_SPIN_CAP) { atomicAdd(&bar[XB_TMO], 1u); break; } }
    }
    nloc = mine > 0u ? mine : 1u; nx = cnt > 0u ? cnt : 1u;
}

__device__ __forceinline__ void xcd_barrier(const XcdBarrier& b) {
    asm volatile("s_waitcnt vmcnt(0)" ::: "memory");
    __syncthreads();
    if (threadIdx.x == 0) {
        unsigned* bar = b.bar;
        __builtin_amdgcn_s_waitcnt(0);
        unsigned nloc = b.st[0], nx = b.st[1];
        if (nloc == 0u) { xcd_barrier_complete(bar, b.x, nloc, nx); b.st[0] = nloc; b.st[1] = nx; }
        const unsigned old = xb_add(&bar[XB_XSUB(b.x)], 1u);
        const unsigned gen = old / nloc;
        if (old + 1u == (gen + 1u) * nloc) {
            __builtin_amdgcn_fence(__ATOMIC_RELEASE, "agent");
            asm volatile("s_waitcnt vmcnt(0)" ::: "memory");
            const unsigned og = xb_add(&bar[XB_TOP], 1u);
            const unsigned tg = og / nx;
            if (og + 1u == (tg + 1u) * nx) xb_add(&bar[XB_TOPGEN], 1u);
            else XB_SPIN(xb_ld(&bar[XB_TOPGEN]) == tg, bar);
            __builtin_amdgcn_fence(__ATOMIC_ACQUIRE, "agent");
            xb_add(&bar[XB_XGEN(b.x)], 1u);
            asm volatile("s_waitcnt vmcnt(0)" ::: "memory");
        } else {
            XB_SPIN(xb_ld(&bar[XB_XGEN(b.x)]) == gen, bar);
            __builtin_amdgcn_fence(__ATOMIC_ACQUIRE, "agent");
            asm volatile("s_waitcnt vmcnt(0)" ::: "memory");
        }
    }
    __syncthreads();
}

#define XL_SUB(j) (5120 + 64 * (j))
#define XL_GEN(j) (5632 + 64 * (j))
__device__ __forceinline__ void xcd_local_barrier(const XcdBarrier& b) {
    asm volatile("s_waitcnt vmcnt(0)" ::: "memory");
    __syncthreads();
    if (threadIdx.x == 0) {
        unsigned* bar = b.bar; const unsigned nloc = b.st[0];
        const unsigned old = xb_add(&bar[XL_SUB(b.x)], 1u), gen = old / nloc;
        if (old + 1u == (gen + 1u) * nloc) xb_add(&bar[XL_GEN(b.x)], 1u);
        else XB_SPIN(xb_ld(&bar[XL_GEN(b.x)]) == gen, bar);
        __builtin_amdgcn_fence(__ATOMIC_ACQUIRE, "agent");
        asm volatile("s_waitcnt vmcnt(0)" ::: "memory");
    }
    __syncthreads();
}
constexpr size_t WS_BAR = 768 * KiB, BAR_BYTES = 24 * KiB;
struct Args { const float* in[14]; float* out; unsigned char* ws; };

template <class CM>
__device__ __forceinline__ void tr_item(const float* W, int K, int N, bf16* WT, const float* kscale, LAS float* scr, int item, int lane, CM cmap) {
    const int nblk = N / 32, kb = item / nblk, nb = item % nblk, k0 = 64 * kb, n0 = 32 * nb;
    const int src = cmap(n0 + (lane & 31));
    float tv[32];
#pragma unroll
    for (int i = 0; i < 32; ++i) tv[i] = W[(size_t)(k0 + 2 * i + (lane >> 5)) * N + src];
#pragma unroll
    for (int i = 0; i < 32; ++i) { const int kk = 2 * i + (lane >> 5); float v = tv[i]; if (kscale) v *= kscale[k0 + kk]; scr[kk * 33 + (lane & 31)] = v; }
    asm volatile("s_waitcnt lgkmcnt(0)" ::: "memory");
    const int c = lane & 7;
#pragma unroll
    for (int j = 0; j < 4; ++j) { const int n = (lane >> 3) + 8 * j; const LAS float* s = scr + (8 * c) * 33 + n;
        v4u o; o.x = pk2(s[0 * 33], s[1 * 33]); o.y = pk2(s[2 * 33], s[3 * 33]); o.z = pk2(s[4 * 33], s[5 * 33]); o.w = pk2(s[6 * 33], s[7 * 33]);
        *(v4u*)(WT + (size_t)(n0 + n) * K + k0 + 8 * c) = o; }
    asm volatile("s_waitcnt lgkmcnt(0)" ::: "memory");
}
struct CmId { __device__ __forceinline__ int operator()(int n) const { return n; } };
struct CmIn {
    __device__ __forceinline__ int operator()(int n) const {
        if (n < 1536 || n >= 3584) return n;
        const int q = n - 1536, j = q >> 8, cl = q & 255;
        const int sel = 2 * (cl >> 7) + ((cl >> 2) & 1), ch = 64 * j + 16 * ((cl >> 5) & 3) + 4 * ((cl >> 3) & 3) + (cl & 3);
        return 1536 + 512 * sel + ch;
    }
};

struct HgOps { s16x4 vb[2]; s16x4 ka[8]; f32x4 g[8]; };
__device__ __forceinline__ void hg_load(HgOps& o, const bf16* KT, const bf16* VTt, const float* G, unsigned cb, int vq, int lm, int kq) {
#pragma unroll
    for (int vt = 0; vt < 2; ++vt) o.vb[vt] = *(const s16x4*)(VTt + (unsigned)((cb + 32 * vq + 16 * vt + lm) * 16 + 4 * kq));
#pragma unroll
    for (int kt = 0; kt < 8; ++kt) { o.ka[kt] = *(const s16x4*)(KT + (unsigned)((cb + 16 * kt + lm) * 16 + 4 * kq)); o.g[kt] = *(const f32x4*)(G + (unsigned)(cb + 16 * kt + 4 * kq)); }
}
template <bool TRACKD>
__device__ __forceinline__ void hg_apply(f32x4 (&S)[8][2], f32x4 (&Dp)[8], const HgOps& o) {
#pragma unroll
    for (int kt = 0; kt < 8; ++kt) {
#pragma unroll
        for (int vt = 0; vt < 2; ++vt) { S[kt][vt] = __builtin_amdgcn_mfma_f32_16x16x16bf16_1k(o.ka[kt], o.vb[vt], S[kt][vt], 0, 0, 0); S[kt][vt] = S[kt][vt] * o.g[kt]; }
        if (TRACKD) Dp[kt] = Dp[kt] * o.g[kt];
    }
}
template <bool TRACKD>
__device__ __forceinline__ void hg_update(f32x4 (&S)[8][2], f32x4 (&Dp)[8], const bf16* KT, const bf16* VTt, const float* G, unsigned cb, int vq, int lm, int kq) {
    HgOps o; hg_load(o, KT, VTt, G, cb, vq, lm, kq); hg_apply<TRACKD>(S, Dp, o);
}

__global__ void __launch_bounds__(NWAVES * 64, 2) mk_fwd(Args args) {
    extern __shared__ __attribute__((aligned(16))) unsigned char lds_raw[];
    LAS unsigned char* lds = (LAS unsigned char*)lds_raw;
    const int tid = threadIdx.x, lane = tid & 63, wave = __builtin_amdgcn_readfirstlane(tid >> 6);
    const int G = gridDim.x, bx = blockIdx.x;
    const int gw = bx * NWAVES + wave, NGW = G * NWAVES;
    const int lm = lane & 15, kq = lane >> 4;
    unsigned char* ws = args.ws;
    if (tid < 16) ((LAS unsigned*)(lds + LDS_CTL))[tid] = 0u;
    __syncthreads();
    const XcdBarrier bar = xcd_barrier_post((unsigned*)(ws + WS_BAR), (volatile LAS unsigned*)(lds + LDS_CTL + 32));
    if (tid == 0) ((LAS unsigned*)(lds + LDS_CTL))[0] = xb_add((unsigned*)(ws + WS_BAR) + 3520 + 64 * bar.x, 1u);
    __syncthreads();
    const unsigned my_rank = ((volatile LAS unsigned*)(lds + LDS_CTL))[0];
    const float* x = args.in[0]; const float* meta = args.in[1]; const float* w_in = args.in[2]; const float* w_na = args.in[3]; const float* w_hg = args.in[4];
    const float* w_o = args.in[5]; const float* w_up = args.in[6]; const float* w_dn = args.in[7]; const float* g_mix = args.in[8]; const float* g_mlp = args.in[9];
    const float* g_fin = args.in[10]; const float* hg_gain = args.in[11]; const float* rpb = args.in[12]; const float* lb_logits = args.in[13];
    float* out = args.out;
    float* ssq1 = (float*)(ws + WS_SSQ1); float* ssq2 = (float*)(ws + WS_SSQ2);
    bf16* KNAm = (bf16*)(ws + WS_KNAM); bf16* VTm = (bf16*)(ws + WS_VTM); bf16* KFTm = (bf16*)(ws + WS_KFTM); bf16* VHTm = (bf16*)(ws + WS_VHTM);
    float* GFm = (float*)(ws + WS_GFM); float* LB = (float*)(ws + WS_LB); float* DSEG = (float*)(ws + WS_DSEG);
    bf16* WT_in = (bf16*)(ws + WS_WIN); bf16* WT_na = (bf16*)(ws + WS_WNA); bf16* WT_hg = (bf16*)(ws + WS_WHG); bf16* WT_o = (bf16*)(ws + WS_WO); bf16* WT_up = (bf16*)(ws + WS_WUP); bf16* WT_dn = (bf16*)(ws + WS_WDN);
    bf16* XN = (bf16*)(ws + WS_XN); float* SBUF = (float*)(ws + WS_XN); bf16* H1B = (bf16*)(ws + WS_XN);
    bf16* QNA = (bf16*)(ws + WS_QNA); bf16* KNA = (bf16*)(ws + WS_KNA); bf16* VT = (bf16*)(ws + WS_VT); bf16* QF = (bf16*)(ws + WS_QF); bf16* QB = (bf16*)(ws + WS_QB);
    bf16* KF = (bf16*)(ws + WS_KF); bf16* KFT = (bf16*)(ws + WS_KFT); bf16* KB = (bf16*)(ws + WS_KB); bf16* KBT = (bf16*)(ws + WS_KBT); bf16* VHT = (bf16*)(ws + WS_VHT);
    bf16* GHG = (bf16*)(ws + WS_GHG); float* GF = (float*)(ws + WS_GF); float* GB = (float*)(ws + WS_GB);
    bf16* SNA = (bf16*)out; bf16* SHG = (bf16*)out + (size_t)M * D;
    bf16* ONA = QNA; bf16* OHG = (bf16*)(ws + WS_OHG); bf16* Tb = (bf16*)(ws + WS_T); bf16* MIX = (bf16*)(ws + WS_MIX); bf16* U = (bf16*)(ws + WS_U);

    {
        f32x4 xv0[4][4];
#pragma unroll
        for (int q = 0; q < 4; ++q)
#pragma unroll
            for (int j = 0; j < 4; ++j) xv0[q][j] = *(const f32x4*)(x + (size_t)(gw + q * NGW) * D + 4 * lane + 256 * j);
        {
            LAS float* mT = (LAS float*)lds;
            LAS float* red = (LAS float*)(lds + 65536);
            LAS float* fin = (LAS float*)(lds + 65536 + 32768);
#pragma unroll
            for (int rr = 0; rr < 2; ++rr) { const int r = 2 * wave + rr; const float* mr = meta + (size_t)r * D;
                f32x4 v[4]; float s = 0.f;
#pragma unroll
                for (int j = 0; j < 4; ++j) { v[j] = *(const f32x4*)(mr + 4 * lane + 256 * j); s += (v[j].x * v[j].x + v[j].y * v[j].y) + (v[j].z * v[j].z + v[j].w * v[j].w); }
                const float rs = rsqrtf(wave_sum(s) * (1.0f / D) + EPS);
#pragma unroll
                for (int j = 0; j < 4; ++j) { const f32x4 g = *(const f32x4*)(g_mix + 4 * lane + 256 * j); const int k = 4 * lane + 256 * j;
                    mT[(k + 0) * 16 + r] = v[j].x * rs * g.x; mT[(k + 1) * 16 + r] = v[j].y * rs * g.y; mT[(k + 2) * 16 + r] = v[j].z * rs * g.z; mT[(k + 3) * 16 + r] = v[j].w * rs * g.w; } }
            __syncthreads();
            for (int cbk = bx; cbk < 256; cbk += G) {
                const int c = tid & 7, ks = tid >> 3, grp = cbk >> 6, cl0 = (cbk & 63) * 8;
                const int src = (grp == 0 ? 512 : grp == 1 ? 1024 : grp == 2 ? 2048 : 3072) + cl0 + c;
                float a[16];
#pragma unroll
                for (int r = 0; r < 16; ++r) a[r] = 0.f;
                float wv[16];
#pragma unroll
                for (int kk = 0; kk < 16; ++kk) wv[kk] = w_in[(size_t)(ks * 16 + kk) * NIN + src];
#pragma unroll
                for (int kk = 0; kk < 16; ++kk) { const int k = ks * 16 + kk; const float w = wv[kk];
                    const f32x4 m0 = *(const LAS f32x4*)(mT + k * 16), m1 = *(const LAS f32x4*)(mT + k * 16 + 4), m2 = *(const LAS f32x4*)(mT + k * 16 + 8), m3 = *(const LAS f32x4*)(mT + k * 16 + 12);
                    a[0] += w * m0.x; a[1] += w * m0.y; a[2] += w * m0.z; a[3] += w * m0.w; a[4] += w * m1.x; a[5] += w * m1.y; a[6] += w * m1.z; a[7] += w * m1.w;
                    a[8] += w * m2.x; a[9] += w * m2.y; a[10] += w * m2.z; a[11] += w * m2.w; a[12] += w * m3.x; a[13] += w * m3.y; a[14] += w * m3.z; a[15] += w * m3.w; }
#pragma unroll
                for (int r = 0; r < 16; ++r) red[(ks * 16 + r) * 8 + c] = a[r];
                __syncthreads();
                if (tid < 128) { float s = 0.f;
                    for (int q = 0; q < 64; ++q) s += red[q * 128 + tid];
                    fin[tid] = s; }
                __syncthreads();
                if (tid < 8) { const int cl = cl0 + tid;
#pragma unroll
                    for (int r = 0; r < 16; ++r) a[r] = fin[r * 8 + tid];
                    if (grp == 0) {
#pragma unroll
                        for (int r = 0; r < 16; ++r) KNAm[r * 512 + cl] = f2bf(a[r]);
                    } else if (grp == 1) { const int h = cl >> 6, d = cl & 63;
#pragma unroll
                        for (int r = 0; r < 16; ++r) VTm[(h * 64 + d) * 16 + r] = f2bf(a[r]);
                    } else if (grp == 2) {
                        const float l0 = lb_logits[cl], l1 = lb_logits[512 + cl]; const float lb = 1.0f / (1.0f + expf(l1 - l0));
                        float bsum = 0.f;
#pragma unroll
                        for (int r = 0; r < 16; ++r) { const float f = lb + (1.0f - lb) * __builtin_amdgcn_rcpf(1.0f + __expf(-a[r])); bsum += __builtin_amdgcn_logf(f) * 0.69314718056f; KFTm[cl * 16 + r] = f2bf((1.0f - f) * __expf(-bsum)); }
                        GFm[cl] = __expf(bsum);
                    } else {
#pragma unroll
                        for (int r = 0; r < 16; ++r) VHTm[cl * 16 + r] = f2bf(a[r]);
                    }
                }
                __syncthreads();
            }
        }
        if (bx == 32 % G) {
            for (int i = tid; i < 1024; i += NWAVES * 64) { const int dir = i >> 9, c = i & 511; const float l0 = lb_logits[dir * 1024 + c], l1 = lb_logits[dir * 1024 + 512 + c]; LB[i] = 1.0f / (1.0f + expf(l1 - l0)); }
        }
        LAS float* scr = (LAS float*)(lds + wave * 16384);
        constexpr int I_IN = (D / 64) * (NIN / 32), I_NA = (512 / 64) * (D / 32), I_O = (D / 64) * (D / 32), I_UP = (D / 64) * (FF / 32), I_DN = (FF / 64) * (D / 32);
        constexpr int NITEMS = I_IN + 2 * I_NA + I_O + I_UP + I_DN;
        for (int it = gw; it < NITEMS; it += NGW) {
            int r = it;
            if (r < I_IN) { tr_item(w_in, D, NIN, WT_in, (const float*)nullptr, scr, r, lane, CmIn()); continue; } r -= I_IN;
            if (r < I_NA) { tr_item(w_na, 512, D, WT_na, (const float*)nullptr, scr, r, lane, CmId()); continue; } r -= I_NA;
            if (r < I_NA) { tr_item(w_hg, 512, D, WT_hg, (const float*)nullptr, scr, r, lane, CmId()); continue; } r -= I_NA;
            if (r < I_O) { tr_item(w_o, D, D, WT_o, (const float*)nullptr, scr, r, lane, CmId()); continue; } r -= I_O;
            if (r < I_UP) { tr_item(w_up, D, FF, WT_up, g_mlp, scr, r, lane, CmId()); continue; } r -= I_UP;
            tr_item(w_dn, FF, D, WT_dn, (const float*)nullptr, scr, r, lane, CmId());
        }
        for (int m0 = gw; m0 < M; m0 += 4 * NGW) {
            f32x4 v[4][4];
            if (m0 == gw) {
#pragma unroll
                for (int q = 0; q < 4; ++q)
#pragma unroll
                    for (int j = 0; j < 4; ++j) v[q][j] = xv0[q][j];
            } else {
#pragma unroll
                for (int q = 0; q < 4; ++q)
#pragma unroll
                    for (int j = 0; j < 4; ++j) v[q][j] = *(const f32x4*)(x + (size_t)(m0 + q * NGW) * D + 4 * lane + 256 * j);
            }
#pragma unroll
            for (int q = 0; q < 4; ++q) { const int m = m0 + q * NGW; float s = 0.f;
#pragma unroll
                for (int j = 0; j < 4; ++j) s += (v[q][j].x * v[q][j].x + v[q][j].y * v[q][j].y) + (v[q][j].z * v[q][j].z + v[q][j].w * v[q][j].w);
                const float rs = rsqrtf(wave_sum(s) * (1.0f / D) + EPS);
#pragma unroll
                for (int j = 0; j < 4; ++j) { const f32x4 g = *(const f32x4*)(g_mix + 4 * lane + 256 * j);
                    v2u o; o.x = pk2(v[q][j].x * rs * g.x, v[q][j].y * rs * g.y); o.y = pk2(v[q][j].z * rs * g.z, v[q][j].w * rs * g.w);
                    *(v2u*)(XN + (size_t)m * D + 4 * lane + 256 * j) = o; } } }
    }
    xcd_barrier(bar);

    int vb = bx; bool xl = false;
    { const unsigned nloc = ((volatile LAS unsigned*)(lds + LDS_CTL + 32))[0], nx = ((volatile LAS unsigned*)(lds + LDS_CTL + 32))[1];
      bool even = (G == 256 && nloc == 32u && nx == 8u && bar.x < 8u && my_rank < 32u);
#pragma unroll
      for (int j = 0; j < 8; ++j) even = even && (xb_ld((unsigned*)(ws + WS_BAR) + XB_XCNT(j)) == 32u);
      if (even) { vb = (int)(my_rank * 8u + bar.x); xl = true; } }
    vb = __builtin_amdgcn_readfirstlane(vb);
#define PHASE_BAR() do { if (xl) xcd_local_barrier(bar); else xcd_barrier(bar); } while (0)
    const int xq = vb & 7, rk = vb >> 3, lw = rk * 8 + wave;
#define MK_EPI(NAME, MODE) pg8::EpiAll<MODE> NAME; NAME.ws = ws; NAME.out = out; NAME.x = x; NAME.gain = hg_gain; NAME.gfin = g_fin;
    {
        MK_EPI(E, pg8::EM_IN)
        pg8::Gemm g{XN, WT_in, M, NIN, D}; pg8::StaticOrder S; S.init(M, NIN, G, vb);
        pg8::gemm_phase<pg8::EpiAll<pg8::EM_IN>, pg8::StaticOrder, true, true>(lds, g, S, E);
    }
    PHASE_BAR();

    { const int wi = xq * 256 + lw;
        const int item = wi >> 2, vq = wi & 3, seg = item & 7, dir = (item >> 3) & 1, h = (item >> 4) & 3, b = item >> 6;
        f32x4 S[8][2], Dp[8];
#pragma unroll
        for (int kt = 0; kt < 8; ++kt) { S[kt][0] = (f32x4){0.f, 0.f, 0.f, 0.f}; S[kt][1] = (f32x4){0.f, 0.f, 0.f, 0.f}; Dp[kt] = (f32x4){1.f, 1.f, 1.f, 1.f}; }
        if (dir == 0 && seg == 0) hg_update<false>(S, Dp, KFTm, VHTm, GFm, (unsigned)(h * 128), vq, lm, kq);
        const bf16* KTp = dir ? KBT : KFT; const float* Gp = dir ? GB : GF;
        const int cstep = dir ? -512 : 512; const int cb0 = (b * 128 + seg * 16 + (dir ? 15 : 0)) * 512 + h * 128;
        {
            LAS unsigned char* stg0 = lds + (wave >> 2) * 9216;
            s16x4 kv[2][2], vbn[2][2], vbr[2][2]; v2u g8 = (v2u){0u, 0u};
#define B1_LOADS(IT) do { _Pragma("unroll") for (int u = 0; u < 2; ++u) { const unsigned cb_ = (unsigned)(cb0 + (2 * (IT) + u) * cstep); \
                _Pragma("unroll") for (int kk = 0; kk < 2; ++kk) kv[u][kk] = *(const s16x4*)(KTp + (unsigned)((cb_ + 16 * (2 * vq + kk) + lm) * 16 + 4 * kq)); \
                _Pragma("unroll") for (int vt = 0; vt < 2; ++vt) vbn[u][vt] = *(const s16x4*)(VHT + (unsigned)((cb_ + 32 * vq + 16 * vt + lm) * 16 + 4 * kq)); \
                if (vq == u) g8 = *(const v2u*)(Gp + cb_ + 2 * lane); } } while (0)
#define B1_STORE(STG) do { _Pragma("unroll") for (int u = 0; u < 2; ++u) { \
                _Pragma("unroll") for (int kk = 0; kk < 2; ++kk) *(LAS s16x4*)((STG) + (u * 8 + 2 * vq + kk) * 512 + lane * 8) = kv[u][kk]; \
                if (vq == u) *(LAS v2u*)((STG) + 8192 + u * 512 + lane * 8) = g8; } } while (0)
            __syncthreads();
            B1_LOADS(0);
            B1_STORE(stg0);
#pragma unroll
            for (int u = 0; u < 2; ++u) { vbr[u][0] = vbn[u][0]; vbr[u][1] = vbn[u][1]; }
            for (int it = 0; it < 8; ++it) {
                __syncthreads();
                LAS unsigned char* stg = stg0 + (it & 1) * 18432;
                if (it < 7) B1_LOADS(it + 1);
                __builtin_amdgcn_sched_barrier(0);
#pragma unroll
                for (int u = 0; u < 2; ++u)
#pragma unroll
                    for (int kt = 0; kt < 8; ++kt) { const s16x4 ka = *(const LAS s16x4*)(stg + (u * 8 + kt) * 512 + lane * 8); const f32x4 g = *(const LAS f32x4*)(stg + 8192 + u * 512 + (16 * kt + 4 * kq) * 4);
#pragma unroll
                        for (int vt = 0; vt < 2; ++vt) { S[kt][vt] = __builtin_amdgcn_mfma_f32_16x16x16bf16_1k(ka, vbr[u][vt], S[kt][vt], 0, 0, 0); S[kt][vt] = S[kt][vt] * g; }
                        Dp[kt] = Dp[kt] * g; }
                __builtin_amdgcn_sched_barrier(0);
                if (it < 7) { B1_STORE(stg0 + ((it + 1) & 1) * 18432);
#pragma unroll
                    for (int u = 0; u < 2; ++u) { vbr[u][0] = vbn[u][0]; vbr[u][1] = vbn[u][1]; } }
            }
#undef B1_LOADS
#undef B1_STORE
        }
        float* sp = SBUF + ((size_t)(item * 4 + vq) * 16) * 256 + lane * 4;
#pragma unroll
        for (int kt = 0; kt < 8; ++kt) { *(f32x4*)(sp + (kt * 2 + 0) * 256) = S[kt][0]; *(f32x4*)(sp + (kt * 2 + 1) * 256) = S[kt][1]; }
        if (vq == 0 && lm == 0) {
#pragma unroll
            for (int kt = 0; kt < 8; ++kt) *(f32x4*)(DSEG + item * 128 + 16 * kt + 4 * kq) = Dp[kt];
        }
    }
    PHASE_BAR();

    for (int i2 = 0; i2 < 2; ++i2) { const int tl = rk * 512 + tid + 16384 * i2;
        const int bhd = xq * 8 + (tl >> 12), e4 = tl & 4095, dir = bhd & 1; const int kt = (e4 >> 7) & 7, ln = e4 & 63; const int k0 = 16 * kt + 4 * (ln >> 4);
        f32x4 carry = (f32x4){0.f, 0.f, 0.f, 0.f}, locv[8], dv[8];
#pragma unroll
        for (int s = 0; s < 8; ++s) { const int seg = dir ? 7 - s : s, item = bhd * 8 + seg;
            locv[s] = *(const f32x4*)(SBUF + (size_t)item * 16384 + e4 * 4); dv[s] = *(const f32x4*)(DSEG + item * 128 + k0); }
#pragma unroll
        for (int s = 0; s < 8; ++s) { const int seg = dir ? 7 - s : s, item = bhd * 8 + seg;
            *(f32x4*)(SBUF + (size_t)item * 16384 + e4 * 4) = carry; carry = dv[s] * carry + locv[s]; }
    }
    {
        LAS float* rp = (LAS float*)lds;
        __syncthreads();
        for (int i = tid; i < 8 * 465; i += NWAVES * 64) rp[i] = rpb[i];
        __syncthreads();
        LAS unsigned char* KS = lds + 15360; LAS unsigned char* VS = lds + 15360 + 73728;
        int prev_hi = -1;
        for (int i4 = 0; i4 < 4; ++i4) {
            const int hh = rk >> 2, rg = rk & 3, rpair = 8 * rg + 2 * i4;
            const int cq = wave & 3, r = rpair + (wave >> 2), h = hh, b = xq;
            const int lo = min(max(rpair - 4, 0), 24);
            __syncthreads();
            { const int c = tid >> 3, q = tid & 7;
              if (i4 == 0) {
                v4u kreg[9], vreg[9];
#pragma unroll
                for (int e9 = 0; e9 < 9; ++e9) { const int row = min(lo + e9, 31);
                    kreg[e9] = *(const v4u*)(KNA + ((size_t)b * SEQ + row * 64 + c) * 512 + h * 64 + q * 8);
                    vreg[e9] = *(const v4u*)(VT + ((((size_t)(b * 8 + h) * 32 + row) * 64 + c) * 64 + q * 8)); }
#pragma unroll
                for (int e9 = 0; e9 < 9; ++e9) { const int kk = ((lo + e9) % 9) * 64 + c;
                    *(LAS v4u*)(KS + kk * 128 + ((q ^ (kk & 7)) * 16)) = kreg[e9]; *(LAS v4u*)(VS + kk * 128 + ((q ^ (kk & 7)) * 16)) = vreg[e9]; }
              } else {
                v4u kreg[2], vreg[2];
#pragma unroll
                for (int e2 = 0; e2 < 2; ++e2) { const int row = min(prev_hi + 1 + e2, 31);
                    kreg[e2] = *(const v4u*)(KNA + ((size_t)b * SEQ + row * 64 + c) * 512 + h * 64 + q * 8);
                    vreg[e2] = *(const v4u*)(VT + ((((size_t)(b * 8 + h) * 32 + row) * 64 + c) * 64 + q * 8)); }
#pragma unroll
                for (int e2 = 0; e2 < 2; ++e2) { const int row = prev_hi + 1 + e2;
                    if (row <= lo + 8 && row < 32) { const int kk = (row % 9) * 64 + c;
                        *(LAS v4u*)(KS + kk * 128 + ((q ^ (kk & 7)) * 16)) = kreg[e2]; *(LAS v4u*)(VS + kk * 128 + ((q ^ (kk & 7)) * 16)) = vreg[e2]; } }
              }
            }
            prev_hi = lo + 8;
            __syncthreads();
            const int c0 = 16 * cq, kc0 = (cq == 0) ? 0 : (cq == 1) ? 8 : (cq == 2) ? 24 : 32;
            const int rs0 = min(max(r - 4, 0), 24);
            const size_t rowq = (size_t)b * SEQ + r * 64 + c0 + lm;
            bf16x8 qf[2], kmf[2]; s16x4 vmf[4];
#pragma unroll
            for (int ks = 0; ks < 2; ++ks) { qf[ks] = *(const bf16x8*)(QNA + rowq * 512 + h * 64 + 32 * ks + 8 * kq); kmf[ks] = *(const bf16x8*)(KNAm + lm * 512 + h * 64 + 32 * ks + 8 * kq); }
#pragma unroll
            for (int dt = 0; dt < 4; ++dt) vmf[dt] = *(const s16x4*)(VTm + (h * 64 + 16 * dt + lm) * 16 + 4 * kq);
            const int cqq = c0 + lm, cs = min(max(cqq - 8, 0), 48);
            f32x4 oa[4];
#pragma unroll
            for (int dt = 0; dt < 4; ++dt) oa[dt] = (f32x4){0.f, 0.f, 0.f, 0.f};
            float mrun = -3.0e38f, lsum = 0.f;
#pragma unroll
            for (int hf = 0; hf < 2; ++hf) {
                f32x4 sc[9]; bf16x8 vf[4][4];
                {   bf16x8 kf[4][2][2];
#pragma unroll
                    for (int j4 = 0; j4 < 4; ++j4)
#pragma unroll
                        for (int t = 0; t < 2; ++t) { const int kcol = kc0 + 8 * (lm >> 2) + 4 * t + (lm & 3); const size_t rowk = (size_t)b * SEQ + (rs0 + 4 * hf + j4) * 64 + kcol;
#pragma unroll
                            for (int ks = 0; ks < 2; ++ks) { const int kk = ((rs0 + 4 * hf + j4) % 9) * 64 + kcol; kf[j4][t][ks] = *(const LAS bf16x8*)(KS + kk * 128 + (((ks * 4 + kq) ^ (kk & 7)) * 16)); } (void)rowk; }
                    __builtin_amdgcn_sched_barrier(0);
#pragma unroll
                    for (int j4 = 0; j4 < 4; ++j4)
#pragma unroll
                        for (int t = 0; t < 2; ++t) { f32x4 a = (f32x4){0.f, 0.f, 0.f, 0.f};
#pragma unroll
                            for (int ks = 0; ks < 2; ++ks) a = __builtin_amdgcn_mfma_f32_16x16x32_bf16(kf[j4][t][ks], qf[ks], a, 0, 0, 0);
                            sc[2 * j4 + t] = a; }
                }
                __builtin_amdgcn_sched_barrier(0);
#pragma unroll
                for (int j4 = 0; j4 < 4; ++j4)
#pragma unroll
                    for (int dt = 0; dt < 4; ++dt) { const int vv = ((rs0 + 4 * hf + j4) % 9) * 64 + 16 * dt + lm; vf[j4][dt] = *(const LAS bf16x8*)(VS + vv * 128 + ((((kc0 >> 3) + kq) ^ (vv & 7)) * 16)); }
                __builtin_amdgcn_sched_barrier(0);
                if (hf == 1) { f32x4 a = (f32x4){0.f, 0.f, 0.f, 0.f};
#pragma unroll
                    for (int ks = 0; ks < 2; ++ks) a = __builtin_amdgcn_mfma_f32_16x16x32_bf16(kmf[ks], qf[ks], a, 0, 0, 0);
                    sc[8] = a; } else sc[8] = (f32x4){-1e30f, -1e30f, -1e30f, -1e30f};
                float mx = -3.0e38f;
#pragma unroll
                for (int j4 = 0; j4 < 4; ++j4)
#pragma unroll
                    for (int t = 0; t < 2; ++t)
#pragma unroll
                        for (int j = 0; j < 4; ++j) { const int kcol = kc0 + 8 * kq + 4 * t + j; const bool inw = (kcol >= cs) && (kcol < cs + 16);
                            const int dr = rs0 + 4 * hf + j4 - r, dc = min(max(kcol - cqq, -15), 15);
                            const float bias = rp[h * 465 + (dr + 7) * 31 + dc + 15];
                            const float s = inw ? sc[2 * j4 + t][j] + bias : -1e30f; sc[2 * j4 + t][j] = s; mx = fmaxf(mx, s); }
#pragma unroll
                for (int j = 0; j < 4; ++j) mx = fmaxf(mx, sc[8][j]);
                mx = fmaxf(mx, __shfl_xor(mx, 16)); mx = fmaxf(mx, __shfl_xor(mx, 32));
                const float mnew = fmaxf(mrun, mx), alpha = __expf(mrun - mnew);
                mrun = mnew; lsum *= alpha;
#pragma unroll
                for (int dt = 0; dt < 4; ++dt) oa[dt] = oa[dt] * alpha;
#pragma unroll
                for (int i = 0; i < 9; ++i)
#pragma unroll
                    for (int j = 0; j < 4; ++j) { const float p = __expf(sc[i][j] - mnew); sc[i][j] = p; lsum += p; }
#pragma unroll
                for (int j4 = 0; j4 < 4; ++j4) {
                    union { bf16x8 v; unsigned u[4]; } pf;
                    pf.u[0] = cvt_pk_bf16(sc[2 * j4][0], sc[2 * j4][1]); pf.u[1] = cvt_pk_bf16(sc[2 * j4][2], sc[2 * j4][3]);
                    pf.u[2] = cvt_pk_bf16(sc[2 * j4 + 1][0], sc[2 * j4 + 1][1]); pf.u[3] = cvt_pk_bf16(sc[2 * j4 + 1][2], sc[2 * j4 + 1][3]);
#pragma unroll
                    for (int dt = 0; dt < 4; ++dt) oa[dt] = __builtin_amdgcn_mfma_f32_16x16x32_bf16(vf[j4][dt], pf.v, oa[dt], 0, 0, 0); }
                if (hf == 1) { union { s16x4 v; unsigned u[2]; } pm; pm.u[0] = cvt_pk_bf16(sc[8][0], sc[8][1]); pm.u[1] = cvt_pk_bf16(sc[8][2], sc[8][3]);
#pragma unroll
                    for (int dt = 0; dt < 4; ++dt) oa[dt] = __builtin_amdgcn_mfma_f32_16x16x16bf16_1k(vmf[dt], pm.v, oa[dt], 0, 0, 0); }
            }
            lsum += __shfl_xor(lsum, 16); lsum += __shfl_xor(lsum, 32);
            const float inv = 1.0f / lsum;
#pragma unroll
            for (int dt = 0; dt < 4; ++dt) { v2u o; o.x = cvt_pk_bf16(oa[dt][0] * inv, oa[dt][1] * inv); o.y = cvt_pk_bf16(oa[dt][2] * inv, oa[dt][3] * inv);
                *(v2u*)(ONA + rowq * 512 + h * 64 + 16 * dt + 4 * kq) = o; }
        }
        __syncthreads();
    }
    PHASE_BAR();

    { const int it = xq * 32 + rk;
        const int seg = it & 7, h = (it >> 3) & 3, b = it >> 5;
        const int dir = wave >> 2, vq = wave & 3, sitem = ((b * 4 + h) * 2 + dir) * 8 + seg;
        LAS unsigned short* ob = (LAS unsigned short*)lds;
        LAS unsigned char* stg0 = lds + 65536 + dir * 17408;
        __syncthreads();
        f32x4 S[8][2], Dp[8];
        { const float* sp = SBUF + ((size_t)(sitem * 4 + vq) * 16) * 256 + lane * 4;
#pragma unroll
          for (int kt = 0; kt < 8; ++kt) { S[kt][0] = *(const f32x4*)(sp + (kt * 2 + 0) * 256); S[kt][1] = *(const f32x4*)(sp + (kt * 2 + 1) * 256); Dp[kt] = (f32x4){1.f, 1.f, 1.f, 1.f}; } }
        if (dir == 0 && seg == 0) hg_update<false>(S, Dp, KFTm, VHTm, GFm, (unsigned)(h * 128), vq, lm, kq);
        const bf16* Qn = dir ? QB : QF; const bf16* Kn = dir ? KB : KF; const bf16* KTp = dir ? KBT : KFT; const float* Gp = dir ? GB : GF;
        s16x4 qv[2][2], kv[2][2], vbn[2][2]; v2u g8 = (v2u){0u, 0u};
#define B3_LOADS(IT) do { _Pragma("unroll") for (int u = 0; u < 2; ++u) { const int cl_ = dir ? 15 - (2 * (IT) + u) : 2 * (IT) + u; const size_t cgi_ = (size_t)b * 128 + seg * 16 + cl_, row0_ = cgi_ * 16; const unsigned cb_ = (unsigned)(cgi_ * 512 + h * 128); \
            _Pragma("unroll") for (int kk = 0; kk < 2; ++kk) { const int kt_ = 2 * vq + kk; \
                qv[u][kk] = *(const s16x4*)(Qn + (row0_ + lm) * 512 + h * 128 + 16 * kt_ + 4 * kq); \
                kv[u][kk] = *(const s16x4*)(KTp + (unsigned)((cb_ + 16 * kt_ + lm) * 16 + 4 * kq)); } \
            _Pragma("unroll") for (int vt = 0; vt < 2; ++vt) vbn[u][vt] = *(const s16x4*)(VHT + (unsigned)((cb_ + 32 * vq + 16 * vt + lm) * 16 + 4 * kq)); \
            if (vq == u) g8 = *(const v2u*)(Gp + cb_ + 2 * lane); } } while (0)
#define B3_STORE(STG) do { _Pragma("unroll") for (int u = 0; u < 2; ++u) { \
            _Pragma("unroll") for (int kk = 0; kk < 2; ++kk) { const int f_ = u * 8 + 2 * vq + kk; \
                *(LAS s16x4*)((STG) + f_ * 512 + lane * 8) = qv[u][kk]; *(LAS s16x4*)((STG) + 8192 + f_ * 512 + lane * 8) = kv[u][kk]; } \
            if (vq == u) *(LAS v2u*)((STG) + 16384 + u * 512 + lane * 8) = g8; } } while (0)
        B3_LOADS(0);
        {
            LAS v2u* PA = (LAS v2u*)(lds + 135168);
            bf16x8 kn4[4][4], qn4[4][4];
#pragma unroll
            for (int q = 0; q < 4; ++q) { const size_t r0 = ((size_t)b * 128 + seg * 16 + vq + 4 * q) * 16;
#pragma unroll
                for (int ii = 0; ii < 4; ++ii) { const size_t o = (r0 + lm) * 512 + h * 128 + 32 * ii + 8 * kq; kn4[q][ii] = *(const bf16x8*)(Kn + o); qn4[q][ii] = *(const bf16x8*)(Qn + o); } }
#pragma unroll
            for (int q = 0; q < 4; ++q) { f32x4 at = (f32x4){0.f, 0.f, 0.f, 0.f};
#pragma unroll
                for (int ii = 0; ii < 4; ++ii) at = __builtin_amdgcn_mfma_f32_16x16x32_bf16(kn4[q][ii], qn4[q][ii], at, 0, 0, 0);
#pragma unroll
                for (int j = 0; j < 4; ++j) { const int s = 4 * kq + j; const bool keep = dir ? (s >= lm) : (s <= lm); at[j] = keep ? at[j] : 0.f; }
                v2u w; w.x = cvt_pk_bf16(at[0], at[1]); w.y = cvt_pk_bf16(at[2], at[3]);
                PA[(dir * 16 + vq + 4 * q) * 64 + lane] = w; }
        }
        __syncthreads();
        B3_STORE(stg0);
        s16x4 vbr[2][2];
#pragma unroll
        for (int u = 0; u < 2; ++u) { vbr[u][0] = vbn[u][0]; vbr[u][1] = vbn[u][1]; }
        for (int it = 0; it < 8; ++it) {
            __syncthreads();
            LAS unsigned char* stg = stg0 + (it & 1) * 34816;
            if (it < 7) B3_LOADS(it + 1);
            __builtin_amdgcn_sched_barrier(0);
#pragma unroll
            for (int u = 0; u < 2; ++u) { const int cl = dir ? 15 - (2 * it + u) : 2 * it + u;
                union { s16x4 v; v2u u2; } pa; pa.u2 = ((const LAS v2u*)(lds + 135168))[(dir * 16 + cl) * 64 + lane];
                f32x4 o2[2]; o2[0] = (f32x4){0.f, 0.f, 0.f, 0.f}; o2[1] = (f32x4){0.f, 0.f, 0.f, 0.f};
#pragma unroll
                for (int kt = 0; kt < 8; ++kt) { const s16x4 q4 = *(const LAS s16x4*)(stg + (u * 8 + kt) * 512 + lane * 8);
#pragma unroll
                    for (int vt = 0; vt < 2; ++vt) { union { s16x4 v; unsigned u[2]; } sb; sb.u[0] = cvt_pk_bf16(S[kt][vt][0], S[kt][vt][1]); sb.u[1] = cvt_pk_bf16(S[kt][vt][2], S[kt][vt][3]);
                        o2[vt] = __builtin_amdgcn_mfma_f32_16x16x16bf16_1k(q4, sb.v, o2[vt], 0, 0, 0); } }
#pragma unroll
                for (int vt = 0; vt < 2; ++vt) { o2[vt] = __builtin_amdgcn_mfma_f32_16x16x16bf16_1k(pa.v, vbr[u][vt], o2[vt], 0, 0, 0);
#pragma unroll
                    for (int j = 0; j < 4; ++j) { LAS unsigned short* op = ob + (16 * cl + 4 * kq + j) * 128 + 32 * vq + 16 * vt + lm;
                        const float val = (it < 4) ? o2[vt][j] : (bflo((unsigned)*op) + o2[vt][j]); *op = f2bf(val); } }
#pragma unroll
                for (int kt = 0; kt < 8; ++kt) { const s16x4 ka = *(const LAS s16x4*)(stg + 8192 + (u * 8 + kt) * 512 + lane * 8); const f32x4 g = *(const LAS f32x4*)(stg + 16384 + u * 512 + (16 * kt + 4 * kq) * 4);
#pragma unroll
                    for (int vt = 0; vt < 2; ++vt) { S[kt][vt] = __builtin_amdgcn_mfma_f32_16x16x16bf16_1k(ka, vbr[u][vt], S[kt][vt], 0, 0, 0); S[kt][vt] = S[kt][vt] * g; } }
            }
            __builtin_amdgcn_sched_barrier(0);
            if (it < 7) { B3_STORE(stg0 + ((it + 1) & 1) * 34816);
#pragma unroll
                for (int u = 0; u < 2; ++u) { vbr[u][0] = vbn[u][0]; vbr[u][1] = vbn[u][1]; } }
        }
#undef B3_LOADS
#undef B3_STORE
        v4u ggp[8];
#pragma unroll
        for (int i = 0; i < 8; ++i) ggp[i] = *(const v4u*)(GHG + ((size_t)b * SEQ + seg * 256 + wave * 32 + 4 * i + kq) * 512 + h * 128 + 8 * lm);
        __syncthreads();
#pragma unroll
        for (int i = 0; i < 8; ++i) { const int tl = wave * 32 + 4 * i + kq; const size_t row = (size_t)b * SEQ + seg * 256 + tl;
            const v4u ov = *(const LAS v4u*)(ob + tl * 128 + 8 * lm);
            const f32x4 v0 = (f32x4){bflo(ov.x), bfhi(ov.x), bflo(ov.y), bfhi(ov.y)}, v1 = (f32x4){bflo(ov.z), bfhi(ov.z), bflo(ov.w), bfhi(ov.w)};
            const v4u gg = ggp[i];
            float s = (v0.x * v0.x + v0.y * v0.y) + (v0.z * v0.z + v0.w * v0.w) + (v1.x * v1.x + v1.y * v1.y) + (v1.z * v1.z + v1.w * v1.w);
            s += __shfl_xor(s, 1); s += __shfl_xor(s, 2); s += __shfl_xor(s, 4); s += __shfl_xor(s, 8);
            const float rs = rsqrtf(s * (1.0f / 128.0f) + EPS);
            v4u o; o.x = cvt_pk_bf16(v0.x * rs * bflo(gg.x), v0.y * rs * bfhi(gg.x)); o.y = cvt_pk_bf16(v0.z * rs * bflo(gg.y), v0.w * rs * bfhi(gg.y));
            o.z = cvt_pk_bf16(v1.x * rs * bflo(gg.z), v1.y * rs * bfhi(gg.z)); o.w = cvt_pk_bf16(v1.z * rs * bflo(gg.w), v1.w * rs * bfhi(gg.w));
            *(v4u*)(OHG + row * 512 + h * 128 + 8 * lm) = o; }
        __syncthreads();
    }
    PHASE_BAR();

    {
        MK_EPI(E, pg8::EM_C1A)
        pg8::Gemm g{ONA, WT_na, 2 * M, 2 * D, 512}; pg8::PairOrder S; S.init(M, D, G, vb);
        pg8::gemm_phase<pg8::EpiAll<pg8::EM_C1A>, pg8::PairOrder, true, true>(lds, g, S, E);
    }
    PHASE_BAR();
    {
        MK_EPI(E, pg8::EM_C2)
        pg8::Gemm g{MIX, WT_o, M, D, D}; pg8::StaticOrder S; S.init(M, D, G, vb);
        pg8::gemm_phase<pg8::EpiAll<pg8::EM_C2>, pg8::StaticOrder, true, true>(lds, g, S, E);
    }
    PHASE_BAR();
    {
        MK_EPI(E, pg8::EM_C3)
        pg8::Gemm g{H1B, WT_up, M, FF, D}; pg8::StaticOrder S; S.init(M, FF, G, vb);
        pg8::gemm_phase<pg8::EpiAll<pg8::EM_C3>, pg8::StaticOrder, true, true>(lds, g, S, E);
    }
    PHASE_BAR();
    {
        MK_EPI(E, pg8::EM_C4)
        pg8::Gemm g{U, WT_dn, M, D, FF}; pg8::StaticOrder S; S.init(M, D, G, vb);
        pg8::gemm_phase<pg8::EpiAll<pg8::EM_C4>, pg8::StaticOrder, true, true>(lds, g, S, E);
    }

}

extern "C" void kernel_launch(void* const* d_in, const int* in_sizes, int n_in, void* d_out, int out_size, void* d_ws, size_t ws_size, hipStream_t stream) {
    static int grid = 0;
    if (grid == 0) {
        if (n_in != 14 || in_sizes[0] != M * D || out_size != M * D || ws_size < WS_END) { fprintf(stderr, "kernel_launch: unexpected shapes / workspace (n_in %d, in0 %d, out %d, ws %zu)\n", n_in, n_in > 0 ? in_sizes[0] : -1, out_size, ws_size); grid = -1; return; }
        int dev = 0, cus = 0, per_cu = 0;
        if (hipGetDevice(&dev) != hipSuccess || hipDeviceGetAttribute(&cus, hipDeviceAttributeMultiprocessorCount, dev) != hipSuccess) { grid = -1; return; }
        if (hipFuncSetAttribute((const void*)mk_fwd, hipFuncAttributeMaxDynamicSharedMemorySize, LDS_BYTES) != hipSuccess) { fprintf(stderr, "kernel_launch: hipFuncSetAttribute failed\n"); grid = -1; return; }
        if (hipOccupancyMaxActiveBlocksPerMultiprocessor(&per_cu, (const void*)mk_fwd, NWAVES * 64, LDS_BYTES) != hipSuccess || per_cu < 1) { fprintf(stderr, "kernel_launch: occupancy query failed (%d)\n", per_cu); (void)hipGetLastError(); per_cu = 1; }
        if (cus != 256) fprintf(stderr, "kernel_launch: built for a 256-CU device (found %d)\n", cus);
        grid = 256;
    }
    if (grid < 0) return;
    Args a{};
    for (int i = 0; i < 14; ++i) a.in[i] = (const float*)d_in[i];
    a.out = (float*)d_out; a.ws = (unsigned char*)d_ws;
    if (hipMemsetAsync((char*)d_ws + WS_BAR, 0, BAR_BYTES, stream) != hipSuccess) { fprintf(stderr, "kernel_launch: memset failed\n"); return; }
    hipLaunchKernelGGL(mk_fwd, dim3(grid), dim3(NWAVES * 64), LDS_BYTES, stream, a);
    const hipError_t e = hipPeekAtLastError();
    if (e != hipSuccess) fprintf(stderr, "kernel_launch: launch failed: %s (grid %d)\n", hipGetErrorName(e), grid);
}
```

```cpp
#include <hip/hip_runtime.h>
#include <cstdio>
#include <cstdint>
constexpr int NWAVES = 8;
constexpr int NB = 8, SEQ = 2048, D = 1024, M = NB * SEQ, NIN = 6144, FF = 4096;
constexpr float EPS = 1e-6f;
constexpr size_t MiB = 1u << 20, KiB = 1024;
constexpr size_t WS_SSQ1 = 245 * MiB, WS_SSQ2 = 246 * MiB,
                WS_KNAM = 128 * KiB, WS_VTM = 144 * KiB, WS_KFTM = 160 * KiB, WS_VHTM = 176 * KiB, WS_GFM = 192 * KiB, WS_LB = 196 * KiB, WS_DSEG = 256 * KiB;
constexpr size_t WS_WIN = 1 * MiB, WS_WNA = 13 * MiB, WS_WHG = 14 * MiB, WS_WO = 15 * MiB, WS_WUP = 17 * MiB, WS_WDN = 237 * MiB;
constexpr size_t WS_XN = 25 * MiB;
constexpr size_t WS_QNA = 57 * MiB, WS_KNA = 73 * MiB, WS_VT = 89 * MiB, WS_QF = 105 * MiB, WS_QB = 121 * MiB, WS_KF = 137 * MiB, WS_KFT = 153 * MiB, WS_KB = 169 * MiB, WS_KBT = 185 * MiB,
                 WS_VHT = 201 * MiB, WS_GHG = 217 * MiB, WS_GF = 233 * MiB, WS_GB = 235 * MiB;
constexpr size_t WS_OHG = WS_KNA;
constexpr size_t WS_T = WS_VT, WS_MIX = WS_KF, WS_U = WS_QNA, WS_END = 247 * MiB;
constexpr int LDS_BYTES = 163840, LDS_CTL = 162816;
constexpr size_t WS_C4CNT = 768 * 1024 + 16 * 1024;

namespace pg8 {
#define PG8_LAS __attribute__((address_space(3)))
typedef unsigned short bf16_t;
typedef short bf16x8 __attribute__((ext_vector_type(8)));
typedef float f32x4 __attribute__((ext_vector_type(4)));
typedef unsigned u32x4 __attribute__((ext_vector_type(4)));
constexpr int BM = 256, BK = 64, HALF = 128, HTB = HALF * BK * 2  , STAGE_BYTES = 8 * HTB, NXCD = 8, WGM = 8;

__host__ __device__ __forceinline__ int lds_byte(int r, int c) { const int st = (r >> 4) * 2 + (c >> 5), rr = r & 15, cc = c & 31, ob = rr * 64 + cc * 2; return st * 1024 + (ob ^ (((ob >> 9) & 1) << 5)); }
__host__ __device__ __forceinline__ void stage_rc(int b, int& R, int& C) { const int st = b / 1024, sb = b % 1024, swz = sb ^ (((sb >> 9) & 1) << 5); R = (st >> 1) * 16 + swz / 64; C = (st & 1) * 32 + (swz % 64) / 2; }
__host__ __device__ __forceinline__ int perm32(int rho) { const int n = rho >> 4, i = rho & 15; return 8 * (i >> 2) + 4 * n + (i & 3); }

struct Unit { int pm, pn; };
struct Gemm { const bf16_t* A; const bf16_t* Bt; int M, N, K; };

struct StaticOrder {
    int nM, nN, nwg, G, c;
    __host__ __device__ void init(int M, int N, int G_, int c_) { nM = M / BM; nN = N / BM; nwg = nM * nN; G = G_; c = c_; }
    __host__ __device__ bool next(int i, Unit& u) const {
        const long L = (long)i * G + c; if (L >= nwg) return false;
        int wgid = (int)L; { const int q = nwg / NXCD, r = nwg % NXCD, xcd = wgid % NXCD, off = wgid / NXCD; wgid = (xcd < r ? xcd * (q + 1) : r * (q + 1) + (xcd - r) * q) + off; }
        const int nig = WGM * nN, gid = wgid / nig, fm = gid * WGM, gsz = (nM - fm) < WGM ? (nM - fm) : WGM;
        u.pm = fm + ((wgid % nig) % gsz); u.pn = (wgid % nig) / gsz; return true;
    }
    __device__ __forceinline__ void a_ready(const Unit&) const {}
    __device__ __forceinline__ void done(const Unit&) const {}
};


struct PairOrder {
    StaticOrder base; Unit u0;
    __host__ __device__ void init(int M_, int N_, int G_, int c_) { base.init(M_, N_, G_, c_); base.next(0, u0); }
    __host__ __device__ bool next(int i, Unit& u) const { if (i >= 2) return false; u.pm = u0.pm + 64 * i; u.pn = u0.pn + 4 * i; return true; }
    __device__ __forceinline__ void a_ready(const Unit&) const {}
    __device__ __forceinline__ void done(const Unit&) const {}
};

typedef float cvt_f32x2_t __attribute__((ext_vector_type(2)));
typedef __bf16 cvt_bf16x2_t __attribute__((ext_vector_type(2)));
__device__ __forceinline__ unsigned cvt_pk_bf16(float lo, float hi) { const cvt_f32x2_t v = {lo, hi}; const cvt_bf16x2_t b = __builtin_convertvector(v, cvt_bf16x2_t); return __builtin_bit_cast(unsigned, b); }
__device__ __forceinline__ unsigned short f2bf(float f) { unsigned u = __builtin_bit_cast(unsigned, f); return (unsigned short)((u + 0x7fffu + ((u >> 16) & 1u)) >> 16); }
__device__ __forceinline__ float bflo(unsigned w) { return __builtin_bit_cast(float, w << 16); }
__device__ __forceinline__ float bfhi(unsigned w) { return __builtin_bit_cast(float, w & 0xffff0000u); }
__device__ __forceinline__ float sigm(float x) { return __builtin_amdgcn_rcpf(1.0f + __expf(-x)); }
template <int CTRL> __device__ __forceinline__ float dpp_mov(float v) { return __builtin_bit_cast(float, __builtin_amdgcn_update_dpp(0, __builtin_bit_cast(int, v), CTRL, 0xf, 0xf, true)); }
__device__ __forceinline__ float row_prefix16(float v, int fr) {
    v += dpp_mov<0x111>(v); v += dpp_mov<0x112>(v); v += dpp_mov<0x114>(v); v += dpp_mov<0x118>(v); (void)fr;
    return v;
}
__device__ __forceinline__ float row_suffix16(float v, int fr) {
    v += dpp_mov<0x101>(v); v += dpp_mov<0x102>(v); v += dpp_mov<0x104>(v); v += dpp_mov<0x108>(v); (void)fr;
    return v;
}

enum EpiMode { EM_IN = 0, EM_C1A = 1, EM_C1B = 2, EM_C2 = 3, EM_C3 = 4, EM_C4 = 5 };
template <int MODE> struct EpiAll {
    static constexpr bool PERM = true, AFTER_DRAIN = false;
    static constexpr int mode = MODE; unsigned char* ws; float* out; const float* x; const float* gain; const float* gfin;
    __device__ __forceinline__ void operator()(const f32x4 (&acc)[2][2][4][2], const Unit& u, int wr, int wc, int fr, int fq) const {
        const int pn = u.pn;
        const int row0 = u.pm * BM + wr * 64 + fr;
#define EP_B(off) ((bf16_t*)(ws + (off)))
#define EP_F(off) ((float*)(ws + (off)))
        bf16_t* const QNA = EP_B(WS_QNA); bf16_t* const KNA = EP_B(WS_KNA); bf16_t* const VT = EP_B(WS_VT); bf16_t* const QF = EP_B(WS_QF); bf16_t* const QB = EP_B(WS_QB); bf16_t* const KF = EP_B(WS_KF); bf16_t* const KB = EP_B(WS_KB);
        bf16_t* const KFT = EP_B(WS_KFT); bf16_t* const KBT = EP_B(WS_KBT); bf16_t* const VHT = EP_B(WS_VHT); bf16_t* const GHG = EP_B(WS_GHG); float* const GF = EP_F(WS_GF); float* const GB = EP_F(WS_GB); const float* const LB = EP_F(WS_LB);
        bf16_t* const SNA = (bf16_t*)out; bf16_t* const SHG = (bf16_t*)out + (size_t)M * D;
        bf16_t* const T = EP_B(WS_T); bf16_t* const MIX = EP_B(WS_MIX); bf16_t* const H1B = EP_B(WS_XN); bf16_t* const U = EP_B(WS_U); float* const ssq1 = EP_F(WS_SSQ1); float* const ssq2 = EP_F(WS_SSQ2);
#undef EP_B
#undef EP_F
        const int cl0 = wc * 32 + 8 * fq;
        if (mode == EM_IN) {
            if (pn < 4) {
                bf16_t* base = (pn < 2) ? QNA : KNA; const float sc = (pn < 2) ? 0.125f : 1.0f; const int colt = (pn & 1) * 256 + cl0;
#pragma unroll
                for (int ai = 0; ai < 2; ++ai)
#pragma unroll
                    for (int m = 0; m < 4; ++m) { bf16_t* rowp = base + (size_t)(row0 + ai * HALF + m * 16) * 512 + colt;
#pragma unroll
                        for (int bj = 0; bj < 2; ++bj) { const f32x4 v0 = acc[ai][bj][m][0] * sc, v1 = acc[ai][bj][m][1] * sc; u32x4 w;
                            w.x = cvt_pk_bf16(v0[0], v0[1]); w.y = cvt_pk_bf16(v0[2], v0[3]); w.z = cvt_pk_bf16(v1[0], v1[1]); w.w = cvt_pk_bf16(v1[2], v1[3]);
                            *(u32x4*)(rowp + bj * HALF) = w; } }
            } else if (pn < 6) {
                const int colt = (pn - 4) * 256 + cl0;
#pragma unroll
                for (int ai = 0; ai < 2; ++ai)
#pragma unroll
                    for (int m = 0; m < 4; ++m) { const int row = row0 + ai * HALF + m * 16; const int b = row >> 11, t = row & 2047, r = t >> 6, c = t & 63;
#pragma unroll
                        for (int bj = 0; bj < 2; ++bj) { const int col = colt + bj * HALF; const int h = col >> 6, d0 = col & 63;
                            bf16_t* bp = VT + ((((size_t)(b * 8 + h) * 32 + r) * 64 + d0) * 64 + c);
#pragma unroll
                            for (int n = 0; n < 2; ++n)
#pragma unroll
                                for (int j = 0; j < 4; ++j) bp[(4 * n + j) * 64] = f2bf(acc[ai][bj][m][n][j]); } }
            } else if (pn < 14) {
                const int ch0 = (pn - 6) * 64 + wc * 16 + fq * 4;
                const f32x4 lbf = *(const f32x4*)(LB + ch0), lbb = *(const f32x4*)(LB + 512 + ch0);
#pragma unroll
                for (int ai = 0; ai < 2; ++ai)
#pragma unroll
                    for (int m = 0; m < 4; ++m) { const int row = row0 + ai * HALF + m * 16; const int chunk = row >> 4;
                        const f32x4 q = acc[ai][0][m][0], zf = acc[ai][0][m][1], zb = acc[ai][1][m][0], iv = acc[ai][1][m][1];
                        float qfv[4], kfv[4], qbv[4], kbv[4]; f32x4 gfv, gbv;
#pragma unroll
                        for (int j = 0; j < 4; ++j) {
                            const float qs = q[j] * sigm(q[j]);
                            const float ff = lbf[j] + (1.0f - lbf[j]) * sigm(zf[j]);
                            const float fb = lbb[j] + (1.0f - lbb[j]) * sigm(zb[j]);
                            const float bf_ = row_prefix16(__builtin_amdgcn_logf(ff) * 0.69314718056f, fr), bb_ = row_suffix16(__builtin_amdgcn_logf(fb) * 0.69314718056f, fr);
                            const float ef = __expf(bf_), eb = __expf(bb_);
                            qfv[j] = qs * ef; kfv[j] = (1.0f - ff) * __expf(-bf_);
                            qbv[j] = qs * eb; kbv[j] = (1.0f - fb) * __expf(-bb_);
                            gfv[j] = ef; gbv[j] = eb;
                        }
                        typedef unsigned u32x2 __attribute__((ext_vector_type(2)));
                        const size_t ro = (size_t)row * 512 + ch0;
                        u32x2 w;
                        w.x = cvt_pk_bf16(qfv[0], qfv[1]); w.y = cvt_pk_bf16(qfv[2], qfv[3]); *(u32x2*)(QF + ro) = w;
                        w.x = cvt_pk_bf16(qbv[0], qbv[1]); w.y = cvt_pk_bf16(qbv[2], qbv[3]); *(u32x2*)(QB + ro) = w;
                        w.x = cvt_pk_bf16(kfv[0], kfv[1]); w.y = cvt_pk_bf16(kfv[2], kfv[3]); *(u32x2*)(KF + ro) = w;
                        w.x = cvt_pk_bf16(kbv[0], kbv[1]); w.y = cvt_pk_bf16(kbv[2], kbv[3]); *(u32x2*)(KB + ro) = w;
                        const size_t to = ((size_t)chunk * 512 + ch0) * 16 + fr;
#pragma unroll
                        for (int j = 0; j < 4; ++j) { KFT[to + j * 16] = f2bf(kfv[j]); KBT[to + j * 16] = f2bf(kbv[j]); VHT[to + j * 16] = f2bf(iv[j]); }
                        if (fr == 15) *(f32x4*)(GF + (size_t)chunk * 512 + ch0) = gfv;
                        if (fr == 0)  *(f32x4*)(GB + (size_t)chunk * 512 + ch0) = gbv;
                    }
            } else if (pn < 16) {
                const int colt = (pn - 14) * 256 + cl0;
#pragma unroll
                for (int bj = 0; bj < 2; ++bj) { const f32x4 g0 = *(const f32x4*)(gain + colt + bj * HALF), g1 = *(const f32x4*)(gain + colt + bj * HALF + 4);
#pragma unroll
                    for (int ai = 0; ai < 2; ++ai)
#pragma unroll
                        for (int m = 0; m < 4; ++m) { f32x4 v0 = acc[ai][bj][m][0], v1 = acc[ai][bj][m][1];
#pragma unroll
                            for (int j = 0; j < 4; ++j) { v0[j] = v0[j] * sigm(v0[j]) * g0[j]; v1[j] = v1[j] * sigm(v1[j]) * g1[j]; }
                            u32x4 w; w.x = cvt_pk_bf16(v0[0], v0[1]); w.y = cvt_pk_bf16(v0[2], v0[3]); w.z = cvt_pk_bf16(v1[0], v1[1]); w.w = cvt_pk_bf16(v1[2], v1[3]);
                            *(u32x4*)(GHG + (size_t)(row0 + ai * HALF + m * 16) * 512 + colt + bj * HALF) = w; } }
            } else {
                bf16_t* base = (pn < 20) ? SNA : SHG; const int colt = ((pn - 16) & 3) * 256 + cl0;
#pragma unroll
                for (int ai = 0; ai < 2; ++ai)
#pragma unroll
                    for (int m = 0; m < 4; ++m)
#pragma unroll
                        for (int bj = 0; bj < 2; ++bj) { f32x4 v0 = acc[ai][bj][m][0], v1 = acc[ai][bj][m][1];
#pragma unroll
                            for (int j = 0; j < 4; ++j) { v0[j] = sigm(v0[j]); v1[j] = sigm(v1[j]); }
                            u32x4 w; w.x = cvt_pk_bf16(v0[0], v0[1]); w.y = cvt_pk_bf16(v0[2], v0[3]); w.z = cvt_pk_bf16(v1[0], v1[1]); w.w = cvt_pk_bf16(v1[2], v1[3]);
                            *(u32x4*)(base + (size_t)(row0 + ai * HALF + m * 16) * 1024 + colt + bj * HALF) = w; }
            }
            return;
        }
        const int colt = (mode == EM_C1A ? (pn & 3) : pn) * BM + cl0;
        if (mode == EM_C1A || mode == EM_C1B) {
            const bool second = (mode == EM_C1B) || (pn >= 4); const int row0c = (mode == EM_C1A) ? (row0 & (M - 1)) : row0;
            const bf16_t* gate = second ? SHG : SNA; bf16_t* dst = second ? MIX : T;
#pragma unroll
            for (int ai = 0; ai < 2; ++ai) {
                u32x4 gv[4][2], tv[4][2];
#pragma unroll
                for (int m = 0; m < 4; ++m)
#pragma unroll
                    for (int bj = 0; bj < 2; ++bj) { const size_t off = (size_t)(row0c + ai * HALF + m * 16) * 1024 + colt + bj * HALF;
                        gv[m][bj] = *(const u32x4*)(gate + off); if (second) tv[m][bj] = *(const u32x4*)(T + off); else tv[m][bj] = (u32x4){0u, 0u, 0u, 0u}; }
#pragma unroll
                for (int m = 0; m < 4; ++m)
#pragma unroll
                    for (int bj = 0; bj < 2; ++bj) { const size_t off = (size_t)(row0c + ai * HALF + m * 16) * 1024 + colt + bj * HALF;
                        const u32x4 g = gv[m][bj], tt = tv[m][bj]; const f32x4 a0 = acc[ai][bj][m][0], a1 = acc[ai][bj][m][1];
                        const float r0 = a0[0] * bflo(g.x) + bflo(tt.x), r1 = a0[1] * bfhi(g.x) + bfhi(tt.x), r2 = a0[2] * bflo(g.y) + bflo(tt.y), r3 = a0[3] * bfhi(g.y) + bfhi(tt.y);
                        const float r4 = a1[0] * bflo(g.z) + bflo(tt.z), r5 = a1[1] * bfhi(g.z) + bfhi(tt.z), r6 = a1[2] * bflo(g.w) + bflo(tt.w), r7 = a1[3] * bfhi(g.w) + bfhi(tt.w);
                        u32x4 w; w.x = cvt_pk_bf16(r0, r1); w.y = cvt_pk_bf16(r2, r3); w.z = cvt_pk_bf16(r4, r5); w.w = cvt_pk_bf16(r6, r7);
                        *(u32x4*)(dst + off) = w; }
            }
        } else if (mode == EM_C4) {
            f32x4 (&hacc)[2][2][4][2] = const_cast<f32x4 (&)[2][2][4][2]>(acc);
#pragma unroll
            for (int ai = 0; ai < 2; ++ai)
#pragma unroll
                for (int mp = 0; mp < 2; ++mp) {
                    f32x4 pre[2][2][2];
#pragma unroll
                    for (int mm = 0; mm < 2; ++mm)
#pragma unroll
                        for (int bj = 0; bj < 2; ++bj) { const size_t off = (size_t)(row0 + ai * HALF + (2 * mp + mm) * 16) * 1024 + colt + bj * HALF;
                            const u32x4 hb = *(const u32x4*)(H1B + off);
                            pre[mm][bj][0] = (f32x4){bflo(hb.x), bfhi(hb.x), bflo(hb.y), bfhi(hb.y)}; pre[mm][bj][1] = (f32x4){bflo(hb.z), bfhi(hb.z), bflo(hb.w), bfhi(hb.w)}; }
#pragma unroll
                    for (int mm = 0; mm < 2; ++mm) { const int m = 2 * mp + mm; const int row = row0 + ai * HALF + m * 16; float s = 0.f;
#pragma unroll
                        for (int bj = 0; bj < 2; ++bj) { const f32x4 h0 = pre[mm][bj][0] + acc[ai][bj][m][0], h1 = pre[mm][bj][1] + acc[ai][bj][m][1];
                            hacc[ai][bj][m][0] = h0; hacc[ai][bj][m][1] = h1;
                            s += (h0[0] * h0[0] + h0[1] * h0[1]) + (h0[2] * h0[2] + h0[3] * h0[3]) + (h1[0] * h1[0] + h1[1] * h1[1]) + (h1[2] * h1[2] + h1[3] * h1[3]); }
                        s += __shfl_xor(s, 16); s += __shfl_xor(s, 32);
                        if (fq == 0) ssq2[(size_t)row * 16 + pn * 4 + wc] = s; }
                    asm volatile("" ::: "memory");
                }
            asm volatile("s_waitcnt vmcnt(0)" ::: "memory");
            __builtin_amdgcn_s_barrier();
            if (threadIdx.x == 0) {
                unsigned* cnt = (unsigned*)(ws + WS_C4CNT) + 16 * u.pm;
                __builtin_amdgcn_fence(__ATOMIC_RELEASE, "agent");
                asm volatile("s_waitcnt vmcnt(0)" ::: "memory");
                __hip_atomic_fetch_add(cnt, 1u, __ATOMIC_RELAXED, __HIP_MEMORY_SCOPE_AGENT);
                unsigned spins = 0;
                while (__hip_atomic_load(cnt, __ATOMIC_RELAXED, __HIP_MEMORY_SCOPE_AGENT) < 4u) { __builtin_amdgcn_s_sleep(2); if (++spins > (1u << 22)) break; }
                __builtin_amdgcn_fence(__ATOMIC_ACQUIRE, "agent");
                asm volatile("s_waitcnt vmcnt(0)" ::: "memory");
            }
            __builtin_amdgcn_s_barrier();
            asm volatile("" ::: "memory");
            const f32x4 gA0 = *(const f32x4*)(gfin + colt), gA1 = *(const f32x4*)(gfin + colt + 4), gB0 = *(const f32x4*)(gfin + colt + HALF), gB1 = *(const f32x4*)(gfin + colt + HALF + 4);
#pragma unroll
            for (int ai = 0; ai < 2; ++ai)
#pragma unroll
                for (int mp = 0; mp < 2; ++mp) {
                    f32x4 pp[2][4];
#pragma unroll
                    for (int mm = 0; mm < 2; ++mm)
#pragma unroll
                        for (int q = 0; q < 4; ++q) pp[mm][q] = *(const f32x4*)(ssq2 + (size_t)(row0 + ai * HALF + (2 * mp + mm) * 16) * 16 + 4 * q);
#pragma unroll
                    for (int mm = 0; mm < 2; ++mm) { const int m = 2 * mp + mm; const int row = row0 + ai * HALF + m * 16; const size_t off = (size_t)row * 1024 + colt;
                        const f32x4 p0 = pp[mm][0], p1 = pp[mm][1], p2 = pp[mm][2], p3 = pp[mm][3];
                        const float rs = rsqrtf(((((p0[0] + p0[1]) + (p0[2] + p0[3])) + ((p1[0] + p1[1]) + (p1[2] + p1[3]))) + (((p2[0] + p2[1]) + (p2[2] + p2[3])) + ((p3[0] + p3[1]) + (p3[2] + p3[3])))) * (1.0f / 1024.0f) + 1e-6f);
                        *(f32x4*)(out + off) = acc[ai][0][m][0] * rs * gA0; *(f32x4*)(out + off + 4) = acc[ai][0][m][1] * rs * gA1;
                        *(f32x4*)(out + off + HALF) = acc[ai][1][m][0] * rs * gB0; *(f32x4*)(out + off + HALF + 4) = acc[ai][1][m][1] * rs * gB1; }
                    asm volatile("" ::: "memory");
                }
        } else if (mode == EM_C2) {
            const float* base = (mode == EM_C2) ? x : (const float*)out; float* ssq = (mode == EM_C2) ? ssq1 : ssq2;
#pragma unroll
            for (int ai = 0; ai < 2; ++ai) {
                f32x4 pre[4][2][2];
#pragma unroll
                for (int m = 0; m < 4; ++m)
#pragma unroll
                    for (int bj = 0; bj < 2; ++bj) { const size_t off = (size_t)(row0 + ai * HALF + m * 16) * 1024 + colt + bj * HALF;
                        pre[m][bj][0] = *(const f32x4*)(base + off); pre[m][bj][1] = *(const f32x4*)(base + off + 4); }
#pragma unroll
                for (int m = 0; m < 4; ++m) { const int row = row0 + ai * HALF + m * 16; float s = 0.f;
#pragma unroll
                    for (int bj = 0; bj < 2; ++bj) { const size_t off = (size_t)row * 1024 + colt + bj * HALF;
                        const f32x4 h0 = pre[m][bj][0] + acc[ai][bj][m][0], h1 = pre[m][bj][1] + acc[ai][bj][m][1];
                        s += (h0[0] * h0[0] + h0[1] * h0[1]) + (h0[2] * h0[2] + h0[3] * h0[3]) + (h1[0] * h1[0] + h1[1] * h1[1]) + (h1[2] * h1[2] + h1[3] * h1[3]);
                        if (mode == EM_C2) { u32x4 w; w.x = cvt_pk_bf16(h0[0], h0[1]); w.y = cvt_pk_bf16(h0[2], h0[3]); w.z = cvt_pk_bf16(h1[0], h1[1]); w.w = cvt_pk_bf16(h1[2], h1[3]);
                            *(u32x4*)(H1B + off) = w; } }
                    s += __shfl_xor(s, 16); s += __shfl_xor(s, 32);
                    if (fq == 0) ssq[(size_t)row * 16 + pn * 4 + wc] = s; }
            }
        } else {
#pragma unroll
            for (int ai = 0; ai < 2; ++ai) {
                f32x4 pp[4][4];
#pragma unroll
                for (int m = 0; m < 4; ++m)
#pragma unroll
                    for (int q = 0; q < 4; ++q) pp[m][q] = *(const f32x4*)(ssq1 + (size_t)(row0 + ai * HALF + m * 16) * 16 + 4 * q);
#pragma unroll
                for (int m = 0; m < 4; ++m) { const int row = row0 + ai * HALF + m * 16;
                    const f32x4 p0 = pp[m][0], p1 = pp[m][1], p2 = pp[m][2], p3 = pp[m][3];
                    const float rs = rsqrtf(((((p0[0] + p0[1]) + (p0[2] + p0[3])) + ((p1[0] + p1[1]) + (p1[2] + p1[3]))) + (((p2[0] + p2[1]) + (p2[2] + p2[3])) + ((p3[0] + p3[1]) + (p3[2] + p3[3])))) * (1.0f / 1024.0f) + 1e-6f);
#pragma unroll
                    for (int bj = 0; bj < 2; ++bj) { f32x4 v0 = acc[ai][bj][m][0] * rs, v1 = acc[ai][bj][m][1] * rs;
#pragma unroll
                        for (int j = 0; j < 4; ++j) { const float a = fmaxf(v0[j], 0.f), b = fmaxf(v1[j], 0.f); v0[j] = a * a; v1[j] = b * b; }
                        u32x4 w; w.x = cvt_pk_bf16(v0[0], v0[1]); w.y = cvt_pk_bf16(v0[2], v0[3]); w.z = cvt_pk_bf16(v1[0], v1[1]); w.w = cvt_pk_bf16(v1[2], v1[3]);
                        *(u32x4*)(U + (size_t)row * 4096 + colt + bj * HALF) = w; } }
            }
        }
    }
};

template <class Epi, class Sched, bool ALIGN_EPI = false, bool SP2 = false>
__device__ __forceinline__ void gemm_phase(PG8_LAS unsigned char* lds, const Gemm g, const Sched& S, const Epi& E) {
    int tid_ = threadIdx.x; asm volatile("" : "+v"(tid_));
    const int tid = tid_, wid = __builtin_amdgcn_readfirstlane(tid >> 6), lane = tid & 63, wr = wid >> 2, wc = wid & 3, fr = lane & 15, fq = lane >> 4;
    const int K = g.K, nt = K / BK;
    unsigned voffA[2], voffB[2];
#pragma unroll
    for (int i = 0; i < 2; ++i) { int R, C; stage_rc(tid * 16 + i * 8192, R, C); const int Rb = Epi::PERM ? ((R & ~31) + perm32(R & 31)) : R;
        voffA[i] = (unsigned)(R * K + C) * 2u; voffB[i] = (unsigned)(Rb * K + C) * 2u; }
    const size_t kstep = (size_t)(BK * 2);
    const size_t hstep = (size_t)HALF * K * 2;
    const size_t tstep = 2 * hstep;
    const unsigned ldsw = (unsigned)wid * 1024u;
    const int aoff = lds_byte(wr * 64 + fr, fq * 8), boff = lds_byte(wc * 32 + fr, fq * 8);
#define PG8_SA(b, h) (((b) * 2 + (h)) * HTB)
#define PG8_SB(b, h) ((4 + (b) * 2 + (h)) * HTB)
#define PG8_STAGE(bufoff, gbase, voff) do { _Pragma("unroll") for (int _i = 0; _i < 2; ++_i) \
        __builtin_amdgcn_global_load_lds((const unsigned*)((const char*)(gbase) + (voff)[_i]), (PG8_LAS unsigned*)(lds + (bufoff) + ldsw + _i * 8192), 16, 0, 0); } while (0)
#define PG8_LDA(dst, b, h) do { _Pragma("unroll") for (int m = 0; m < 4; ++m) _Pragma("unroll") for (int k = 0; k < 2; ++k) dst[m][k] = *(const PG8_LAS bf16x8*)(lds + PG8_SA(b, h) + aoff + m * 2048 + k * 1024); } while (0)
#define PG8_LDB(dst, b, h) do { _Pragma("unroll") for (int n = 0; n < 2; ++n) _Pragma("unroll") for (int k = 0; k < 2; ++k) dst[n][k] = *(const PG8_LAS bf16x8*)(lds + PG8_SB(b, h) + boff + n * 2048 + k * 1024); } while (0)
#define PG8_MMA(ai, bj, At, Bt) do { __builtin_amdgcn_s_setprio(1); _Pragma("unroll") for (int m = 0; m < 4; ++m) _Pragma("unroll") for (int n = 0; n < 2; ++n) _Pragma("unroll") for (int k = 0; k < 2; ++k) \
        acc[ai][bj][m][n] = __builtin_amdgcn_mfma_f32_16x16x32_bf16(Bt[n][k], At[m][k], acc[ai][bj][m][n], 0, 0, 0); __builtin_amdgcn_s_setprio(0); } while (0)
#define PG8_WAIT_V(n) asm volatile("s_waitcnt vmcnt(" #n ")" ::: "memory")
#define PG8_WAIT_L(n) asm volatile("s_waitcnt lgkmcnt(" #n ")" ::: "memory")
#define PG8_BAR __builtin_amdgcn_s_barrier()
#define PG8_SCHED __builtin_amdgcn_sched_barrier(0)
    Unit cur, nxt; int ui = 0;
    if (!S.next(0, cur)) return;
    f32x4 acc[2][2][4][2];
#pragma unroll
    for (int a = 0; a < 2; ++a)
#pragma unroll
        for (int b = 0; b < 2; ++b)
#pragma unroll
            for (int m = 0; m < 4; ++m)
#pragma unroll
                for (int n = 0; n < 2; ++n) acc[a][b][m][n] = (f32x4){0.f, 0.f, 0.f, 0.f};
    bf16x8 At[4][2], B0[2][2], B1[2][2];
    const char* cA = (const char*)g.A + (size_t)cur.pm * tstep; const char* cB = (const char*)g.Bt + (size_t)cur.pn * tstep;
    S.a_ready(cur);
    if constexpr (SP2) {
        PG8_STAGE(PG8_SB(0, 0), cB, voffB); PG8_STAGE(PG8_SB(0, 1), cB + hstep, voffB); PG8_STAGE(PG8_SA(0, 0), cA, voffA); PG8_STAGE(PG8_SA(0, 1), cA + hstep, voffA);
        if (wr == 1) PG8_BAR;
        PG8_WAIT_V(2); PG8_BAR;
        PG8_STAGE(PG8_SB(1, 0), cB + kstep, voffB); PG8_STAGE(PG8_SA(1, 0), cA + kstep, voffA); PG8_STAGE(PG8_SB(1, 1), cB + hstep + kstep, voffB);
        PG8_WAIT_V(6); PG8_BAR;
    } else {
        PG8_STAGE(PG8_SB(0, 0), cB, voffB); PG8_STAGE(PG8_SA(0, 0), cA, voffA); PG8_STAGE(PG8_SB(0, 1), cB + hstep, voffB); PG8_STAGE(PG8_SA(0, 1), cA + hstep, voffA);
        if (wr == 1) PG8_BAR;
        PG8_WAIT_V(4); PG8_BAR;
        PG8_STAGE(PG8_SB(1, 0), cB + kstep, voffB); PG8_STAGE(PG8_SA(1, 0), cA + kstep, voffA); PG8_STAGE(PG8_SB(1, 1), cB + hstep + kstep, voffB);
        PG8_WAIT_V(6); PG8_BAR;
    }
    for (;;) {
        const bool has_next = S.next(ui + 1, nxt);
        const char* nA = has_next ? (const char*)g.A + (size_t)nxt.pm * tstep : cA; const char* nB = has_next ? (const char*)g.Bt + (size_t)nxt.pn * tstep : cB;
        for (int t = 0; t < nt; t += 2) {
            const bool last = (t == nt - 2);
            const char* a1 = cA + (size_t)(t + 1) * kstep;
            const char* a2 = last ? nA : cA + (size_t)(t + 2) * kstep; const char* b2 = last ? nB : cB + (size_t)(t + 2) * kstep;
            const char* a3 = a2 + kstep; const char* b3 = b2 + kstep;
            if (last && has_next) S.a_ready(nxt);
            if constexpr (SP2) {
            PG8_LDB(B0, 0, 0); PG8_LDB(B1, 0, 1); PG8_SCHED; PG8_LDA(At, 0, 0); PG8_STAGE(PG8_SA(1, 1), a1 + hstep, voffA);
            PG8_WAIT_V(8); PG8_WAIT_L(0); PG8_BAR; PG8_MMA(0, 0, At, B0); PG8_MMA(0, 1, At, B1); PG8_BAR; PG8_SCHED;
            PG8_LDA(At, 0, 1); PG8_STAGE(PG8_SB(0, 0), b2, voffB); PG8_STAGE(PG8_SB(0, 1), b2 + hstep, voffB); PG8_STAGE(PG8_SA(0, 0), a2, voffA);
            PG8_WAIT_V(8); PG8_WAIT_L(0); PG8_BAR; PG8_MMA(1, 0, At, B0); PG8_MMA(1, 1, At, B1); PG8_BAR; PG8_SCHED;
            PG8_LDB(B0, 1, 0); PG8_LDB(B1, 1, 1); PG8_SCHED; PG8_LDA(At, 1, 0); PG8_STAGE(PG8_SA(0, 1), a2 + hstep, voffA);
            PG8_WAIT_V(8); PG8_WAIT_L(0); PG8_BAR; PG8_MMA(0, 0, At, B0); PG8_MMA(0, 1, At, B1); PG8_BAR; PG8_SCHED;
            PG8_LDA(At, 1, 1); PG8_STAGE(PG8_SB(1, 0), b3, voffB); PG8_STAGE(PG8_SB(1, 1), b3 + hstep, voffB); PG8_STAGE(PG8_SA(1, 0), a3, voffA);
            PG8_WAIT_V(8); PG8_WAIT_L(0); PG8_BAR; PG8_MMA(1, 0, At, B0); PG8_MMA(1, 1, At, B1); PG8_BAR; PG8_SCHED;
            } else {
            PG8_LDB(B0, 0, 0); PG8_SCHED; PG8_LDA(At, 0, 0); PG8_STAGE(PG8_SA(1, 1), a1 + hstep, voffA);
            PG8_WAIT_L(8); PG8_BAR; PG8_WAIT_L(0); PG8_MMA(0, 0, At, B0); PG8_BAR; PG8_SCHED;
            PG8_LDB(B1, 0, 1); PG8_STAGE(PG8_SB(0, 0), b2, voffB);
            PG8_BAR; PG8_WAIT_L(0); PG8_MMA(0, 1, At, B1); PG8_BAR;
            PG8_LDA(At, 0, 1); PG8_STAGE(PG8_SA(0, 0), a2, voffA);
            PG8_BAR; PG8_WAIT_L(0); PG8_MMA(1, 0, At, B0); PG8_BAR; PG8_SCHED;
            PG8_STAGE(PG8_SB(0, 1), b2 + hstep, voffB);
            PG8_WAIT_V(6); PG8_BAR; PG8_MMA(1, 1, At, B1); PG8_BAR;
            PG8_LDB(B0, 1, 0); PG8_SCHED; PG8_LDA(At, 1, 0); PG8_STAGE(PG8_SA(0, 1), a2 + hstep, voffA);
            PG8_WAIT_L(8); PG8_BAR; PG8_WAIT_L(0); PG8_MMA(0, 0, At, B0); PG8_BAR; PG8_SCHED;
            PG8_LDB(B1, 1, 1); PG8_STAGE(PG8_SB(1, 0), b3, voffB);
            PG8_BAR; PG8_WAIT_L(0); PG8_MMA(0, 1, At, B1); PG8_BAR;
            PG8_LDA(At, 1, 1); PG8_STAGE(PG8_SA(1, 0), a3, voffA);
            PG8_BAR; PG8_WAIT_L(0); PG8_MMA(1, 0, At, B0); PG8_BAR; PG8_SCHED;
            PG8_STAGE(PG8_SB(1, 1), b3 + hstep, voffB);
            PG8_WAIT_V(6); PG8_BAR; PG8_MMA(1, 1, At, B1); PG8_BAR;
            }
        }
        if constexpr (ALIGN_EPI) { if (wr == 0) PG8_BAR; }
        if constexpr (!Epi::AFTER_DRAIN) { E(acc, cur, wr, wc, fr, fq); S.done(cur); }
        if (!has_next) break;
#pragma unroll
        for (int a = 0; a < 2; ++a)
#pragma unroll
            for (int b = 0; b < 2; ++b)
#pragma unroll
                for (int m = 0; m < 4; ++m)
#pragma unroll
                    for (int n = 0; n < 2; ++n) acc[a][b][m][n] = (f32x4){0.f, 0.f, 0.f, 0.f};
        cur = nxt; cA = nA; cB = nB; ++ui;
        if constexpr (ALIGN_EPI) { if (wr == 1) PG8_BAR; }
    }
    PG8_WAIT_V(0);
    if constexpr (!ALIGN_EPI) { if (wr == 0) PG8_BAR; }
    PG8_BAR;
    if constexpr (Epi::AFTER_DRAIN) { E.fused(acc, cur, wr, wc, fr, fq, lds, wid, lane); S.done(cur); }
#undef PG8_SA
#undef PG8_SB
#undef PG8_STAGE
#undef PG8_LDA
#undef PG8_LDB
#undef PG8_MMA
#undef PG8_WAIT_V
#undef PG8_WAIT_L
#undef PG8_BAR
#undef PG8_SCHED
}
}

#define GAS __attribute__((address_space(1)))
#define LAS __attribute__((address_space(3)))
typedef unsigned short bf16;
typedef unsigned v4u __attribute__((ext_vector_type(4)));
typedef unsigned v2u __attribute__((ext_vector_type(2)));
typedef float f32x4 __attribute__((ext_vector_type(4)));
typedef float f32x2 __attribute__((ext_vector_type(2)));
typedef short bf16x8 __attribute__((ext_vector_type(8)));
typedef short s16x4 __attribute__((ext_vector_type(4)));
using pg8::f2bf; using pg8::cvt_pk_bf16; using pg8::bflo; using pg8::bfhi;


__device__ __forceinline__ float wave_sum(float v) {
#pragma unroll
    for (int o = 1; o < 64; o <<= 1) v += __shfl_xor(v, o);
    return v;
}
__device__ __forceinline__ unsigned pk2(float lo, float hi) { return (unsigned)f2bf(lo) | ((unsigned)f2bf(hi) << 16); }

#define XB_TMO      128
#define XB_XCNT(j)  (256  + 64 * (j))
#define XB_XSUB(j)  (1280 + 64 * (j))
#define XB_XGEN(j)  (2304 + 64 * (j))
#define XB_TOP      3328
#define XB_TOPGEN   3392
#define XCD_BAR_WORDS 3456
#define XB_SPIN_CAP (1u << 18)

__device__ __forceinline__ unsigned xb_ld(unsigned* p)              { return __hip_atomic_load(p, __ATOMIC_RELAXED, __HIP_MEMORY_SCOPE_AGENT); }
__device__ __forceinline__ unsigned xb_add(unsigned* p, unsigned v) { return __hip_atomic_fetch_add(p, v, __ATOMIC_RELAXED, __HIP_MEMORY_SCOPE_AGENT); }
__device__ __forceinline__ unsigned xb_xcc_id() { return (unsigned)__builtin_amdgcn_s_getreg((3 << 11) | 20) & 0xFu; }
#define XB_SPIN(cond, bar) do { unsigned _sp = 0; while (cond) { __builtin_amdgcn_s_sleep(1); \
    if ((++_sp & 255u) == 0u) { if (xb_ld(&(bar)[XB_TMO])) break; if (_sp > XB_SPIN_CAP) { atomicAdd(&(bar)[XB_TMO], 1u); break; } } } } while (0)

struct XcdBarrier {
    unsigned* bar; unsigned x;
    volatile LAS unsigned* st;
};

__device__ __forceinline__ XcdBarrier xcd_barrier_post(unsigned* bar, volatile LAS unsigned* st) {
    XcdBarrier b; b.bar = bar; b.x = xb_xcc_id(); b.st = st;
    if (threadIdx.x == 0) (void)xb_add(&bar[XB_XCNT(b.x)], 1u);
    return b;
}
__device__ __forceinline__ void xcd_barrier_complete(unsigned* bar, unsigned x, unsigned& nloc, unsigned& nx) {
    const unsigned G = gridDim.x * gridDim.y * gridDim.z;
    unsigned sum, cnt, mine, sp = 0u;
    for (;;) {
        sum = 0u; cnt = 0u; mine = 0u;
#pragma unroll
        for (unsigned j = 0; j < 16; ++j) { const unsigned c = xb_ld(&bar[XB_XCNT(j)]); sum += c; cnt += (c > 0u) ? 1u : 0u; mine = (j == x) ? c : mine; }
        if (sum == G) break;
        __builtin_amdgcn_s_sleep(1);
        if ((++sp & 255u) == 0u) { if (xb_ld(&bar[XB_TMO])) break; if (sp > XB_SPIN_CAP) { atomicAdd(&bar[XB_TMO], 1u); break; } }
    }
    nloc = mine > 0u ? mine : 1u; nx = cnt > 0u ? cnt : 1u;
}

__device__ __forceinline__ void xcd_barrier(const XcdBarrier& b) {
    asm volatile("s_waitcnt vmcnt(0)" ::: "memory");
    __syncthreads();
    if (threadIdx.x == 0) {
        unsigned* bar = b.bar;
        __builtin_amdgcn_s_waitcnt(0);
        unsigned nloc = b.st[0], nx = b.st[1];
        if (nloc == 0u) { xcd_barrier_complete(bar, b.x, nloc, nx); b.st[0] = nloc; b.st[1] = nx; }
        const unsigned old = xb_add(&bar[XB_XSUB(b.x)], 1u);
        const unsigned gen = old / nloc;
        if (old + 1u == (gen + 1u) * nloc) {
            __builtin_amdgcn_fence(__ATOMIC_RELEASE, "agent");
            asm volatile("s_waitcnt vmcnt(0)" ::: "memory");
            const unsigned og = xb_add(&bar[XB_TOP], 1u);
            const unsigned tg = og / nx;
            if (og + 1u == (tg + 1u) * nx) xb_add(&bar[XB_TOPGEN], 1u);
            else XB_SPIN(xb_ld(&bar[XB_TOPGEN]) == tg, bar);
            __builtin_amdgcn_fence(__ATOMIC_ACQUIRE, "agent");
            xb_add(&bar[XB_XGEN(b.x)], 1u);
            asm volatile("s_waitcnt vmcnt(0)" ::: "memory");
        } else {
            XB_SPIN(xb_ld(&bar[XB_XGEN(b.x)]) == gen, bar);
            __builtin_amdgcn_fence(__ATOMIC_ACQUIRE, "agent");
            asm volatile("s_waitcnt vmcnt(0)" ::: "memory");
        }
    }
    __syncthreads();
}

#define XL_SUB(j) (5120 + 64 * (j))
#define XL_GEN(j) (5632 + 64 * (j))
__device__ __forceinline__ void xcd_local_barrier(const XcdBarrier& b) {
    asm volatile("s_waitcnt vmcnt(0)" ::: "memory");
    __syncthreads();
    if (threadIdx.x == 0) {
        unsigned* bar = b.bar; const unsigned nloc = b.st[0];
        const unsigned old = xb_add(&bar[XL_SUB(b.x)], 1u), gen = old / nloc;
        if (old + 1u == (gen + 1u) * nloc) xb_add(&bar[XL_GEN(b.x)], 1u);
        else XB_SPIN(xb_ld(&bar[XL_GEN(b.x)]) == gen, bar);
        __builtin_amdgcn_fence(__ATOMIC_ACQUIRE, "agent");
        asm volatile("s_waitcnt vmcnt(0)" ::: "memory");
    }
    __syncthreads();
}
constexpr size_t WS_BAR = 768 * KiB, BAR_BYTES = 24 * KiB;
struct Args { const float* in[14]; float* out; unsigned char* ws; };

template <class CM>
__device__ __forceinline__ void tr_item(const float* W, int K, int N, bf16* WT, const float* kscale, LAS float* scr, int item, int lane, CM cmap) {
    const int nblk = N / 32, kb = item / nblk, nb = item % nblk, k0 = 64 * kb, n0 = 32 * nb;
    const int src = cmap(n0 + (lane & 31));
    float tv[32];
#pragma unroll
    for (int i = 0; i < 32; ++i) tv[i] = W[(size_t)(k0 + 2 * i + (lane >> 5)) * N + src];
#pragma unroll
    for (int i = 0; i < 32; ++i) { const int kk = 2 * i + (lane >> 5); float v = tv[i]; if (kscale) v *= kscale[k0 + kk]; scr[kk * 33 + (lane & 31)] = v; }
    asm volatile("s_waitcnt lgkmcnt(0)" ::: "memory");
    const int c = lane & 7;
#pragma unroll
    for (int j = 0; j < 4; ++j) { const int n = (lane >> 3) + 8 * j; const LAS float* s = scr + (8 * c) * 33 + n;
        v4u o; o.x = pk2(s[0 * 33], s[1 * 33]); o.y = pk2(s[2 * 33], s[3 * 33]); o.z = pk2(s[4 * 33], s[5 * 33]); o.w = pk2(s[6 * 33], s[7 * 33]);
        *(v4u*)(WT + (size_t)(n0 + n) * K + k0 + 8 * c) = o; }
    asm volatile("s_waitcnt lgkmcnt(0)" ::: "memory");
}
struct CmId { __device__ __forceinline__ int operator()(int n) const { return n; } };
struct CmIn {
    __device__ __forceinline__ int operator()(int n) const {
        if (n < 1536 || n >= 3584) return n;
        const int q = n - 1536, j = q >> 8, cl = q & 255;
        const int sel = 2 * (cl >> 7) + ((cl >> 2) & 1), ch = 64 * j + 16 * ((cl >> 5) & 3) + 4 * ((cl >> 3) & 3) + (cl & 3);
        return 1536 + 512 * sel + ch;
    }
};

struct HgOps { s16x4 vb[2]; s16x4 ka[8]; f32x4 g[8]; };
__device__ __forceinline__ void hg_load(HgOps& o, const bf16* KT, const bf16* VTt, const float* G, unsigned cb, int vq, int lm, int kq) {
#pragma unroll
    for (int vt = 0; vt < 2; ++vt) o.vb[vt] = *(const s16x4*)(VTt + (unsigned)((cb + 32 * vq + 16 * vt + lm) * 16 + 4 * kq));
#pragma unroll
    for (int kt = 0; kt < 8; ++kt) { o.ka[kt] = *(const s16x4*)(KT + (unsigned)((cb + 16 * kt + lm) * 16 + 4 * kq)); o.g[kt] = *(const f32x4*)(G + (unsigned)(cb + 16 * kt + 4 * kq)); }
}
template <bool TRACKD>
__device__ __forceinline__ void hg_apply(f32x4 (&S)[8][2], f32x4 (&Dp)[8], const HgOps& o) {
#pragma unroll
    for (int kt = 0; kt < 8; ++kt) {
#pragma unroll
        for (int vt = 0; vt < 2; ++vt) { S[kt][vt] = __builtin_amdgcn_mfma_f32_16x16x16bf16_1k(o.ka[kt], o.vb[vt], S[kt][vt], 0, 0, 0); S[kt][vt] = S[kt][vt] * o.g[kt]; }
        if (TRACKD) Dp[kt] = Dp[kt] * o.g[kt];
    }
}
template <bool TRACKD>
__device__ __forceinline__ void hg_update(f32x4 (&S)[8][2], f32x4 (&Dp)[8], const bf16* KT, const bf16* VTt, const float* G, unsigned cb, int vq, int lm, int kq) {
    HgOps o; hg_load(o, KT, VTt, G, cb, vq, lm, kq); hg_apply<TRACKD>(S, Dp, o);
}

__global__ void __launch_bounds__(NWAVES * 64, 2) mk_fwd(Args args) {
    extern __shared__ __attribute__((aligned(16))) unsigned char lds_raw[];
    LAS unsigned char* lds = (LAS unsigned char*)lds_raw;
    const int tid = threadIdx.x, lane = tid & 63, wave = __builtin_amdgcn_readfirstlane(tid >> 6);
    const int G = gridDim.x, bx = blockIdx.x;
    const int gw = bx * NWAVES + wave, NGW = G * NWAVES;
    const int lm = lane & 15, kq = lane >> 4;
    unsigned char* ws = args.ws;
    if (tid < 16) ((LAS unsigned*)(lds + LDS_CTL))[tid] = 0u;
    __syncthreads();
    const XcdBarrier bar = xcd_barrier_post((unsigned*)(ws + WS_BAR), (volatile LAS unsigned*)(lds + LDS_CTL + 32));
    if (tid == 0) ((LAS unsigned*)(lds + LDS_CTL))[0] = xb_add((unsigned*)(ws + WS_BAR) + 3520 + 64 * bar.x, 1u);
    __syncthreads();
    const unsigned my_rank = ((volatile LAS unsigned*)(lds + LDS_CTL))[0];
    const float* x = args.in[0]; const float* meta = args.in[1]; const float* w_in = args.in[2]; const float* w_na = args.in[3]; const float* w_hg = args.in[4];
    const float* w_o = args.in[5]; const float* w_up = args.in[6]; const float* w_dn = args.in[7]; const float* g_mix = args.in[8]; const float* g_mlp = args.in[9];
    const float* g_fin = args.in[10]; const float* hg_gain = args.in[11]; const float* rpb = args.in[12]; const float* lb_logits = args.in[13];
    float* out = args.out;
    float* ssq1 = (float*)(ws + WS_SSQ1); float* ssq2 = (float*)(ws + WS_SSQ2);
    bf16* KNAm = (bf16*)(ws + WS_KNAM); bf16* VTm = (bf16*)(ws + WS_VTM); bf16* KFTm = (bf16*)(ws + WS_KFTM); bf16* VHTm = (bf16*)(ws + WS_VHTM);
    float* GFm = (float*)(ws + WS_GFM); float* LB = (float*)(ws + WS_LB); float* DSEG = (float*)(ws + WS_DSEG);
    bf16* WT_in = (bf16*)(ws + WS_WIN); bf16* WT_na = (bf16*)(ws + WS_WNA); bf16* WT_hg = (bf16*)(ws + WS_WHG); bf16* WT_o = (bf16*)(ws + WS_WO); bf16* WT_up = (bf16*)(ws + WS_WUP); bf16* WT_dn = (bf16*)(ws + WS_WDN);
    bf16* XN = (bf16*)(ws + WS_XN); float* SBUF = (float*)(ws + WS_XN); bf16* H1B = (bf16*)(ws + WS_XN);
    bf16* QNA = (bf16*)(ws + WS_QNA); bf16* KNA = (bf16*)(ws + WS_KNA); bf16* VT = (bf16*)(ws + WS_VT); bf16* QF = (bf16*)(ws + WS_QF); bf16* QB = (bf16*)(ws + WS_QB);
    bf16* KF = (bf16*)(ws + WS_KF); bf16* KFT = (bf16*)(ws + WS_KFT); bf16* KB = (bf16*)(ws + WS_KB); bf16* KBT = (bf16*)(ws + WS_KBT); bf16* VHT = (bf16*)(ws + WS_VHT);
    bf16* GHG = (bf16*)(ws + WS_GHG); float* GF = (float*)(ws + WS_GF); float* GB = (float*)(ws + WS_GB);
    bf16* SNA = (bf16*)out; bf16* SHG = (bf16*)out + (size_t)M * D;
    bf16* ONA = QNA; bf16* OHG = (bf16*)(ws + WS_OHG); bf16* Tb = (bf16*)(ws + WS_T); bf16* MIX = (bf16*)(ws + WS_MIX); bf16* U = (bf16*)(ws + WS_U);

    {
        f32x4 xv0[4][4];
#pragma unroll
        for (int q = 0; q < 4; ++q)
#pragma unroll
            for (int j = 0; j < 4; ++j) xv0[q][j] = *(const f32x4*)(x + (size_t)(gw + q * NGW) * D + 4 * lane + 256 * j);
        {
            LAS float* mT = (LAS float*)lds;
            LAS float* red = (LAS float*)(lds + 65536);
            LAS float* fin = (LAS float*)(lds + 65536 + 32768);
#pragma unroll
            for (int rr = 0; rr < 2; ++rr) { const int r = 2 * wave + rr; const float* mr = meta + (size_t)r * D;
                f32x4 v[4]; float s = 0.f;
#pragma unroll
                for (int j = 0; j < 4; ++j) { v[j] = *(const f32x4*)(mr + 4 * lane + 256 * j); s += (v[j].x * v[j].x + v[j].y * v[j].y) + (v[j].z * v[j].z + v[j].w * v[j].w); }
                const float rs = rsqrtf(wave_sum(s) * (1.0f / D) + EPS);
#pragma unroll
                for (int j = 0; j < 4; ++j) { const f32x4 g = *(const f32x4*)(g_mix + 4 * lane + 256 * j); const int k = 4 * lane + 256 * j;
                    mT[(k + 0) * 16 + r] = v[j].x * rs * g.x; mT[(k + 1) * 16 + r] = v[j].y * rs * g.y; mT[(k + 2) * 16 + r] = v[j].z * rs * g.z; mT[(k + 3) * 16 + r] = v[j].w * rs * g.w; } }
            __syncthreads();
            for (int cbk = bx; cbk < 256; cbk += G) {
                const int c = tid & 7, ks = tid >> 3, grp = cbk >> 6, cl0 = (cbk & 63) * 8;
                const int src = (grp == 0 ? 512 : grp == 1 ? 1024 : grp == 2 ? 2048 : 3072) + cl0 + c;
                float a[16];
#pragma unroll
                for (int r = 0; r < 16; ++r) a[r] = 0.f;
                float wv[16];
#pragma unroll
                for (int kk = 0; kk < 16; ++kk) wv[kk] = w_in[(size_t)(ks * 16 + kk) * NIN + src];
#pragma unroll
                for (int kk = 0; kk < 16; ++kk) { const int k = ks * 16 + kk; const float w = wv[kk];
                    const f32x4 m0 = *(const LAS f32x4*)(mT + k * 16), m1 = *(const LAS f32x4*)(mT + k * 16 + 4), m2 = *(const LAS f32x4*)(mT + k * 16 + 8), m3 = *(const LAS f32x4*)(mT + k * 16 + 12);
                    a[0] += w * m0.x; a[1] += w * m0.y; a[2] += w * m0.z; a[3] += w * m0.w; a[4] += w * m1.x; a[5] += w * m1.y; a[6] += w * m1.z; a[7] += w * m1.w;
                    a[8] += w * m2.x; a[9] += w * m2.y; a[10] += w * m2.z; a[11] += w * m2.w; a[12] += w * m3.x; a[13] += w * m3.y; a[14] += w * m3.z; a[15] += w * m3.w; }
#pragma unroll
                for (int r = 0; r < 16; ++r) red[(ks * 16 + r) * 8 + c] = a[r];
                __syncthreads();
                if (tid < 128) { float s = 0.f;
                    for (int q = 0; q < 64; ++q) s += red[q * 128 + tid];
                    fin[tid] = s; }
                __syncthreads();
                if (tid < 8) { const int cl = cl0 + tid;
#pragma unroll
                    for (int r = 0; r < 16; ++r) a[r] = fin[r * 8 + tid];
                    if (grp == 0) {
#pragma unroll
                        for (int r = 0; r < 16; ++r) KNAm[r * 512 + cl] = f2bf(a[r]);
                    } else if (grp == 1) { const int h = cl >> 6, d = cl & 63;
#pragma unroll
                        for (int r = 0; r < 16; ++r) VTm[(h * 64 + d) * 16 + r] = f2bf(a[r]);
                    } else if (grp == 2) {
                        const float l0 = lb_logits[cl], l1 = lb_logits[512 + cl]; const float lb = 1.0f / (1.0f + expf(l1 - l0));
                        float bsum = 0.f;
#pragma unroll
                        for (int r = 0; r < 16; ++r) { const float f = lb + (1.0f - lb) * __builtin_amdgcn_rcpf(1.0f + __expf(-a[r])); bsum += __builtin_amdgcn_logf(f) * 0.69314718056f; KFTm[cl * 16 + r] = f2bf((1.0f - f) * __expf(-bsum)); }
                        GFm[cl] = __expf(bsum);
                    } else {
#pragma unroll
                        for (int r = 0; r < 16; ++r) VHTm[cl * 16 + r] = f2bf(a[r]);
                    }
                }
                __syncthreads();
            }
        }
        for (int i = bx * 4 + tid; tid < 4 && i < 1024; i += G * 4) {
            const int dir = i >> 9, c = i & 511; const float l0 = lb_logits[dir * 1024 + c], l1 = lb_logits[dir * 1024 + 512 + c]; LB[i] = 1.0f / (1.0f + expf(l1 - l0)); }
        LAS float* scr = (LAS float*)(lds + wave * 16384);
        constexpr int I_IN = (D / 64) * (NIN / 32), I_NA = (512 / 64) * (D / 32), I_O = (D / 64) * (D / 32), I_UP = (D / 64) * (FF / 32), I_DN = (FF / 64) * (D / 32);
        constexpr int NITEMS = I_IN + 2 * I_NA + I_O + I_UP + I_DN;
        for (int it = gw; it < NITEMS; it += NGW) {
            int r = it;
            if (r < I_IN) { tr_item(w_in, D, NIN, WT_in, (const float*)nullptr, scr, r, lane, CmIn()); continue; } r -= I_IN;
            if (r < I_NA) { tr_item(w_na, 512, D, WT_na, (const float*)nullptr, scr, r, lane, CmId()); continue; } r -= I_NA;
            if (r < I_NA) { tr_item(w_hg, 512, D, WT_hg, (const float*)nullptr, scr, r, lane, CmId()); continue; } r -= I_NA;
            if (r < I_O) { tr_item(w_o, D, D, WT_o, (const float*)nullptr, scr, r, lane, CmId()); continue; } r -= I_O;
            if (r < I_UP) { tr_item(w_up, D, FF, WT_up, g_mlp, scr, r, lane, CmId()); continue; } r -= I_UP;
            tr_item(w_dn, FF, D, WT_dn, (const float*)nullptr, scr, r, lane, CmId());
        }
        for (int m0 = gw; m0 < M; m0 += 4 * NGW) {
            f32x4 v[4][4];
            if (m0 == gw) {
#pragma unroll
                for (int q = 0; q < 4; ++q)
#pragma unroll
                    for (int j = 0; j < 4; ++j) v[q][j] = xv0[q][j];
            } else {
#pragma unroll
                for (int q = 0; q < 4; ++q)
#pragma unroll
                    for (int j = 0; j < 4; ++j) v[q][j] = *(const f32x4*)(x + (size_t)(m0 + q * NGW) * D + 4 * lane + 256 * j);
            }
#pragma unroll
            for (int q = 0; q < 4; ++q) { const int m = m0 + q * NGW; float s = 0.f;
#pragma unroll
                for (int j = 0; j < 4; ++j) s += (v[q][j].x * v[q][j].x + v[q][j].y * v[q][j].y) + (v[q][j].z * v[q][j].z + v[q][j].w * v[q][j].w);
                const float rs = rsqrtf(wave_sum(s) * (1.0f / D) + EPS);
#pragma unroll
                for (int j = 0; j < 4; ++j) { const f32x4 g = *(const f32x4*)(g_mix + 4 * lane + 256 * j);
                    v2u o; o.x = pk2(v[q][j].x * rs * g.x, v[q][j].y * rs * g.y); o.y = pk2(v[q][j].z * rs * g.z, v[q][j].w * rs * g.w);
                    *(v2u*)(XN + (size_t)m * D + 4 * lane + 256 * j) = o; } } }
    }
    xcd_barrier(bar);

    int vb = bx; bool xl = false;
    { const unsigned nloc = ((volatile LAS unsigned*)(lds + LDS_CTL + 32))[0], nx = ((volatile LAS unsigned*)(lds + LDS_CTL + 32))[1];
      bool even = (G == 256 && nloc == 32u && nx == 8u && bar.x < 8u && my_rank < 32u);
#pragma unroll
      for (int j = 0; j < 8; ++j) even = even && (xb_ld((unsigned*)(ws + WS_BAR) + XB_XCNT(j)) == 32u);
      if (even) { vb = (int)(my_rank * 8u + bar.x); xl = true; } }
    vb = __builtin_amdgcn_readfirstlane(vb);
#define PHASE_BAR() do { if (xl) xcd_local_barrier(bar); else xcd_barrier(bar); } while (0)
    const int xq = vb & 7, rk = vb >> 3, lw = rk * 8 + wave;
#define MK_EPI(NAME, MODE) pg8::EpiAll<MODE> NAME; NAME.ws = ws; NAME.out = out; NAME.x = x; NAME.gain = hg_gain; NAME.gfin = g_fin;
    {
        MK_EPI(E, pg8::EM_IN)
        pg8::Gemm g{XN, WT_in, M, NIN, D}; pg8::StaticOrder S; S.init(M, NIN, G, vb);
        pg8::gemm_phase<pg8::EpiAll<pg8::EM_IN>, pg8::StaticOrder, true, true>(lds, g, S, E);
    }
    PHASE_BAR();

    { const int wi = xq * 256 + lw;
        const int item = wi >> 2, vq = wi & 3, seg = item & 7, dir = (item >> 3) & 1, h = (item >> 4) & 3, b = item >> 6;
        f32x4 S[8][2], Dp[8];
#pragma unroll
        for (int kt = 0; kt < 8; ++kt) { S[kt][0] = (f32x4){0.f, 0.f, 0.f, 0.f}; S[kt][1] = (f32x4){0.f, 0.f, 0.f, 0.f}; Dp[kt] = (f32x4){1.f, 1.f, 1.f, 1.f}; }
        if (dir == 0 && seg == 0) hg_update<false>(S, Dp, KFTm, VHTm, GFm, (unsigned)(h * 128), vq, lm, kq);
        const bf16* KTp = dir ? KBT : KFT; const float* Gp = dir ? GB : GF;
        const int cstep = dir ? -512 : 512; const int cb0 = (b * 128 + seg * 16 + (dir ? 15 : 0)) * 512 + h * 128;
        {
            LAS unsigned char* stg0 = lds + (wave >> 2) * 9216;
            s16x4 kv[2][2], vbn[2][2], vbr[2][2]; v2u g8 = (v2u){0u, 0u};
#define B1_LOADS(IT) do { _Pragma("unroll") for (int u = 0; u < 2; ++u) { const unsigned cb_ = (unsigned)(cb0 + (2 * (IT) + u) * cstep); \
                _Pragma("unroll") for (int kk = 0; kk < 2; ++kk) kv[u][kk] = *(const s16x4*)(KTp + (unsigned)((cb_ + 16 * (2 * vq + kk) + lm) * 16 + 4 * kq)); \
                _Pragma("unroll") for (int vt = 0; vt < 2; ++vt) vbn[u][vt] = *(const s16x4*)(VHT + (unsigned)((cb_ + 32 * vq + 16 * vt + lm) * 16 + 4 * kq)); \
                if (vq == u) g8 = *(const v2u*)(Gp + cb_ + 2 * lane); } } while (0)
#define B1_STORE(STG) do { _Pragma("unroll") for (int u = 0; u < 2; ++u) { \
                _Pragma("unroll") for (int kk = 0; kk < 2; ++kk) *(LAS s16x4*)((STG) + (u * 8 + 2 * vq + kk) * 512 + lane * 8) = kv[u][kk]; \
                if (vq == u) *(LAS v2u*)((STG) + 8192 + u * 512 + lane * 8) = g8; } } while (0)
            __syncthreads();
            B1_LOADS(0);
            B1_STORE(stg0);
#pragma unroll
            for (int u = 0; u < 2; ++u) { vbr[u][0] = vbn[u][0]; vbr[u][1] = vbn[u][1]; }
            for (int it = 0; it < 8; ++it) {
                __syncthreads();
                LAS unsigned char* stg = stg0 + (it & 1) * 18432;
                if (it < 7) B1_LOADS(it + 1);
                __builtin_amdgcn_sched_barrier(0);
#pragma unroll
                for (int u = 0; u < 2; ++u)
#pragma unroll
                    for (int kt = 0; kt < 8; ++kt) { const s16x4 ka = *(const LAS s16x4*)(stg + (u * 8 + kt) * 512 + lane * 8); const f32x4 g = *(const LAS f32x4*)(stg + 8192 + u * 512 + (16 * kt + 4 * kq) * 4);
#pragma unroll
                        for (int vt = 0; vt < 2; ++vt) { S[kt][vt] = __builtin_amdgcn_mfma_f32_16x16x16bf16_1k(ka, vbr[u][vt], S[kt][vt], 0, 0, 0); S[kt][vt] = S[kt][vt] * g; }
                        Dp[kt] = Dp[kt] * g; }
                __builtin_amdgcn_sched_barrier(0);
                if (it < 7) { B1_STORE(stg0 + ((it + 1) & 1) * 18432);
#pragma unroll
                    for (int u = 0; u < 2; ++u) { vbr[u][0] = vbn[u][0]; vbr[u][1] = vbn[u][1]; } }
            }
#undef B1_LOADS
#undef B1_STORE
        }
        float* sp = SBUF + ((size_t)(item * 4 + vq) * 16) * 256 + lane * 4;
#pragma unroll
        for (int kt = 0; kt < 8; ++kt) { *(f32x4*)(sp + (kt * 2 + 0) * 256) = S[kt][0]; *(f32x4*)(sp + (kt * 2 + 1) * 256) = S[kt][1]; }
        if (vq == 0 && lm == 0) {
#pragma unroll
            for (int kt = 0; kt < 8; ++kt) *(f32x4*)(DSEG + item * 128 + 16 * kt + 4 * kq) = Dp[kt];
        }
    }
    PHASE_BAR();

    for (int i2 = 0; i2 < 2; ++i2) { const int tl = rk * 512 + tid + 16384 * i2;
        const int bhd = xq * 8 + (tl >> 12), e4 = tl & 4095, dir = bhd & 1; const int kt = (e4 >> 7) & 7, ln = e4 & 63; const int k0 = 16 * kt + 4 * (ln >> 4);
        f32x4 carry = (f32x4){0.f, 0.f, 0.f, 0.f}, locv[8], dv[8];
#pragma unroll
        for (int s = 0; s < 8; ++s) { const int seg = dir ? 7 - s : s, item = bhd * 8 + seg;
            locv[s] = *(const f32x4*)(SBUF + (size_t)item * 16384 + e4 * 4); dv[s] = *(const f32x4*)(DSEG + item * 128 + k0); }
#pragma unroll
        for (int s = 0; s < 8; ++s) { const int seg = dir ? 7 - s : s, item = bhd * 8 + seg;
            *(f32x4*)(SBUF + (size_t)item * 16384 + e4 * 4) = carry; carry = dv[s] * carry + locv[s]; }
    }
    {
        LAS float* rp = (LAS float*)lds;
        __syncthreads();
        if (tid < 465) rp[tid] = rpb[(rk >> 2) * 465 + tid];
        __syncthreads();
        LAS unsigned char* KS = lds + 15360; LAS unsigned char* VS = lds + 15360 + 73728;
        int prev_hi = -1;
        for (int i4 = 0; i4 < 4; ++i4) {
            const int hh = rk >> 2, rg = rk & 3, rpair = 8 * rg + 2 * i4;
            const int cq = wave & 3, r = rpair + (wave >> 2), h = hh, b = xq;
            const int lo = min(max(rpair - 4, 0), 24);
            __syncthreads();
            { const int c = tid >> 3, q = tid & 7;
              if (i4 == 0) {
                v4u kreg[9], vreg[9];
#pragma unroll
                for (int e9 = 0; e9 < 9; ++e9) { const int row = min(lo + e9, 31);
                    kreg[e9] = *(const v4u*)(KNA + ((size_t)b * SEQ + row * 64 + c) * 512 + h * 64 + q * 8);
                    vreg[e9] = *(const v4u*)(VT + ((((size_t)(b * 8 + h) * 32 + row) * 64 + c) * 64 + q * 8)); }
#pragma unroll
                for (int e9 = 0; e9 < 9; ++e9) { const int kk = ((lo + e9) % 9) * 64 + c;
                    *(LAS v4u*)(KS + kk * 128 + ((q ^ (kk & 7)) * 16)) = kreg[e9]; *(LAS v4u*)(VS + kk * 128 + ((q ^ (kk & 7)) * 16)) = vreg[e9]; }
              } else {
                v4u kreg[2], vreg[2];
#pragma unroll
                for (int e2 = 0; e2 < 2; ++e2) { const int row = min(prev_hi + 1 + e2, 31);
                    kreg[e2] = *(const v4u*)(KNA + ((size_t)b * SEQ + row * 64 + c) * 512 + h * 64 + q * 8);
                    vreg[e2] = *(const v4u*)(VT + ((((size_t)(b * 8 + h) * 32 + row) * 64 + c) * 64 + q * 8)); }
#pragma unroll
                for (int e2 = 0; e2 < 2; ++e2) { const int row = prev_hi + 1 + e2;
                    if (row <= lo + 8 && row < 32) { const int kk = (row % 9) * 64 + c;
                        *(LAS v4u*)(KS + kk * 128 + ((q ^ (kk & 7)) * 16)) = kreg[e2]; *(LAS v4u*)(VS + kk * 128 + ((q ^ (kk & 7)) * 16)) = vreg[e2]; } }
              }
            }
            prev_hi = lo + 8;
            __syncthreads();
            const int c0 = 16 * cq, kc0 = (cq == 0) ? 0 : (cq == 1) ? 8 : (cq == 2) ? 24 : 32;
            const int rs0 = min(max(r - 4, 0), 24);
            const size_t rowq = (size_t)b * SEQ + r * 64 + c0 + lm;
            bf16x8 qf[2], kmf[2]; s16x4 vmf[4];
#pragma unroll
            for (int ks = 0; ks < 2; ++ks) { qf[ks] = *(const bf16x8*)(QNA + rowq * 512 + h * 64 + 32 * ks + 8 * kq); kmf[ks] = *(const bf16x8*)(KNAm + lm * 512 + h * 64 + 32 * ks + 8 * kq); }
#pragma unroll
            for (int dt = 0; dt < 4; ++dt) vmf[dt] = *(const s16x4*)(VTm + (h * 64 + 16 * dt + lm) * 16 + 4 * kq);
            const int cqq = c0 + lm, cs = min(max(cqq - 8, 0), 48);
            f32x4 oa[4];
#pragma unroll
            for (int dt = 0; dt < 4; ++dt) oa[dt] = (f32x4){0.f, 0.f, 0.f, 0.f};
            float mrun = -3.0e38f, lsum = 0.f;
#pragma unroll
            for (int hf = 0; hf < 2; ++hf) {
                f32x4 sc[9]; bf16x8 vf[4][4];
                {   bf16x8 kf[4][2][2];
#pragma unroll
                    for (int j4 = 0; j4 < 4; ++j4)
#pragma unroll
                        for (int t = 0; t < 2; ++t) { const int kcol = kc0 + 8 * (lm >> 2) + 4 * t + (lm & 3); const size_t rowk = (size_t)b * SEQ + (rs0 + 4 * hf + j4) * 64 + kcol;
#pragma unroll
                            for (int ks = 0; ks < 2; ++ks) { const int kk = ((rs0 + 4 * hf + j4) % 9) * 64 + kcol; kf[j4][t][ks] = *(const LAS bf16x8*)(KS + kk * 128 + (((ks * 4 + kq) ^ (kk & 7)) * 16)); } (void)rowk; }
                    __builtin_amdgcn_sched_barrier(0);
#pragma unroll
                    for (int j4 = 0; j4 < 4; ++j4)
#pragma unroll
                        for (int t = 0; t < 2; ++t) { f32x4 a = (f32x4){0.f, 0.f, 0.f, 0.f};
#pragma unroll
                            for (int ks = 0; ks < 2; ++ks) a = __builtin_amdgcn_mfma_f32_16x16x32_bf16(kf[j4][t][ks], qf[ks], a, 0, 0, 0);
                            sc[2 * j4 + t] = a; }
                }
                __builtin_amdgcn_sched_barrier(0);
#pragma unroll
                for (int j4 = 0; j4 < 4; ++j4)
#pragma unroll
                    for (int dt = 0; dt < 4; ++dt) { const int vv = ((rs0 + 4 * hf + j4) % 9) * 64 + 16 * dt + lm; vf[j4][dt] = *(const LAS bf16x8*)(VS + vv * 128 + ((((kc0 >> 3) + kq) ^ (vv & 7)) * 16)); }
                __builtin_amdgcn_sched_barrier(0);
                if (hf == 1) { f32x4 a = (f32x4){0.f, 0.f, 0.f, 0.f};
#pragma unroll
                    for (int ks = 0; ks < 2; ++ks) a = __builtin_amdgcn_mfma_f32_16x16x32_bf16(kmf[ks], qf[ks], a, 0, 0, 0);
                    sc[8] = a; } else sc[8] = (f32x4){-1e30f, -1e30f, -1e30f, -1e30f};
                float mx = -3.0e38f;
#pragma unroll
                for (int j4 = 0; j4 < 4; ++j4)
#pragma unroll
                    for (int t = 0; t < 2; ++t)
#pragma unroll
                        for (int j = 0; j < 4; ++j) { const int kcol = kc0 + 8 * kq + 4 * t + j; const bool inw = (kcol >= cs) && (kcol < cs + 16);
                            const int dr = rs0 + 4 * hf + j4 - r, dc = min(max(kcol - cqq, -15), 15);
                            const float bias = rp[(dr + 7) * 31 + dc + 15];
                            const float s = inw ? sc[2 * j4 + t][j] + bias : -1e30f; sc[2 * j4 + t][j] = s; mx = fmaxf(mx, s); }
#pragma unroll
                for (int j = 0; j < 4; ++j) mx = fmaxf(mx, sc[8][j]);
                mx = fmaxf(mx, __shfl_xor(mx, 16)); mx = fmaxf(mx, __shfl_xor(mx, 32));
                const float mnew = fmaxf(mrun, mx), alpha = __expf(mrun - mnew);
                mrun = mnew; lsum *= alpha;
#pragma unroll
                for (int dt = 0; dt < 4; ++dt) oa[dt] = oa[dt] * alpha;
#pragma unroll
                for (int i = 0; i < 9; ++i)
#pragma unroll
                    for (int j = 0; j < 4; ++j) { const float p = __expf(sc[i][j] - mnew); sc[i][j] = p; lsum += p; }
#pragma unroll
                for (int j4 = 0; j4 < 4; ++j4) {
                    union { bf16x8 v; unsigned u[4]; } pf;
                    pf.u[0] = cvt_pk_bf16(sc[2 * j4][0], sc[2 * j4][1]); pf.u[1] = cvt_pk_bf16(sc[2 * j4][2], sc[2 * j4][3]);
                    pf.u[2] = cvt_pk_bf16(sc[2 * j4 + 1][0], sc[2 * j4 + 1][1]); pf.u[3] = cvt_pk_bf16(sc[2 * j4 + 1][2], sc[2 * j4 + 1][3]);
#pragma unroll
                    for (int dt = 0; dt < 4; ++dt) oa[dt] = __builtin_amdgcn_mfma_f32_16x16x32_bf16(vf[j4][dt], pf.v, oa[dt], 0, 0, 0); }
                if (hf == 1) { union { s16x4 v; unsigned u[2]; } pm; pm.u[0] = cvt_pk_bf16(sc[8][0], sc[8][1]); pm.u[1] = cvt_pk_bf16(sc[8][2], sc[8][3]);
#pragma unroll
                    for (int dt = 0; dt < 4; ++dt) oa[dt] = __builtin_amdgcn_mfma_f32_16x16x16bf16_1k(vmf[dt], pm.v, oa[dt], 0, 0, 0); }
            }
            lsum += __shfl_xor(lsum, 16); lsum += __shfl_xor(lsum, 32);
            const float inv = 1.0f / lsum;
#pragma unroll
            for (int dt = 0; dt < 4; ++dt) { v2u o; o.x = cvt_pk_bf16(oa[dt][0] * inv, oa[dt][1] * inv); o.y = cvt_pk_bf16(oa[dt][2] * inv, oa[dt][3] * inv);
                *(v2u*)(ONA + rowq * 512 + h * 64 + 16 * dt + 4 * kq) = o; }
        }
        __syncthreads();
    }
    PHASE_BAR();

    { const int it = xq * 32 + rk;
        const int seg = it & 7, h = (it >> 3) & 3, b = it >> 5;
        const int dir = wave >> 2, vq = wave & 3, sitem = ((b * 4 + h) * 2 + dir) * 8 + seg;
        LAS unsigned short* ob = (LAS unsigned short*)lds;
        LAS unsigned char* stg0 = lds + 65536 + dir * 17408;
        __syncthreads();
        f32x4 S[8][2], Dp[8];
        { const float* sp = SBUF + ((size_t)(sitem * 4 + vq) * 16) * 256 + lane * 4;
#pragma unroll
          for (int kt = 0; kt < 8; ++kt) { S[kt][0] = *(const f32x4*)(sp + (kt * 2 + 0) * 256); S[kt][1] = *(const f32x4*)(sp + (kt * 2 + 1) * 256); Dp[kt] = (f32x4){1.f, 1.f, 1.f, 1.f}; } }
        if (dir == 0 && seg == 0) hg_update<false>(S, Dp, KFTm, VHTm, GFm, (unsigned)(h * 128), vq, lm, kq);
        const bf16* Qn = dir ? QB : QF; const bf16* Kn = dir ? KB : KF; const bf16* KTp = dir ? KBT : KFT; const float* Gp = dir ? GB : GF;
        s16x4 qv[2][2], kv[2][2], vbn[2][2]; v2u g8 = (v2u){0u, 0u};
#define B3_LOADS(IT) do { _Pragma("unroll") for (int u = 0; u < 2; ++u) { const int cl_ = dir ? 15 - (2 * (IT) + u) : 2 * (IT) + u; const size_t cgi_ = (size_t)b * 128 + seg * 16 + cl_, row0_ = cgi_ * 16; const unsigned cb_ = (unsigned)(cgi_ * 512 + h * 128); \
            _Pragma("unroll") for (int kk = 0; kk < 2; ++kk) { const int kt_ = 2 * vq + kk; \
                qv[u][kk] = *(const s16x4*)(Qn + (row0_ + lm) * 512 + h * 128 + 16 * kt_ + 4 * kq); \
                kv[u][kk] = *(const s16x4*)(KTp + (unsigned)((cb_ + 16 * kt_ + lm) * 16 + 4 * kq)); } \
            _Pragma("unroll") for (int vt = 0; vt < 2; ++vt) vbn[u][vt] = *(const s16x4*)(VHT + (unsigned)((cb_ + 32 * vq + 16 * vt + lm) * 16 + 4 * kq)); \
            if (vq == u) g8 = *(const v2u*)(Gp + cb_ + 2 * lane); } } while (0)
#define B3_STORE(STG) do { _Pragma("unroll") for (int u = 0; u < 2; ++u) { \
            _Pragma("unroll") for (int kk = 0; kk < 2; ++kk) { const int f_ = u * 8 + 2 * vq + kk; \
                *(LAS s16x4*)((STG) + f_ * 512 + lane * 8) = qv[u][kk]; *(LAS s16x4*)((STG) + 8192 + f_ * 512 + lane * 8) = kv[u][kk]; } \
            if (vq == u) *(LAS v2u*)((STG) + 16384 + u * 512 + lane * 8) = g8; } } while (0)
        B3_LOADS(0);
        {
            LAS v2u* PA = (LAS v2u*)(lds + 135168);
            bf16x8 kn4[4][4], qn4[4][4];
#pragma unroll
            for (int q = 0; q < 4; ++q) { const size_t r0 = ((size_t)b * 128 + seg * 16 + vq + 4 * q) * 16;
#pragma unroll
                for (int ii = 0; ii < 4; ++ii) { const size_t o = (r0 + lm) * 512 + h * 128 + 32 * ii + 8 * kq; kn4[q][ii] = *(const bf16x8*)(Kn + o); qn4[q][ii] = *(const bf16x8*)(Qn + o); } }
#pragma unroll
            for (int q = 0; q < 4; ++q) { f32x4 at = (f32x4){0.f, 0.f, 0.f, 0.f};
#pragma unroll
                for (int ii = 0; ii < 4; ++ii) at = __builtin_amdgcn_mfma_f32_16x16x32_bf16(kn4[q][ii], qn4[q][ii], at, 0, 0, 0);
#pragma unroll
                for (int j = 0; j < 4; ++j) { const int s = 4 * kq + j; const bool keep = dir ? (s >= lm) : (s <= lm); at[j] = keep ? at[j] : 0.f; }
                v2u w; w.x = cvt_pk_bf16(at[0], at[1]); w.y = cvt_pk_bf16(at[2], at[3]);
                PA[(dir * 16 + vq + 4 * q) * 64 + lane] = w; }
        }
        __syncthreads();
        B3_STORE(stg0);
        s16x4 vbr[2][2];
#pragma unroll
        for (int u = 0; u < 2; ++u) { vbr[u][0] = vbn[u][0]; vbr[u][1] = vbn[u][1]; }
        for (int it = 0; it < 8; ++it) {
            __syncthreads();
            LAS unsigned char* stg = stg0 + (it & 1) * 34816;
            if (it < 7) B3_LOADS(it + 1);
            __builtin_amdgcn_sched_barrier(0);
#pragma unroll
            for (int u = 0; u < 2; ++u) { const int cl = dir ? 15 - (2 * it + u) : 2 * it + u;
                union { s16x4 v; v2u u2; } pa; pa.u2 = ((const LAS v2u*)(lds + 135168))[(dir * 16 + cl) * 64 + lane];
                f32x4 o2[2]; o2[0] = (f32x4){0.f, 0.f, 0.f, 0.f}; o2[1] = (f32x4){0.f, 0.f, 0.f, 0.f};
#pragma unroll
                for (int kt = 0; kt < 8; ++kt) { const s16x4 q4 = *(const LAS s16x4*)(stg + (u * 8 + kt) * 512 + lane * 8);
#pragma unroll
                    for (int vt = 0; vt < 2; ++vt) { union { s16x4 v; unsigned u[2]; } sb; sb.u[0] = cvt_pk_bf16(S[kt][vt][0], S[kt][vt][1]); sb.u[1] = cvt_pk_bf16(S[kt][vt][2], S[kt][vt][3]);
                        o2[vt] = __builtin_amdgcn_mfma_f32_16x16x16bf16_1k(q4, sb.v, o2[vt], 0, 0, 0); } }
#pragma unroll
                for (int vt = 0; vt < 2; ++vt) { o2[vt] = __builtin_amdgcn_mfma_f32_16x16x16bf16_1k(pa.v, vbr[u][vt], o2[vt], 0, 0, 0);
#pragma unroll
                    for (int j = 0; j < 4; ++j) { LAS unsigned short* op = ob + (16 * cl + 4 * kq + j) * 128 + 32 * vq + 16 * vt + lm;
                        const float val = (it < 4) ? o2[vt][j] : (bflo((unsigned)*op) + o2[vt][j]); *op = f2bf(val); } }
#pragma unroll
                for (int kt = 0; kt < 8; ++kt) { const s16x4 ka = *(const LAS s16x4*)(stg + 8192 + (u * 8 + kt) * 512 + lane * 8); const f32x4 g = *(const LAS f32x4*)(stg + 16384 + u * 512 + (16 * kt + 4 * kq) * 4);
#pragma unroll
                    for (int vt = 0; vt < 2; ++vt) { S[kt][vt] = __builtin_amdgcn_mfma_f32_16x16x16bf16_1k(ka, vbr[u][vt], S[kt][vt], 0, 0, 0); S[kt][vt] = S[kt][vt] * g; } }
            }
            __builtin_amdgcn_sched_barrier(0);
            if (it < 7) { B3_STORE(stg0 + ((it + 1) & 1) * 34816);
#pragma unroll
                for (int u = 0; u < 2; ++u) { vbr[u][0] = vbn[u][0]; vbr[u][1] = vbn[u][1]; } }
        }
#undef B3_LOADS
#undef B3_STORE
        v4u ggp[8];
#pragma unroll
        for (int i = 0; i < 8; ++i) ggp[i] = *(const v4u*)(GHG + ((size_t)b * SEQ + seg * 256 + wave * 32 + 4 * i + kq) * 512 + h * 128 + 8 * lm);
        __syncthreads();
#pragma unroll
        for (int i = 0; i < 8; ++i) { const int tl = wave * 32 + 4 * i + kq; const size_t row = (size_t)b * SEQ + seg * 256 + tl;
            const v4u ov = *(const LAS v4u*)(ob + tl * 128 + 8 * lm);
            const f32x4 v0 = (f32x4){bflo(ov.x), bfhi(ov.x), bflo(ov.y), bfhi(ov.y)}, v1 = (f32x4){bflo(ov.z), bfhi(ov.z), bflo(ov.w), bfhi(ov.w)};
            const v4u gg = ggp[i];
            float s = (v0.x * v0.x + v0.y * v0.y) + (v0.z * v0.z + v0.w * v0.w) + (v1.x * v1.x + v1.y * v1.y) + (v1.z * v1.z + v1.w * v1.w);
            s += __shfl_xor(s, 1); s += __shfl_xor(s, 2); s += __shfl_xor(s, 4); s += __shfl_xor(s, 8);
            const float rs = rsqrtf(s * (1.0f / 128.0f) + EPS);
            v4u o; o.x = cvt_pk_bf16(v0.x * rs * bflo(gg.x), v0.y * rs * bfhi(gg.x)); o.y = cvt_pk_bf16(v0.z * rs * bflo(gg.y), v0.w * rs * bfhi(gg.y));
            o.z = cvt_pk_bf16(v1.x * rs * bflo(gg.z), v1.y * rs * bfhi(gg.z)); o.w = cvt_pk_bf16(v1.z * rs * bflo(gg.w), v1.w * rs * bfhi(gg.w));
            *(v4u*)(OHG + row * 512 + h * 128 + 8 * lm) = o; }
        __syncthreads();
    }
    PHASE_BAR();

    {
        MK_EPI(E, pg8::EM_C1A)
        pg8::Gemm g{ONA, WT_na, 2 * M, 2 * D, 512}; pg8::PairOrder S; S.init(M, D, G, vb);
        pg8::gemm_phase<pg8::EpiAll<pg8::EM_C1A>, pg8::PairOrder, true, true>(lds, g, S, E);
    }
    PHASE_BAR();
    {
        MK_EPI(E, pg8::EM_C2)
        pg8::Gemm g{MIX, WT_o, M, D, D}; pg8::StaticOrder S; S.init(M, D, G, vb);
        pg8::gemm_phase<pg8::EpiAll<pg8::EM_C2>, pg8::StaticOrder, true, true>(lds, g, S, E);
    }
    PHASE_BAR();
    {
        MK_EPI(E, pg8::EM_C3)
        pg8::Gemm g{H1B, WT_up, M, FF, D}; pg8::StaticOrder S; S.init(M, FF, G, vb);
        pg8::gemm_phase<pg8::EpiAll<pg8::EM_C3>, pg8::StaticOrder, true, true>(lds, g, S, E);
    }
    PHASE_BAR();
    {
        MK_EPI(E, pg8::EM_C4)
        pg8::Gemm g{U, WT_dn, M, D, FF}; pg8::StaticOrder S; S.init(M, D, G, vb);
        pg8::gemm_phase<pg8::EpiAll<pg8::EM_C4>, pg8::StaticOrder, true, true>(lds, g, S, E);
    }

}

extern "C" void kernel_launch(void* const* d_in, const int* in_sizes, int n_in, void* d_out, int out_size, void* d_ws, size_t ws_size, hipStream_t stream) {
    static int grid = 0;
    if (grid == 0) {
        if (n_in != 14 || in_sizes[0] != M * D || out_size != M * D || ws_size < WS_END) { fprintf(stderr, "kernel_launch: unexpected shapes / workspace (n_in %d, in0 %d, out %d, ws %zu)\n", n_in, n_in > 0 ? in_sizes[0] : -1, out_size, ws_size); grid = -1; return; }
        int dev = 0, cus = 0, per_cu = 0;
        if (hipGetDevice(&dev) != hipSuccess || hipDeviceGetAttribute(&cus, hipDeviceAttributeMultiprocessorCount, dev) != hipSuccess) { grid = -1; return; }
        if (hipFuncSetAttribute((const void*)mk_fwd, hipFuncAttributeMaxDynamicSharedMemorySize, LDS_BYTES) != hipSuccess) { fprintf(stderr, "kernel_launch: hipFuncSetAttribute failed\n"); grid = -1; return; }
        if (hipOccupancyMaxActiveBlocksPerMultiprocessor(&per_cu, (const void*)mk_fwd, NWAVES * 64, LDS_BYTES) != hipSuccess || per_cu < 1) { fprintf(stderr, "kernel_launch: occupancy query failed (%d)\n", per_cu); (void)hipGetLastError(); per_cu = 1; }
        if (cus != 256) fprintf(stderr, "kernel_launch: built for a 256-CU device (found %d)\n", cus);
        grid = 256;
    }
    if (grid < 0) return;
    Args a{};
    for (int i = 0; i < 14; ++i) a.in[i] = (const float*)d_in[i];
    a.out = (float*)d_out; a.ws = (unsigned char*)d_ws;
    if (hipMemsetAsync((char*)d_ws + WS_BAR, 0, BAR_BYTES, stream) != hipSuccess) { fprintf(stderr, "kernel_launch: memset failed\n"); return; }
    hipLaunchKernelGGL(mk_fwd, dim3(grid), dim3(NWAVES * 64), LDS_BYTES, stream, a);
    const hipError_t e = hipPeekAtLastError();
    if (e != hipSuccess) fprintf(stderr, "kernel_launch: launch failed: %s (grid %d)\n", hipGetErrorName(e), grid);
}
```

```cpp
#include <hip/hip_runtime.h>
#include <cstdio>
#include <cstdint>
constexpr int NWAVES = 8;
constexpr int NB = 8, SEQ = 2048, D = 1024, M = NB * SEQ, NIN = 6144, FF = 4096;
constexpr float EPS = 1e-6f;
constexpr size_t MiB = 1u << 20, KiB = 1024;
constexpr size_t WS_SSQ1 = 245 * MiB, WS_SSQ2 = 246 * MiB,
                WS_KNAM = 128 * KiB, WS_VTM = 144 * KiB, WS_KFTM = 160 * KiB, WS_VHTM = 176 * KiB, WS_GFM = 192 * KiB, WS_LB = 196 * KiB, WS_DSEG = 256 * KiB;
constexpr size_t WS_WIN = 1 * MiB, WS_WNA = 13 * MiB, WS_WHG = 14 * MiB, WS_WO = 15 * MiB, WS_WUP = 17 * MiB, WS_WDN = 237 * MiB;
constexpr size_t WS_XN = 25 * MiB;
constexpr size_t WS_QNA = 57 * MiB, WS_KNA = 73 * MiB, WS_VT = 89 * MiB, WS_QF = 105 * MiB, WS_QB = 121 * MiB, WS_KF = 137 * MiB, WS_KFT = 153 * MiB, WS_KB = 169 * MiB, WS_KBT = 185 * MiB,
                 WS_VHT = 201 * MiB, WS_GHG = 217 * MiB, WS_GF = 233 * MiB, WS_GB = 235 * MiB;
constexpr size_t WS_OHG = WS_KNA;
constexpr size_t WS_T = WS_VT, WS_MIX = WS_KF, WS_U = WS_QNA, WS_END = 247 * MiB;
constexpr int LDS_BYTES = 163840, LDS_CTL = 162816;
constexpr size_t WS_C4CNT = 768 * 1024 + 16 * 1024;

namespace pg8 {
#define PG8_LAS __attribute__((address_space(3)))
typedef unsigned short bf16_t;
typedef short bf16x8 __attribute__((ext_vector_type(8)));
typedef float f32x4 __attribute__((ext_vector_type(4)));
typedef unsigned u32x4 __attribute__((ext_vector_type(4)));
constexpr int BM = 256, BK = 64, HALF = 128, HTB = HALF * BK * 2  , STAGE_BYTES = 8 * HTB, NXCD = 8, WGM = 8;

__host__ __device__ __forceinline__ int lds_byte(int r, int c) { const int st = (r >> 4) * 2 + (c >> 5), rr = r & 15, cc = c & 31, ob = rr * 64 + cc * 2; return st * 1024 + (ob ^ (((ob >> 9) & 1) << 5)); }
__host__ __device__ __forceinline__ void stage_rc(int b, int& R, int& C) { const int st = b / 1024, sb = b % 1024, swz = sb ^ (((sb >> 9) & 1) << 5); R = (st >> 1) * 16 + swz / 64; C = (st & 1) * 32 + (swz % 64) / 2; }
__host__ __device__ __forceinline__ int perm32(int rho) { const int n = rho >> 4, i = rho & 15; return 8 * (i >> 2) + 4 * n + (i & 3); }

struct Unit { int pm, pn; };
struct Gemm { const bf16_t* A; const bf16_t* Bt; int M, N, K; };

struct StaticOrder {
    int nM, nN, nwg, G, c;
    __host__ __device__ void init(int M, int N, int G_, int c_) { nM = M / BM; nN = N / BM; nwg = nM * nN; G = G_; c = c_; }
    __host__ __device__ bool next(int i, Unit& u) const {
        const long L = (long)i * G + c; if (L >= nwg) return false;
        int wgid = (int)L; { const int q = nwg / NXCD, r = nwg % NXCD, xcd = wgid % NXCD, off = wgid / NXCD; wgid = (xcd < r ? xcd * (q + 1) : r * (q + 1) + (xcd - r) * q) + off; }
        const int nig = WGM * nN, gid = wgid / nig, fm = gid * WGM, gsz = (nM - fm) < WGM ? (nM - fm) : WGM;
        u.pm = fm + ((wgid % nig) % gsz); u.pn = (wgid % nig) / gsz; return true;
    }
    __device__ __forceinline__ void a_ready(const Unit&) const {}
    __device__ __forceinline__ void done(const Unit&) const {}
};


struct PairOrder {
    StaticOrder base; Unit u0;
    __host__ __device__ void init(int M_, int N_, int G_, int c_) { base.init(M_, N_, G_, c_); base.next(0, u0); }
    __host__ __device__ bool next(int i, Unit& u) const { if (i >= 2) return false; u.pm = u0.pm + 64 * i; u.pn = u0.pn + 4 * i; return true; }
    __device__ __forceinline__ void a_ready(const Unit&) const {}
    __device__ __forceinline__ void done(const Unit&) const {}
};

typedef float cvt_f32x2_t __attribute__((ext_vector_type(2)));
typedef __bf16 cvt_bf16x2_t __attribute__((ext_vector_type(2)));
__device__ __forceinline__ unsigned cvt_pk_bf16(float lo, float hi) { const cvt_f32x2_t v = {lo, hi}; const cvt_bf16x2_t b = __builtin_convertvector(v, cvt_bf16x2_t); return __builtin_bit_cast(unsigned, b); }
__device__ __forceinline__ unsigned short f2bf(float f) { unsigned u = __builtin_bit_cast(unsigned, f); return (unsigned short)((u + 0x7fffu + ((u >> 16) & 1u)) >> 16); }
__device__ __forceinline__ float bflo(unsigned w) { return __builtin_bit_cast(float, w << 16); }
__device__ __forceinline__ float bfhi(unsigned w) { return __builtin_bit_cast(float, w & 0xffff0000u); }
__device__ __forceinline__ float sigm(float x) { return __builtin_amdgcn_rcpf(1.0f + __expf(-x)); }
template <int CTRL> __device__ __forceinline__ float dpp_mov(float v) { return __builtin_bit_cast(float, __builtin_amdgcn_update_dpp(0, __builtin_bit_cast(int, v), CTRL, 0xf, 0xf, true)); }
__device__ __forceinline__ float row_prefix16(float v, int fr) {
    v += dpp_mov<0x111>(v); v += dpp_mov<0x112>(v); v += dpp_mov<0x114>(v); v += dpp_mov<0x118>(v); (void)fr;
    return v;
}
__device__ __forceinline__ float row_suffix16(float v, int fr) {
    v += dpp_mov<0x101>(v); v += dpp_mov<0x102>(v); v += dpp_mov<0x104>(v); v += dpp_mov<0x108>(v); (void)fr;
    return v;
}

enum EpiMode { EM_IN = 0, EM_C1A = 1, EM_C1B = 2, EM_C2 = 3, EM_C3 = 4, EM_C4 = 5 };
template <int MODE> struct EpiAll {
    static constexpr bool PERM = true, AFTER_DRAIN = false;
    static constexpr int mode = MODE; unsigned char* ws; float* out; const float* x; const float* gain; const float* gfin;
    __device__ __forceinline__ void operator()(const f32x4 (&acc)[2][2][4][2], const Unit& u, int wr, int wc, int fr, int fq) const {
        const int pn = u.pn;
        const int row0 = u.pm * BM + wr * 64 + fr;
#define EP_B(off) ((bf16_t*)(ws + (off)))
#define EP_F(off) ((float*)(ws + (off)))
        bf16_t* const QNA = EP_B(WS_QNA); bf16_t* const KNA = EP_B(WS_KNA); bf16_t* const VT = EP_B(WS_VT); bf16_t* const QF = EP_B(WS_QF); bf16_t* const QB = EP_B(WS_QB); bf16_t* const KF = EP_B(WS_KF); bf16_t* const KB = EP_B(WS_KB);
        bf16_t* const KFT = EP_B(WS_KFT); bf16_t* const KBT = EP_B(WS_KBT); bf16_t* const VHT = EP_B(WS_VHT); bf16_t* const GHG = EP_B(WS_GHG); float* const GF = EP_F(WS_GF); float* const GB = EP_F(WS_GB); const float* const LB = EP_F(WS_LB);
        bf16_t* const SNA = (bf16_t*)out; bf16_t* const SHG = (bf16_t*)out + (size_t)M * D;
        bf16_t* const T = EP_B(WS_T); bf16_t* const MIX = EP_B(WS_MIX); bf16_t* const H1B = EP_B(WS_XN); bf16_t* const U = EP_B(WS_U); float* const ssq1 = EP_F(WS_SSQ1); float* const ssq2 = EP_F(WS_SSQ2);
#undef EP_B
#undef EP_F
        const int cl0 = wc * 32 + 8 * fq;
        if (mode == EM_IN) {
            if (pn < 4) {
                bf16_t* base = (pn < 2) ? QNA : KNA; const float sc = (pn < 2) ? 0.125f : 1.0f; const int colt = (pn & 1) * 256 + cl0;
#pragma unroll
                for (int ai = 0; ai < 2; ++ai)
#pragma unroll
                    for (int m = 0; m < 4; ++m) { bf16_t* rowp = base + (size_t)(row0 + ai * HALF + m * 16) * 512 + colt;
#pragma unroll
                        for (int bj = 0; bj < 2; ++bj) { const f32x4 v0 = acc[ai][bj][m][0] * sc, v1 = acc[ai][bj][m][1] * sc; u32x4 w;
                            w.x = cvt_pk_bf16(v0[0], v0[1]); w.y = cvt_pk_bf16(v0[2], v0[3]); w.z = cvt_pk_bf16(v1[0], v1[1]); w.w = cvt_pk_bf16(v1[2], v1[3]);
                            *(u32x4*)(rowp + bj * HALF) = w; } }
            } else if (pn < 6) {
                const int colt = (pn - 4) * 256 + cl0;
#pragma unroll
                for (int ai = 0; ai < 2; ++ai)
#pragma unroll
                    for (int m = 0; m < 4; ++m) { const int row = row0 + ai * HALF + m * 16; const int b = row >> 11, t = row & 2047, r = t >> 6, c = t & 63;
#pragma unroll
                        for (int bj = 0; bj < 2; ++bj) { const int col = colt + bj * HALF; const int h = col >> 6, d0 = col & 63;
                            bf16_t* bp = VT + ((((size_t)(b * 8 + h) * 32 + r) * 64 + d0) * 64 + c);
#pragma unroll
                            for (int n = 0; n < 2; ++n)
#pragma unroll
                                for (int j = 0; j < 4; ++j) bp[(4 * n + j) * 64] = f2bf(acc[ai][bj][m][n][j]); } }
            } else if (pn < 14) {
                const int ch0 = (pn - 6) * 64 + wc * 16 + fq * 4;
                const f32x4 lbf = *(const f32x4*)(LB + ch0), lbb = *(const f32x4*)(LB + 512 + ch0);
#pragma unroll
                for (int ai = 0; ai < 2; ++ai)
#pragma unroll
                    for (int m = 0; m < 4; ++m) { const int row = row0 + ai * HALF + m * 16; const int chunk = row >> 4;
                        const f32x4 q = acc[ai][0][m][0], zf = acc[ai][0][m][1], zb = acc[ai][1][m][0], iv = acc[ai][1][m][1];
                        float qfv[4], kfv[4], qbv[4], kbv[4]; f32x4 gfv, gbv;
#pragma unroll
                        for (int j = 0; j < 4; ++j) {
                            const float qs = q[j] * sigm(q[j]);
                            const float ff = lbf[j] + (1.0f - lbf[j]) * sigm(zf[j]);
                            const float fb = lbb[j] + (1.0f - lbb[j]) * sigm(zb[j]);
                            const float bf_ = row_prefix16(__builtin_amdgcn_logf(ff) * 0.69314718056f, fr), bb_ = row_suffix16(__builtin_amdgcn_logf(fb) * 0.69314718056f, fr);
                            const float ef = __expf(bf_), eb = __expf(bb_);
                            qfv[j] = qs * ef; kfv[j] = (1.0f - ff) * __expf(-bf_);
                            qbv[j] = qs * eb; kbv[j] = (1.0f - fb) * __expf(-bb_);
                            gfv[j] = ef; gbv[j] = eb;
                        }
                        typedef unsigned u32x2 __attribute__((ext_vector_type(2)));
                        const size_t ro = (size_t)row * 512 + ch0;
                        u32x2 w;
                        w.x = cvt_pk_bf16(qfv[0], qfv[1]); w.y = cvt_pk_bf16(qfv[2], qfv[3]); *(u32x2*)(QF + ro) = w;
                        w.x = cvt_pk_bf16(qbv[0], qbv[1]); w.y = cvt_pk_bf16(qbv[2], qbv[3]); *(u32x2*)(QB + ro) = w;
                        w.x = cvt_pk_bf16(kfv[0], kfv[1]); w.y = cvt_pk_bf16(kfv[2], kfv[3]); *(u32x2*)(KF + ro) = w;
                        w.x = cvt_pk_bf16(kbv[0], kbv[1]); w.y = cvt_pk_bf16(kbv[2], kbv[3]); *(u32x2*)(KB + ro) = w;
                        const size_t to = ((size_t)chunk * 512 + ch0) * 16 + fr;
#pragma unroll
                        for (int j = 0; j < 4; ++j) { KFT[to + j * 16] = f2bf(kfv[j]); KBT[to + j * 16] = f2bf(kbv[j]); VHT[to + j * 16] = f2bf(iv[j]); }
                        if (fr == 15) *(f32x4*)(GF + (size_t)chunk * 512 + ch0) = gfv;
                        if (fr == 0)  *(f32x4*)(GB + (size_t)chunk * 512 + ch0) = gbv;
                    }
            } else if (pn < 16) {
                const int colt = (pn - 14) * 256 + cl0;
#pragma unroll
                for (int bj = 0; bj < 2; ++bj) { const f32x4 g0 = *(const f32x4*)(gain + colt + bj * HALF), g1 = *(const f32x4*)(gain + colt + bj * HALF + 4);
#pragma unroll
                    for (int ai = 0; ai < 2; ++ai)
#pragma unroll
                        for (int m = 0; m < 4; ++m) { f32x4 v0 = acc[ai][bj][m][0], v1 = acc[ai][bj][m][1];
#pragma unroll
                            for (int j = 0; j < 4; ++j) { v0[j] = v0[j] * sigm(v0[j]) * g0[j]; v1[j] = v1[j] * sigm(v1[j]) * g1[j]; }
                            u32x4 w; w.x = cvt_pk_bf16(v0[0], v0[1]); w.y = cvt_pk_bf16(v0[2], v0[3]); w.z = cvt_pk_bf16(v1[0], v1[1]); w.w = cvt_pk_bf16(v1[2], v1[3]);
                            *(u32x4*)(GHG + (size_t)(row0 + ai * HALF + m * 16) * 512 + colt + bj * HALF) = w; } }
            } else {
                bf16_t* base = (pn < 20) ? SNA : SHG; const int colt = ((pn - 16) & 3) * 256 + cl0;
#pragma unroll
                for (int ai = 0; ai < 2; ++ai)
#pragma unroll
                    for (int m = 0; m < 4; ++m)
#pragma unroll
                        for (int bj = 0; bj < 2; ++bj) { f32x4 v0 = acc[ai][bj][m][0], v1 = acc[ai][bj][m][1];
#pragma unroll
                            for (int j = 0; j < 4; ++j) { v0[j] = sigm(v0[j]); v1[j] = sigm(v1[j]); }
                            u32x4 w; w.x = cvt_pk_bf16(v0[0], v0[1]); w.y = cvt_pk_bf16(v0[2], v0[3]); w.z = cvt_pk_bf16(v1[0], v1[1]); w.w = cvt_pk_bf16(v1[2], v1[3]);
                            *(u32x4*)(base + (size_t)(row0 + ai * HALF + m * 16) * 1024 + colt + bj * HALF) = w; }
            }
            return;
        }
        const int colt = (mode == EM_C1A ? (pn & 3) : pn) * BM + cl0;
        if (mode == EM_C1A || mode == EM_C1B) {
            const bool second = (mode == EM_C1B) || (pn >= 4); const int row0c = (mode == EM_C1A) ? (row0 & (M - 1)) : row0;
            const bf16_t* gate = second ? SHG : SNA; bf16_t* dst = second ? MIX : T;
#pragma unroll
            for (int ai = 0; ai < 2; ++ai) {
                u32x4 gv[4][2], tv[4][2];
#pragma unroll
                for (int m = 0; m < 4; ++m)
#pragma unroll
                    for (int bj = 0; bj < 2; ++bj) { const size_t off = (size_t)(row0c + ai * HALF + m * 16) * 1024 + colt + bj * HALF;
                        gv[m][bj] = *(const u32x4*)(gate + off); if (second) tv[m][bj] = *(const u32x4*)(T + off); else tv[m][bj] = (u32x4){0u, 0u, 0u, 0u}; }
#pragma unroll
                for (int m = 0; m < 4; ++m)
#pragma unroll
                    for (int bj = 0; bj < 2; ++bj) { const size_t off = (size_t)(row0c + ai * HALF + m * 16) * 1024 + colt + bj * HALF;
                        const u32x4 g = gv[m][bj], tt = tv[m][bj]; const f32x4 a0 = acc[ai][bj][m][0], a1 = acc[ai][bj][m][1];
                        const float r0 = a0[0] * bflo(g.x) + bflo(tt.x), r1 = a0[1] * bfhi(g.x) + bfhi(tt.x), r2 = a0[2] * bflo(g.y) + bflo(tt.y), r3 = a0[3] * bfhi(g.y) + bfhi(tt.y);
                        const float r4 = a1[0] * bflo(g.z) + bflo(tt.z), r5 = a1[1] * bfhi(g.z) + bfhi(tt.z), r6 = a1[2] * bflo(g.w) + bflo(tt.w), r7 = a1[3] * bfhi(g.w) + bfhi(tt.w);
                        u32x4 w; w.x = cvt_pk_bf16(r0, r1); w.y = cvt_pk_bf16(r2, r3); w.z = cvt_pk_bf16(r4, r5); w.w = cvt_pk_bf16(r6, r7);
                        *(u32x4*)(dst + off) = w; }
            }
        } else if (mode == EM_C4) {
            f32x4 (&hacc)[2][2][4][2] = const_cast<f32x4 (&)[2][2][4][2]>(acc);
#pragma unroll
            for (int ai = 0; ai < 2; ++ai)
#pragma unroll
                for (int mp = 0; mp < 2; ++mp) {
                    f32x4 pre[2][2][2];
#pragma unroll
                    for (int mm = 0; mm < 2; ++mm)
#pragma unroll
                        for (int bj = 0; bj < 2; ++bj) { const size_t off = (size_t)(row0 + ai * HALF + (2 * mp + mm) * 16) * 1024 + colt + bj * HALF;
                            const u32x4 hb = *(const u32x4*)(H1B + off);
                            pre[mm][bj][0] = (f32x4){bflo(hb.x), bfhi(hb.x), bflo(hb.y), bfhi(hb.y)}; pre[mm][bj][1] = (f32x4){bflo(hb.z), bfhi(hb.z), bflo(hb.w), bfhi(hb.w)}; }
#pragma unroll
                    for (int mm = 0; mm < 2; ++mm) { const int m = 2 * mp + mm; const int row = row0 + ai * HALF + m * 16; float s = 0.f;
#pragma unroll
                        for (int bj = 0; bj < 2; ++bj) { const f32x4 h0 = pre[mm][bj][0] + acc[ai][bj][m][0], h1 = pre[mm][bj][1] + acc[ai][bj][m][1];
                            hacc[ai][bj][m][0] = h0; hacc[ai][bj][m][1] = h1;
                            s += (h0[0] * h0[0] + h0[1] * h0[1]) + (h0[2] * h0[2] + h0[3] * h0[3]) + (h1[0] * h1[0] + h1[1] * h1[1]) + (h1[2] * h1[2] + h1[3] * h1[3]); }
                        s += __shfl_xor(s, 16); s += __shfl_xor(s, 32);
                        if (fq == 0) ssq2[(size_t)row * 16 + pn * 4 + wc] = s; }
                    asm volatile("" ::: "memory");
                }
            asm volatile("s_waitcnt vmcnt(0)" ::: "memory");
            __builtin_amdgcn_s_barrier();
            if (threadIdx.x == 0) {
                unsigned* cnt = (unsigned*)(ws + WS_C4CNT) + 16 * u.pm;
                __builtin_amdgcn_fence(__ATOMIC_RELEASE, "agent");
                asm volatile("s_waitcnt vmcnt(0)" ::: "memory");
                __hip_atomic_fetch_add(cnt, 1u, __ATOMIC_RELAXED, __HIP_MEMORY_SCOPE_AGENT);
                unsigned spins = 0;
                while (__hip_atomic_load(cnt, __ATOMIC_RELAXED, __HIP_MEMORY_SCOPE_AGENT) < 4u) { __builtin_amdgcn_s_sleep(2); if (++spins > (1u << 22)) break; }
                __builtin_amdgcn_fence(__ATOMIC_ACQUIRE, "agent");
                asm volatile("s_waitcnt vmcnt(0)" ::: "memory");
            }
            __builtin_amdgcn_s_barrier();
            asm volatile("" ::: "memory");
            const f32x4 gA0 = *(const f32x4*)(gfin + colt), gA1 = *(const f32x4*)(gfin + colt + 4), gB0 = *(const f32x4*)(gfin + colt + HALF), gB1 = *(const f32x4*)(gfin + colt + HALF + 4);
#pragma unroll
            for (int ai = 0; ai < 2; ++ai)
#pragma unroll
                for (int mp = 0; mp < 2; ++mp) {
                    f32x4 pp[2][4];
#pragma unroll
                    for (int mm = 0; mm < 2; ++mm)
#pragma unroll
                        for (int q = 0; q < 4; ++q) pp[mm][q] = *(const f32x4*)(ssq2 + (size_t)(row0 + ai * HALF + (2 * mp + mm) * 16) * 16 + 4 * q);
#pragma unroll
                    for (int mm = 0; mm < 2; ++mm) { const int m = 2 * mp + mm; const int row = row0 + ai * HALF + m * 16; const size_t off = (size_t)row * 1024 + colt;
                        const f32x4 p0 = pp[mm][0], p1 = pp[mm][1], p2 = pp[mm][2], p3 = pp[mm][3];
                        const float rs = rsqrtf(((((p0[0] + p0[1]) + (p0[2] + p0[3])) + ((p1[0] + p1[1]) + (p1[2] + p1[3]))) + (((p2[0] + p2[1]) + (p2[2] + p2[3])) + ((p3[0] + p3[1]) + (p3[2] + p3[3])))) * (1.0f / 1024.0f) + 1e-6f);
                        *(f32x4*)(out + off) = acc[ai][0][m][0] * rs * gA0; *(f32x4*)(out + off + 4) = acc[ai][0][m][1] * rs * gA1;
                        *(f32x4*)(out + off + HALF) = acc[ai][1][m][0] * rs * gB0; *(f32x4*)(out + off + HALF + 4) = acc[ai][1][m][1] * rs * gB1; }
                    asm volatile("" ::: "memory");
                }
        } else if (mode == EM_C2) {
            const float* base = (mode == EM_C2) ? x : (const float*)out; float* ssq = (mode == EM_C2) ? ssq1 : ssq2;
#pragma unroll
            for (int ai = 0; ai < 2; ++ai) {
                f32x4 pre[4][2][2];
#pragma unroll
                for (int m = 0; m < 4; ++m)
#pragma unroll
                    for (int bj = 0; bj < 2; ++bj) { const size_t off = (size_t)(row0 + ai * HALF + m * 16) * 1024 + colt + bj * HALF;
                        pre[m][bj][0] = *(const f32x4*)(base + off); pre[m][bj][1] = *(const f32x4*)(base + off + 4); }
#pragma unroll
                for (int m = 0; m < 4; ++m) { const int row = row0 + ai * HALF + m * 16; float s = 0.f;
#pragma unroll
                    for (int bj = 0; bj < 2; ++bj) { const size_t off = (size_t)row * 1024 + colt + bj * HALF;
                        const f32x4 h0 = pre[m][bj][0] + acc[ai][bj][m][0], h1 = pre[m][bj][1] + acc[ai][bj][m][1];
                        s += (h0[0] * h0[0] + h0[1] * h0[1]) + (h0[2] * h0[2] + h0[3] * h0[3]) + (h1[0] * h1[0] + h1[1] * h1[1]) + (h1[2] * h1[2] + h1[3] * h1[3]);
                        if (mode == EM_C2) { u32x4 w; w.x = cvt_pk_bf16(h0[0], h0[1]); w.y = cvt_pk_bf16(h0[2], h0[3]); w.z = cvt_pk_bf16(h1[0], h1[1]); w.w = cvt_pk_bf16(h1[2], h1[3]);
                            *(u32x4*)(H1B + off) = w; } }
                    s += __shfl_xor(s, 16); s += __shfl_xor(s, 32);
                    if (fq == 0) ssq[(size_t)row * 16 + pn * 4 + wc] = s; }
            }
        } else {
#pragma unroll
            for (int ai = 0; ai < 2; ++ai) {
                f32x4 pp[4][4];
#pragma unroll
                for (int m = 0; m < 4; ++m)
#pragma unroll
                    for (int q = 0; q < 4; ++q) pp[m][q] = *(const f32x4*)(ssq1 + (size_t)(row0 + ai * HALF + m * 16) * 16 + 4 * q);
#pragma unroll
                for (int m = 0; m < 4; ++m) { const int row = row0 + ai * HALF + m * 16;
                    const f32x4 p0 = pp[m][0], p1 = pp[m][1], p2 = pp[m][2], p3 = pp[m][3];
                    const float rs = rsqrtf(((((p0[0] + p0[1]) + (p0[2] + p0[3])) + ((p1[0] + p1[1]) + (p1[2] + p1[3]))) + (((p2[0] + p2[1]) + (p2[2] + p2[3])) + ((p3[0] + p3[1]) + (p3[2] + p3[3])))) * (1.0f / 1024.0f) + 1e-6f);
#pragma unroll
                    for (int bj = 0; bj < 2; ++bj) { f32x4 v0 = acc[ai][bj][m][0] * rs, v1 = acc[ai][bj][m][1] * rs;
#pragma unroll
                        for (int j = 0; j < 4; ++j) { const float a = fmaxf(v0[j], 0.f), b = fmaxf(v1[j], 0.f); v0[j] = a * a; v1[j] = b * b; }
                        u32x4 w; w.x = cvt_pk_bf16(v0[0], v0[1]); w.y = cvt_pk_bf16(v0[2], v0[3]); w.z = cvt_pk_bf16(v1[0], v1[1]); w.w = cvt_pk_bf16(v1[2], v1[3]);
                        *(u32x4*)(U + (size_t)row * 4096 + colt + bj * HALF) = w; } }
            }
        }
    }
};

template <class Epi, class Sched, bool ALIGN_EPI = false, bool SP2 = false>
__device__ __forceinline__ void gemm_phase(PG8_LAS unsigned char* lds, const Gemm g, const Sched& S, const Epi& E) {
    int tid_ = threadIdx.x; asm volatile("" : "+v"(tid_));
    const int tid = tid_, wid = __builtin_amdgcn_readfirstlane(tid >> 6), lane = tid & 63, wr = wid >> 2, wc = wid & 3, fr = lane & 15, fq = lane >> 4;
    const int K = g.K, nt = K / BK;
    unsigned voffA[2], voffB[2];
#pragma unroll
    for (int i = 0; i < 2; ++i) { int R, C; stage_rc(tid * 16 + i * 8192, R, C); const int Rb = Epi::PERM ? ((R & ~31) + perm32(R & 31)) : R;
        voffA[i] = (unsigned)(R * K + C) * 2u; voffB[i] = (unsigned)(Rb * K + C) * 2u; }
    const size_t kstep = (size_t)(BK * 2);
    const size_t hstep = (size_t)HALF * K * 2;
    const size_t tstep = 2 * hstep;
    const unsigned ldsw = (unsigned)wid * 1024u;
    const int aoff = lds_byte(wr * 64 + fr, fq * 8), boff = lds_byte(wc * 32 + fr, fq * 8);
#define PG8_SA(b, h) (((b) * 2 + (h)) * HTB)
#define PG8_SB(b, h) ((4 + (b) * 2 + (h)) * HTB)
#define PG8_STAGE(bufoff, gbase, voff) do { _Pragma("unroll") for (int _i = 0; _i < 2; ++_i) \
        __builtin_amdgcn_global_load_lds((const unsigned*)((const char*)(gbase) + (voff)[_i]), (PG8_LAS unsigned*)(lds + (bufoff) + ldsw + _i * 8192), 16, 0, 0); } while (0)
#define PG8_LDA(dst, b, h) do { _Pragma("unroll") for (int m = 0; m < 4; ++m) _Pragma("unroll") for (int k = 0; k < 2; ++k) dst[m][k] = *(const PG8_LAS bf16x8*)(lds + PG8_SA(b, h) + aoff + m * 2048 + k * 1024); } while (0)
#define PG8_LDB(dst, b, h) do { _Pragma("unroll") for (int n = 0; n < 2; ++n) _Pragma("unroll") for (int k = 0; k < 2; ++k) dst[n][k] = *(const PG8_LAS bf16x8*)(lds + PG8_SB(b, h) + boff + n * 2048 + k * 1024); } while (0)
#define PG8_MMA(ai, bj, At, Bt) do { __builtin_amdgcn_s_setprio(1); _Pragma("unroll") for (int m = 0; m < 4; ++m) _Pragma("unroll") for (int n = 0; n < 2; ++n) _Pragma("unroll") for (int k = 0; k < 2; ++k) \
        acc[ai][bj][m][n] = __builtin_amdgcn_mfma_f32_16x16x32_bf16(Bt[n][k], At[m][k], acc[ai][bj][m][n], 0, 0, 0); __builtin_amdgcn_s_setprio(0); } while (0)
#define PG8_WAIT_V(n) asm volatile("s_waitcnt vmcnt(" #n ")" ::: "memory")
#define PG8_WAIT_L(n) asm volatile("s_waitcnt lgkmcnt(" #n ")" ::: "memory")
#define PG8_BAR __builtin_amdgcn_s_barrier()
#define PG8_SCHED __builtin_amdgcn_sched_barrier(0)
    Unit cur, nxt; int ui = 0;
    if (!S.next(0, cur)) return;
    f32x4 acc[2][2][4][2];
#pragma unroll
    for (int a = 0; a < 2; ++a)
#pragma unroll
        for (int b = 0; b < 2; ++b)
#pragma unroll
            for (int m = 0; m < 4; ++m)
#pragma unroll
                for (int n = 0; n < 2; ++n) acc[a][b][m][n] = (f32x4){0.f, 0.f, 0.f, 0.f};
    bf16x8 At[4][2], B0[2][2], B1[2][2];
    const char* cA = (const char*)g.A + (size_t)cur.pm * tstep; const char* cB = (const char*)g.Bt + (size_t)cur.pn * tstep;
    S.a_ready(cur);
    if constexpr (SP2) {
        PG8_STAGE(PG8_SB(0, 0), cB, voffB); PG8_STAGE(PG8_SB(0, 1), cB + hstep, voffB); PG8_STAGE(PG8_SA(0, 0), cA, voffA); PG8_STAGE(PG8_SA(0, 1), cA + hstep, voffA);
        if (wr == 1) PG8_BAR;
        PG8_WAIT_V(2); PG8_BAR;
        PG8_STAGE(PG8_SB(1, 0), cB + kstep, voffB); PG8_STAGE(PG8_SA(1, 0), cA + kstep, voffA); PG8_STAGE(PG8_SB(1, 1), cB + hstep + kstep, voffB);
        PG8_WAIT_V(6); PG8_BAR;
    } else {
        PG8_STAGE(PG8_SB(0, 0), cB, voffB); PG8_STAGE(PG8_SA(0, 0), cA, voffA); PG8_STAGE(PG8_SB(0, 1), cB + hstep, voffB); PG8_STAGE(PG8_SA(0, 1), cA + hstep, voffA);
        if (wr == 1) PG8_BAR;
        PG8_WAIT_V(4); PG8_BAR;
        PG8_STAGE(PG8_SB(1, 0), cB + kstep, voffB); PG8_STAGE(PG8_SA(1, 0), cA + kstep, voffA); PG8_STAGE(PG8_SB(1, 1), cB + hstep + kstep, voffB);
        PG8_WAIT_V(6); PG8_BAR;
    }
    for (;;) {
        const bool has_next = S.next(ui + 1, nxt);
        const char* nA = has_next ? (const char*)g.A + (size_t)nxt.pm * tstep : cA; const char* nB = has_next ? (const char*)g.Bt + (size_t)nxt.pn * tstep : cB;
        for (int t = 0; t < nt; t += 2) {
            const bool last = (t == nt - 2);
            const char* a1 = cA + (size_t)(t + 1) * kstep;
            const char* a2 = last ? nA : cA + (size_t)(t + 2) * kstep; const char* b2 = last ? nB : cB + (size_t)(t + 2) * kstep;
            const char* a3 = a2 + kstep; const char* b3 = b2 + kstep;
            if (last && has_next) S.a_ready(nxt);
            if constexpr (SP2) {
            PG8_LDB(B0, 0, 0); PG8_LDB(B1, 0, 1); PG8_SCHED; PG8_LDA(At, 0, 0); PG8_STAGE(PG8_SA(1, 1), a1 + hstep, voffA);
            PG8_WAIT_V(8); PG8_WAIT_L(0); PG8_BAR; PG8_MMA(0, 0, At, B0); PG8_MMA(0, 1, At, B1); PG8_BAR; PG8_SCHED;
            PG8_LDA(At, 0, 1); PG8_STAGE(PG8_SB(0, 0), b2, voffB); PG8_STAGE(PG8_SB(0, 1), b2 + hstep, voffB); PG8_STAGE(PG8_SA(0, 0), a2, voffA);
            PG8_WAIT_V(8); PG8_WAIT_L(0); PG8_BAR; PG8_MMA(1, 0, At, B0); PG8_MMA(1, 1, At, B1); PG8_BAR; PG8_SCHED;
            PG8_LDB(B0, 1, 0); PG8_LDB(B1, 1, 1); PG8_SCHED; PG8_LDA(At, 1, 0); PG8_STAGE(PG8_SA(0, 1), a2 + hstep, voffA);
            PG8_WAIT_V(8); PG8_WAIT_L(0); PG8_BAR; PG8_MMA(0, 0, At, B0); PG8_MMA(0, 1, At, B1); PG8_BAR; PG8_SCHED;
            PG8_LDA(At, 1, 1); PG8_STAGE(PG8_SB(1, 0), b3, voffB); PG8_STAGE(PG8_SB(1, 1), b3 + hstep, voffB); PG8_STAGE(PG8_SA(1, 0), a3, voffA);
            PG8_WAIT_V(8); PG8_WAIT_L(0); PG8_BAR; PG8_MMA(1, 0, At, B0); PG8_MMA(1, 1, At, B1); PG8_BAR; PG8_SCHED;
            } else {
            PG8_LDB(B0, 0, 0); PG8_SCHED; PG8_LDA(At, 0, 0); PG8_STAGE(PG8_SA(1, 1), a1 + hstep, voffA);
            PG8_WAIT_L(8); PG8_BAR; PG8_WAIT_L(0); PG8_MMA(0, 0, At, B0); PG8_BAR; PG8_SCHED;
            PG8_LDB(B1, 0, 1); PG8_STAGE(PG8_SB(0, 0), b2, voffB);
            PG8_BAR; PG8_WAIT_L(0); PG8_MMA(0, 1, At, B1); PG8_BAR;
            PG8_LDA(At, 0, 1); PG8_STAGE(PG8_SA(0, 0), a2, voffA);
            PG8_BAR; PG8_WAIT_L(0); PG8_MMA(1, 0, At, B0); PG8_BAR; PG8_SCHED;
            PG8_STAGE(PG8_SB(0, 1), b2 + hstep, voffB);
            PG8_WAIT_V(6); PG8_BAR; PG8_MMA(1, 1, At, B1); PG8_BAR;
            PG8_LDB(B0, 1, 0); PG8_SCHED; PG8_LDA(At, 1, 0); PG8_STAGE(PG8_SA(0, 1), a2 + hstep, voffA);
            PG8_WAIT_L(8); PG8_BAR; PG8_WAIT_L(0); PG8_MMA(0, 0, At, B0); PG8_BAR; PG8_SCHED;
            PG8_LDB(B1, 1, 1); PG8_STAGE(PG8_SB(1, 0), b3, voffB);
            PG8_BAR; PG8_WAIT_L(0); PG8_MMA(0, 1, At, B1); PG8_BAR;
            PG8_LDA(At, 1, 1); PG8_STAGE(PG8_SA(1, 0), a3, voffA);
            PG8_BAR; PG8_WAIT_L(0); PG8_MMA(1, 0, At, B0); PG8_BAR; PG8_SCHED;
            PG8_STAGE(PG8_SB(1, 1), b3 + hstep, voffB);
            PG8_WAIT_V(6); PG8_BAR; PG8_MMA(1, 1, At, B1); PG8_BAR;
            }
        }
        if constexpr (ALIGN_EPI) { if (wr == 0) PG8_BAR; }
        if constexpr (!Epi::AFTER_DRAIN) { E(acc, cur, wr, wc, fr, fq); S.done(cur); }
        if (!has_next) break;
#pragma unroll
        for (int a = 0; a < 2; ++a)
#pragma unroll
            for (int b = 0; b < 2; ++b)
#pragma unroll
                for (int m = 0; m < 4; ++m)
#pragma unroll
                    for (int n = 0; n < 2; ++n) acc[a][b][m][n] = (f32x4){0.f, 0.f, 0.f, 0.f};
        cur = nxt; cA = nA; cB = nB; ++ui;
        if constexpr (ALIGN_EPI) { if (wr == 1) PG8_BAR; }
    }
    PG8_WAIT_V(0);
    if constexpr (!ALIGN_EPI) { if (wr == 0) PG8_BAR; }
    PG8_BAR;
    if constexpr (Epi::AFTER_DRAIN) { E.fused(acc, cur, wr, wc, fr, fq, lds, wid, lane); S.done(cur); }
#undef PG8_SA
#undef PG8_SB
#undef PG8_STAGE
#undef PG8_LDA
#undef PG8_LDB
#undef PG8_MMA
#undef PG8_WAIT_V
#undef PG8_WAIT_L
#undef PG8_BAR
#undef PG8_SCHED
}
}

#define GAS __attribute__((address_space(1)))
#define LAS __attribute__((address_space(3)))
typedef unsigned short bf16;
typedef unsigned v4u __attribute__((ext_vector_type(4)));
typedef unsigned v2u __attribute__((ext_vector_type(2)));
typedef float f32x4 __attribute__((ext_vector_type(4)));
typedef float f32x2 __attribute__((ext_vector_type(2)));
typedef short bf16x8 __attribute__((ext_vector_type(8)));
typedef short s16x4 __attribute__((ext_vector_type(4)));
using pg8::f2bf; using pg8::cvt_pk_bf16; using pg8::bflo; using pg8::bfhi;


__device__ __forceinline__ float wave_sum(float v) {
#pragma unroll
    for (int o = 1; o < 64; o <<= 1) v += __shfl_xor(v, o);
    return v;
}
__device__ __forceinline__ unsigned pk2(float lo, float hi) { return (unsigned)f2bf(lo) | ((unsigned)f2bf(hi) << 16); }

#define XB_TMO      128
#define XB_XCNT(j)  (256  + 64 * (j))
#define XB_XSUB(j)  (1280 + 64 * (j))
#define XB_XGEN(j)  (2304 + 64 * (j))
#define XB_TOP      3328
#define XB_TOPGEN   3392
#define XCD_BAR_WORDS 3456
#define XB_SPIN_CAP (1u << 18)

__device__ __forceinline__ unsigned xb_ld(unsigned* p)              { return __hip_atomic_load(p, __ATOMIC_RELAXED, __HIP_MEMORY_SCOPE_AGENT); }
__device__ __forceinline__ unsigned xb_add(unsigned* p, unsigned v) { return __hip_atomic_fetch_add(p, v, __ATOMIC_RELAXED, __HIP_MEMORY_SCOPE_AGENT); }
__device__ __forceinline__ unsigned xb_xcc_id() { return (unsigned)__builtin_amdgcn_s_getreg((3 << 11) | 20) & 0xFu; }
#define XB_SPIN(cond, bar) do { unsigned _sp = 0; while (cond) { __builtin_amdgcn_s_sleep(1); \
    if ((++_sp & 255u) == 0u) { if (xb_ld(&(bar)[XB_TMO])) break; if (_sp > XB_SPIN_CAP) { atomicAdd(&(bar)[XB_TMO], 1u); break; } } } } while (0)

struct XcdBarrier {
    unsigned* bar; unsigned x;
    volatile LAS unsigned* st;
};

__device__ __forceinline__ XcdBarrier xcd_barrier_post(unsigned* bar, volatile LAS unsigned* st) {
    XcdBarrier b; b.bar = bar; b.x = xb_xcc_id(); b.st = st;
    if (threadIdx.x == 0) (void)xb_add(&bar[XB_XCNT(b.x)], 1u);
    return b;
}
__device__ __forceinline__ void xcd_barrier_complete(unsigned* bar, unsigned x, unsigned& nloc, unsigned& nx) {
    const unsigned G = gridDim.x * gridDim.y * gridDim.z;
    unsigned sum, cnt, mine, sp = 0u;
    for (;;) {
        sum = 0u; cnt = 0u; mine = 0u;
#pragma unroll
        for (unsigned j = 0; j < 16; ++j) { const unsigned c = xb_ld(&bar[XB_XCNT(j)]); sum += c; cnt += (c > 0u) ? 1u : 0u; mine = (j == x) ? c : mine; }
        if (sum == G) break;
        __builtin_amdgcn_s_sleep(1);
        if ((++sp & 255u) == 0u) { if (xb_ld(&bar[XB_TMO])) break; if (sp > XB_SPIN_CAP) { atomicAdd(&bar[XB_TMO], 1u); break; } }
    }
    nloc = mine > 0u ? mine : 1u; nx = cnt > 0u ? cnt : 1u;
}

__device__ __forceinline__ void xcd_barrier(const XcdBarrier& b) {
    asm volatile("s_waitcnt vmcnt(0)" ::: "memory");
    __syncthreads();
    if (threadIdx.x == 0) {
        unsigned* bar = b.bar;
        __builtin_amdgcn_s_waitcnt(0);
        unsigned nloc = b.st[0], nx = b.st[1];
        if (nloc == 0u) { xcd_barrier_complete(bar, b.x, nloc, nx); b.st[0] = nloc; b.st[1] = nx; }
        const unsigned old = xb_add(&bar[XB_XSUB(b.x)], 1u);
        const unsigned gen = old / nloc;
        if (old + 1u == (gen + 1u) * nloc) {
            __builtin_amdgcn_fence(__ATOMIC_RELEASE, "agent");
            asm volatile("s_waitcnt vmcnt(0)" ::: "memory");
            const unsigned og = xb_add(&bar[XB_TOP], 1u);
            const unsigned tg = og / nx;
            if (og + 1u == (tg + 1u) * nx) xb_add(&bar[XB_TOPGEN], 1u);
            else XB_SPIN(xb_ld(&bar[XB_TOPGEN]) == tg, bar);
            __builtin_amdgcn_fence(__ATOMIC_ACQUIRE, "agent");
            xb_add(&bar[XB_XGEN(b.x)], 1u);
            asm volatile("s_waitcnt vmcnt(0)" ::: "memory");
        } else {
            XB_SPIN(xb_ld(&bar[XB_XGEN(b.x)]) == gen, bar);
            __builtin_amdgcn_fence(__ATOMIC_ACQUIRE, "agent");
            asm volatile("s_waitcnt vmcnt(0)" ::: "memory");
        }
    }
    __syncthreads();
}

#define XL_SUB(j) (5120 + 64 * (j))
#define XL_GEN(j) (5632 + 64 * (j))
__device__ __forceinline__ void xcd_local_barrier(const XcdBarrier& b) {
    asm volatile("s_waitcnt vmcnt(0)" ::: "memory");
    __syncthreads();
    if (threadIdx.x == 0) {
        unsigned* bar = b.bar; const unsigned nloc = b.st[0];
        const unsigned old = xb_add(&bar[XL_SUB(b.x)], 1u), gen = old / nloc;
        if (old + 1u == (gen + 1u) * nloc) xb_add(&bar[XL_GEN(b.x)], 1u);
        else XB_SPIN(xb_ld(&bar[XL_GEN(b.x)]) == gen, bar);
        __builtin_amdgcn_fence(__ATOMIC_ACQUIRE, "agent");
        asm volatile("s_waitcnt vmcnt(0)" ::: "memory");
    }
    __syncthreads();
}
constexpr size_t WS_BAR = 768 * KiB, BAR_BYTES = 24 * KiB;
struct Args { const float* in[14]; float* out; unsigned char* ws; };

template <class CM>
__device__ __forceinline__ void tr_item(const float* W, int K, int N, bf16* WT, const float* kscale, LAS float* scr, int item, int lane, CM cmap) {
    const int nblk = N / 32, kb = item / nblk, nb = item % nblk, k0 = 64 * kb, n0 = 32 * nb;
    const int src = cmap(n0 + (lane & 31));
    float tv[32];
#pragma unroll
    for (int i = 0; i < 32; ++i) tv[i] = __builtin_nontemporal_load(W + (size_t)(k0 + 2 * i + (lane >> 5)) * N + src);
#pragma unroll
    for (int i = 0; i < 32; ++i) { const int kk = 2 * i + (lane >> 5); float v = tv[i]; if (kscale) v *= kscale[k0 + kk]; scr[kk * 33 + (lane & 31)] = v; }
    asm volatile("s_waitcnt lgkmcnt(0)" ::: "memory");
    const int c = lane & 7;
#pragma unroll
    for (int j = 0; j < 4; ++j) { const int n = (lane >> 3) + 8 * j; const LAS float* s = scr + (8 * c) * 33 + n;
        v4u o; o.x = pk2(s[0 * 33], s[1 * 33]); o.y = pk2(s[2 * 33], s[3 * 33]); o.z = pk2(s[4 * 33], s[5 * 33]); o.w = pk2(s[6 * 33], s[7 * 33]);
        *(v4u*)(WT + (size_t)(n0 + n) * K + k0 + 8 * c) = o; }
    asm volatile("s_waitcnt lgkmcnt(0)" ::: "memory");
}
struct CmId { __device__ __forceinline__ int operator()(int n) const { return n; } };
struct CmIn {
    __device__ __forceinline__ int operator()(int n) const {
        if (n < 1536 || n >= 3584) return n;
        const int q = n - 1536, j = q >> 8, cl = q & 255;
        const int sel = 2 * (cl >> 7) + ((cl >> 2) & 1), ch = 64 * j + 16 * ((cl >> 5) & 3) + 4 * ((cl >> 3) & 3) + (cl & 3);
        return 1536 + 512 * sel + ch;
    }
};

struct HgOps { s16x4 vb[2]; s16x4 ka[8]; f32x4 g[8]; };
__device__ __forceinline__ void hg_load(HgOps& o, const bf16* KT, const bf16* VTt, const float* G, unsigned cb, int vq, int lm, int kq) {
#pragma unroll
    for (int vt = 0; vt < 2; ++vt) o.vb[vt] = *(const s16x4*)(VTt + (unsigned)((cb + 32 * vq + 16 * vt + lm) * 16 + 4 * kq));
#pragma unroll
    for (int kt = 0; kt < 8; ++kt) { o.ka[kt] = *(const s16x4*)(KT + (unsigned)((cb + 16 * kt + lm) * 16 + 4 * kq)); o.g[kt] = *(const f32x4*)(G + (unsigned)(cb + 16 * kt + 4 * kq)); }
}
template <bool TRACKD>
__device__ __forceinline__ void hg_apply(f32x4 (&S)[8][2], f32x4 (&Dp)[8], const HgOps& o) {
#pragma unroll
    for (int kt = 0; kt < 8; ++kt) {
#pragma unroll
        for (int vt = 0; vt < 2; ++vt) { S[kt][vt] = __builtin_amdgcn_mfma_f32_16x16x16bf16_1k(o.ka[kt], o.vb[vt], S[kt][vt], 0, 0, 0); S[kt][vt] = S[kt][vt] * o.g[kt]; }
        if (TRACKD) Dp[kt] = Dp[kt] * o.g[kt];
    }
}
template <bool TRACKD>
__device__ __forceinline__ void hg_update(f32x4 (&S)[8][2], f32x4 (&Dp)[8], const bf16* KT, const bf16* VTt, const float* G, unsigned cb, int vq, int lm, int kq) {
    HgOps o; hg_load(o, KT, VTt, G, cb, vq, lm, kq); hg_apply<TRACKD>(S, Dp, o);
}

__global__ void __launch_bounds__(NWAVES * 64, 2) mk_fwd(Args args) {
    extern __shared__ __attribute__((aligned(16))) unsigned char lds_raw[];
    LAS unsigned char* lds = (LAS unsigned char*)lds_raw;
    const int tid = threadIdx.x, lane = tid & 63, wave = __builtin_amdgcn_readfirstlane(tid >> 6);
    const int G = gridDim.x, bx = blockIdx.x;
    const int gw = bx * NWAVES + wave, NGW = G * NWAVES;
    const int lm = lane & 15, kq = lane >> 4;
    unsigned char* ws = args.ws;
    if (tid < 16) ((LAS unsigned*)(lds + LDS_CTL))[tid] = 0u;
    __syncthreads();
    const XcdBarrier bar = xcd_barrier_post((unsigned*)(ws + WS_BAR), (volatile LAS unsigned*)(lds + LDS_CTL + 32));
    if (tid == 0) ((LAS unsigned*)(lds + LDS_CTL))[0] = xb_add((unsigned*)(ws + WS_BAR) + 3520 + 64 * bar.x, 1u);
    __syncthreads();
    const unsigned my_rank = ((volatile LAS unsigned*)(lds + LDS_CTL))[0];
    const float* x = args.in[0]; const float* meta = args.in[1]; const float* w_in = args.in[2]; const float* w_na = args.in[3]; const float* w_hg = args.in[4];
    const float* w_o = args.in[5]; const float* w_up = args.in[6]; const float* w_dn = args.in[7]; const float* g_mix = args.in[8]; const float* g_mlp = args.in[9];
    const float* g_fin = args.in[10]; const float* hg_gain = args.in[11]; const float* rpb = args.in[12]; const float* lb_logits = args.in[13];
    float* out = args.out;
    float* ssq1 = (float*)(ws + WS_SSQ1); float* ssq2 = (float*)(ws + WS_SSQ2);
    bf16* KNAm = (bf16*)(ws + WS_KNAM); bf16* VTm = (bf16*)(ws + WS_VTM); bf16* KFTm = (bf16*)(ws + WS_KFTM); bf16* VHTm = (bf16*)(ws + WS_VHTM);
    float* GFm = (float*)(ws + WS_GFM); float* LB = (float*)(ws + WS_LB); float* DSEG = (float*)(ws + WS_DSEG);
    bf16* WT_in = (bf16*)(ws + WS_WIN); bf16* WT_na = (bf16*)(ws + WS_WNA); bf16* WT_hg = (bf16*)(ws + WS_WHG); bf16* WT_o = (bf16*)(ws + WS_WO); bf16* WT_up = (bf16*)(ws + WS_WUP); bf16* WT_dn = (bf16*)(ws + WS_WDN);
    bf16* XN = (bf16*)(ws + WS_XN); float* SBUF = (float*)(ws + WS_XN); bf16* H1B = (bf16*)(ws + WS_XN);
    bf16* QNA = (bf16*)(ws + WS_QNA); bf16* KNA = (bf16*)(ws + WS_KNA); bf16* VT = (bf16*)(ws + WS_VT); bf16* QF = (bf16*)(ws + WS_QF); bf16* QB = (bf16*)(ws + WS_QB);
    bf16* KF = (bf16*)(ws + WS_KF); bf16* KFT = (bf16*)(ws + WS_KFT); bf16* KB = (bf16*)(ws + WS_KB); bf16* KBT = (bf16*)(ws + WS_KBT); bf16* VHT = (bf16*)(ws + WS_VHT);
    bf16* GHG = (bf16*)(ws + WS_GHG); float* GF = (float*)(ws + WS_GF); float* GB = (float*)(ws + WS_GB);
    bf16* SNA = (bf16*)out; bf16* SHG = (bf16*)out + (size_t)M * D;
    bf16* ONA = QNA; bf16* OHG = (bf16*)(ws + WS_OHG); bf16* Tb = (bf16*)(ws + WS_T); bf16* MIX = (bf16*)(ws + WS_MIX); bf16* U = (bf16*)(ws + WS_U);

    {
        f32x4 xv0[4][4];
#pragma unroll
        for (int q = 0; q < 4; ++q)
#pragma unroll
            for (int j = 0; j < 4; ++j) xv0[q][j] = __builtin_nontemporal_load((const f32x4*)(x + (size_t)(gw + q * NGW) * D + 4 * lane + 256 * j));
        {
            LAS float* mT = (LAS float*)lds;
            LAS float* red = (LAS float*)(lds + 65536);
            LAS float* fin = (LAS float*)(lds + 65536 + 32768);
#pragma unroll
            for (int rr = 0; rr < 2; ++rr) { const int r = 2 * wave + rr; const float* mr = meta + (size_t)r * D;
                f32x4 v[4]; float s = 0.f;
#pragma unroll
                for (int j = 0; j < 4; ++j) { v[j] = *(const f32x4*)(mr + 4 * lane + 256 * j); s += (v[j].x * v[j].x + v[j].y * v[j].y) + (v[j].z * v[j].z + v[j].w * v[j].w); }
                const float rs = rsqrtf(wave_sum(s) * (1.0f / D) + EPS);
#pragma unroll
                for (int j = 0; j < 4; ++j) { const f32x4 g = *(const f32x4*)(g_mix + 4 * lane + 256 * j); const int k = 4 * lane + 256 * j;
                    mT[(k + 0) * 16 + r] = v[j].x * rs * g.x; mT[(k + 1) * 16 + r] = v[j].y * rs * g.y; mT[(k + 2) * 16 + r] = v[j].z * rs * g.z; mT[(k + 3) * 16 + r] = v[j].w * rs * g.w; } }
            __syncthreads();
            for (int cbk = bx; cbk < 256; cbk += G) {
                const int c = tid & 7, ks = tid >> 3, grp = cbk >> 6, cl0 = (cbk & 63) * 8;
                const int src = (grp == 0 ? 512 : grp == 1 ? 1024 : grp == 2 ? 2048 : 3072) + cl0 + c;
                float a[16];
#pragma unroll
                for (int r = 0; r < 16; ++r) a[r] = 0.f;
                float wv[16];
#pragma unroll
                for (int kk = 0; kk < 16; ++kk) wv[kk] = w_in[(size_t)(ks * 16 + kk) * NIN + src];
#pragma unroll
                for (int kk = 0; kk < 16; ++kk) { const int k = ks * 16 + kk; const float w = wv[kk];
                    const f32x4 m0 = *(const LAS f32x4*)(mT + k * 16), m1 = *(const LAS f32x4*)(mT + k * 16 + 4), m2 = *(const LAS f32x4*)(mT + k * 16 + 8), m3 = *(const LAS f32x4*)(mT + k * 16 + 12);
                    a[0] += w * m0.x; a[1] += w * m0.y; a[2] += w * m0.z; a[3] += w * m0.w; a[4] += w * m1.x; a[5] += w * m1.y; a[6] += w * m1.z; a[7] += w * m1.w;
                    a[8] += w * m2.x; a[9] += w * m2.y; a[10] += w * m2.z; a[11] += w * m2.w; a[12] += w * m3.x; a[13] += w * m3.y; a[14] += w * m3.z; a[15] += w * m3.w; }
#pragma unroll
                for (int r = 0; r < 16; ++r) red[(ks * 16 + r) * 8 + c] = a[r];
                __syncthreads();
                if (tid < 128) { float s = 0.f;
                    for (int q = 0; q < 64; ++q) s += red[q * 128 + tid];
                    fin[tid] = s; }
                __syncthreads();
                if (tid < 8) { const int cl = cl0 + tid;
#pragma unroll
                    for (int r = 0; r < 16; ++r) a[r] = fin[r * 8 + tid];
                    if (grp == 0) {
#pragma unroll
                        for (int r = 0; r < 16; ++r) KNAm[r * 512 + cl] = f2bf(a[r]);
                    } else if (grp == 1) { const int h = cl >> 6, d = cl & 63;
#pragma unroll
                        for (int r = 0; r < 16; ++r) VTm[(h * 64 + d) * 16 + r] = f2bf(a[r]);
                    } else if (grp == 2) {
                        const float l0 = lb_logits[cl], l1 = lb_logits[512 + cl]; const float lb = 1.0f / (1.0f + expf(l1 - l0));
                        float bsum = 0.f;
#pragma unroll
                        for (int r = 0; r < 16; ++r) { const float f = lb + (1.0f - lb) * __builtin_amdgcn_rcpf(1.0f + __expf(-a[r])); bsum += __builtin_amdgcn_logf(f) * 0.69314718056f; KFTm[cl * 16 + r] = f2bf((1.0f - f) * __expf(-bsum)); }
                        GFm[cl] = __expf(bsum);
                    } else {
#pragma unroll
                        for (int r = 0; r < 16; ++r) VHTm[cl * 16 + r] = f2bf(a[r]);
                    }
                }
                __syncthreads();
            }
        }
        for (int i = bx * 4 + tid; tid < 4 && i < 1024; i += G * 4) {
            const int dir = i >> 9, c = i & 511; const float l0 = lb_logits[dir * 1024 + c], l1 = lb_logits[dir * 1024 + 512 + c]; LB[i] = 1.0f / (1.0f + expf(l1 - l0)); }
        LAS float* scr = (LAS float*)(lds + wave * 16384);
        constexpr int I_IN = (D / 64) * (NIN / 32), I_NA = (512 / 64) * (D / 32), I_O = (D / 64) * (D / 32), I_UP = (D / 64) * (FF / 32), I_DN = (FF / 64) * (D / 32);
        constexpr int NITEMS = I_IN + 2 * I_NA + I_O + I_UP + I_DN;
        for (int it = gw; it < NITEMS; it += NGW) {
            int r = it;
            if (r < I_IN) { tr_item(w_in, D, NIN, WT_in, (const float*)nullptr, scr, r, lane, CmIn()); continue; } r -= I_IN;
            if (r < I_NA) { tr_item(w_na, 512, D, WT_na, (const float*)nullptr, scr, r, lane, CmId()); continue; } r -= I_NA;
            if (r < I_NA) { tr_item(w_hg, 512, D, WT_hg, (const float*)nullptr, scr, r, lane, CmId()); continue; } r -= I_NA;
            if (r < I_O) { tr_item(w_o, D, D, WT_o, (const float*)nullptr, scr, r, lane, CmId()); continue; } r -= I_O;
            if (r < I_UP) { tr_item(w_up, D, FF, WT_up, g_mlp, scr, r, lane, CmId()); continue; } r -= I_UP;
            tr_item(w_dn, FF, D, WT_dn, (const float*)nullptr, scr, r, lane, CmId());
        }
        for (int m0 = gw; m0 < M; m0 += 4 * NGW) {
            f32x4 v[4][4];
            if (m0 == gw) {
#pragma unroll
                for (int q = 0; q < 4; ++q)
#pragma unroll
                    for (int j = 0; j < 4; ++j) v[q][j] = xv0[q][j];
            } else {
#pragma unroll
                for (int q = 0; q < 4; ++q)
#pragma unroll
                    for (int j = 0; j < 4; ++j) v[q][j] = __builtin_nontemporal_load((const f32x4*)(x + (size_t)(m0 + q * NGW) * D + 4 * lane + 256 * j));
            }
#pragma unroll
            for (int q = 0; q < 4; ++q) { const int m = m0 + q * NGW; float s = 0.f;
#pragma unroll
                for (int j = 0; j < 4; ++j) s += (v[q][j].x * v[q][j].x + v[q][j].y * v[q][j].y) + (v[q][j].z * v[q][j].z + v[q][j].w * v[q][j].w);
                const float rs = rsqrtf(wave_sum(s) * (1.0f / D) + EPS);
#pragma unroll
                for (int j = 0; j < 4; ++j) { const f32x4 g = *(const f32x4*)(g_mix + 4 * lane + 256 * j);
                    v2u o; o.x = pk2(v[q][j].x * rs * g.x, v[q][j].y * rs * g.y); o.y = pk2(v[q][j].z * rs * g.z, v[q][j].w * rs * g.w);
                    *(v2u*)(XN + (size_t)m * D + 4 * lane + 256 * j) = o; } } }
    }
    xcd_barrier(bar);

    int vb = bx; bool xl = false;
    { const unsigned nloc = ((volatile LAS unsigned*)(lds + LDS_CTL + 32))[0], nx = ((volatile LAS unsigned*)(lds + LDS_CTL + 32))[1];
      bool even = (G == 256 && nloc == 32u && nx == 8u && bar.x < 8u && my_rank < 32u);
#pragma unroll
      for (int j = 0; j < 8; ++j) even = even && (xb_ld((unsigned*)(ws + WS_BAR) + XB_XCNT(j)) == 32u);
      if (even) { vb = (int)(my_rank * 8u + bar.x); xl = true; } }
    vb = __builtin_amdgcn_readfirstlane(vb);
#define PHASE_BAR() do { if (xl) xcd_local_barrier(bar); else xcd_barrier(bar); } while (0)
    const int xq = vb & 7, rk = vb >> 3, lw = rk * 8 + wave;
#define MK_EPI(NAME, MODE) pg8::EpiAll<MODE> NAME; NAME.ws = ws; NAME.out = out; NAME.x = x; NAME.gain = hg_gain; NAME.gfin = g_fin;
    {
        MK_EPI(E, pg8::EM_IN)
        pg8::Gemm g{XN, WT_in, M, NIN, D}; pg8::StaticOrder S; S.init(M, NIN, G, vb);
        pg8::gemm_phase<pg8::EpiAll<pg8::EM_IN>, pg8::StaticOrder, true, true>(lds, g, S, E);
    }
    PHASE_BAR();

    { const int wi = xq * 256 + lw;
        const int item = wi >> 2, vq = wi & 3, seg = item & 7, dir = (item >> 3) & 1, h = (item >> 4) & 3, b = item >> 6;
        f32x4 S[8][2], Dp[8];
#pragma unroll
        for (int kt = 0; kt < 8; ++kt) { S[kt][0] = (f32x4){0.f, 0.f, 0.f, 0.f}; S[kt][1] = (f32x4){0.f, 0.f, 0.f, 0.f}; Dp[kt] = (f32x4){1.f, 1.f, 1.f, 1.f}; }
        if (dir == 0 && seg == 0) hg_update<false>(S, Dp, KFTm, VHTm, GFm, (unsigned)(h * 128), vq, lm, kq);
        const bf16* KTp = dir ? KBT : KFT; const float* Gp = dir ? GB : GF;
        const int cstep = dir ? -512 : 512; const int cb0 = (b * 128 + seg * 16 + (dir ? 15 : 0)) * 512 + h * 128;
        {
            LAS unsigned char* stg0 = lds + (wave >> 2) * 9216;
            s16x4 kv[2][2], vbn[2][2], vbr[2][2]; v2u g8 = (v2u){0u, 0u};
#define B1_LOADS(IT) do { _Pragma("unroll") for (int u = 0; u < 2; ++u) { const unsigned cb_ = (unsigned)(cb0 + (2 * (IT) + u) * cstep); \
                _Pragma("unroll") for (int kk = 0; kk < 2; ++kk) kv[u][kk] = *(const s16x4*)(KTp + (unsigned)((cb_ + 16 * (2 * vq + kk) + lm) * 16 + 4 * kq)); \
                _Pragma("unroll") for (int vt = 0; vt < 2; ++vt) vbn[u][vt] = *(const s16x4*)(VHT + (unsigned)((cb_ + 32 * vq + 16 * vt + lm) * 16 + 4 * kq)); \
                if (vq == u) g8 = *(const v2u*)(Gp + cb_ + 2 * lane); } } while (0)
#define B1_STORE(STG) do { _Pragma("unroll") for (int u = 0; u < 2; ++u) { \
                _Pragma("unroll") for (int kk = 0; kk < 2; ++kk) *(LAS s16x4*)((STG) + (u * 8 + 2 * vq + kk) * 512 + lane * 8) = kv[u][kk]; \
                if (vq == u) *(LAS v2u*)((STG) + 8192 + u * 512 + lane * 8) = g8; } } while (0)
            __syncthreads();
            B1_LOADS(0);
            B1_STORE(stg0);
#pragma unroll
            for (int u = 0; u < 2; ++u) { vbr[u][0] = vbn[u][0]; vbr[u][1] = vbn[u][1]; }
            for (int it = 0; it < 8; ++it) {
                __syncthreads();
                LAS unsigned char* stg = stg0 + (it & 1) * 18432;
                if (it < 7) B1_LOADS(it + 1);
                __builtin_amdgcn_sched_barrier(0);
#pragma unroll
                for (int u = 0; u < 2; ++u)
#pragma unroll
                    for (int kt = 0; kt < 8; ++kt) { const s16x4 ka = *(const LAS s16x4*)(stg + (u * 8 + kt) * 512 + lane * 8); const f32x4 g = *(const LAS f32x4*)(stg + 8192 + u * 512 + (16 * kt + 4 * kq) * 4);
#pragma unroll
                        for (int vt = 0; vt < 2; ++vt) { S[kt][vt] = __builtin_amdgcn_mfma_f32_16x16x16bf16_1k(ka, vbr[u][vt], S[kt][vt], 0, 0, 0); S[kt][vt] = S[kt][vt] * g; }
                        Dp[kt] = Dp[kt] * g; }
                __builtin_amdgcn_sched_barrier(0);
                if (it < 7) { B1_STORE(stg0 + ((it + 1) & 1) * 18432);
#pragma unroll
                    for (int u = 0; u < 2; ++u) { vbr[u][0] = vbn[u][0]; vbr[u][1] = vbn[u][1]; } }
            }
#undef B1_LOADS
#undef B1_STORE
        }
        float* sp = SBUF + ((size_t)(item * 4 + vq) * 16) * 256 + lane * 4;
#pragma unroll
        for (int kt = 0; kt < 8; ++kt) { *(f32x4*)(sp + (kt * 2 + 0) * 256) = S[kt][0]; *(f32x4*)(sp + (kt * 2 + 1) * 256) = S[kt][1]; }
        if (vq == 0 && lm == 0) {
#pragma unroll
            for (int kt = 0; kt < 8; ++kt) *(f32x4*)(DSEG + item * 128 + 16 * kt + 4 * kq) = Dp[kt];
        }
    }
    PHASE_BAR();

    for (int i2 = 0; i2 < 2; ++i2) { const int tl = rk * 512 + tid + 16384 * i2;
        const int bhd = xq * 8 + (tl >> 12), e4 = tl & 4095, dir = bhd & 1; const int kt = (e4 >> 7) & 7, ln = e4 & 63; const int k0 = 16 * kt + 4 * (ln >> 4);
        f32x4 carry = (f32x4){0.f, 0.f, 0.f, 0.f}, locv[8], dv[8];
#pragma unroll
        for (int s = 0; s < 8; ++s) { const int seg = dir ? 7 - s : s, item = bhd * 8 + seg;
            locv[s] = *(const f32x4*)(SBUF + (size_t)item * 16384 + e4 * 4); dv[s] = *(const f32x4*)(DSEG + item * 128 + k0); }
#pragma unroll
        for (int s = 0; s < 8; ++s) { const int seg = dir ? 7 - s : s, item = bhd * 8 + seg;
            *(f32x4*)(SBUF + (size_t)item * 16384 + e4 * 4) = carry; carry = dv[s] * carry + locv[s]; }
    }
    {
        LAS float* rp = (LAS float*)lds;
        __syncthreads();
        if (tid < 465) rp[tid] = rpb[(rk >> 2) * 465 + tid];
        __syncthreads();
        LAS unsigned char* KS = lds + 15360; LAS unsigned char* VS = lds + 15360 + 73728;
        int prev_hi = -1;
        for (int i4 = 0; i4 < 4; ++i4) {
            const int hh = rk >> 2, rg = rk & 3, rpair = 8 * rg + 2 * i4;
            const int cq = wave & 3, r = rpair + (wave >> 2), h = hh, b = xq;
            const int lo = min(max(rpair - 4, 0), 24);
            __syncthreads();
            { const int c = tid >> 3, q = tid & 7;
              if (i4 == 0) {
                v4u kreg[9], vreg[9];
#pragma unroll
                for (int e9 = 0; e9 < 9; ++e9) { const int row = min(lo + e9, 31);
                    kreg[e9] = *(const v4u*)(KNA + ((size_t)b * SEQ + row * 64 + c) * 512 + h * 64 + q * 8);
                    vreg[e9] = *(const v4u*)(VT + ((((size_t)(b * 8 + h) * 32 + row) * 64 + c) * 64 + q * 8)); }
#pragma unroll
                for (int e9 = 0; e9 < 9; ++e9) { const int kk = ((lo + e9) % 9) * 64 + c;
                    *(LAS v4u*)(KS + kk * 128 + ((q ^ (kk & 7)) * 16)) = kreg[e9]; *(LAS v4u*)(VS + kk * 128 + ((q ^ (kk & 7)) * 16)) = vreg[e9]; }
              } else {
                v4u kreg[2], vreg[2];
#pragma unroll
                for (int e2 = 0; e2 < 2; ++e2) { const int row = min(prev_hi + 1 + e2, 31);
                    kreg[e2] = *(const v4u*)(KNA + ((size_t)b * SEQ + row * 64 + c) * 512 + h * 64 + q * 8);
                    vreg[e2] = *(const v4u*)(VT + ((((size_t)(b * 8 + h) * 32 + row) * 64 + c) * 64 + q * 8)); }
#pragma unroll
                for (int e2 = 0; e2 < 2; ++e2) { const int row = prev_hi + 1 + e2;
                    if (row <= lo + 8 && row < 32) { const int kk = (row % 9) * 64 + c;
                        *(LAS v4u*)(KS + kk * 128 + ((q ^ (kk & 7)) * 16)) = kreg[e2]; *(LAS v4u*)(VS + kk * 128 + ((q ^ (kk & 7)) * 16)) = vreg[e2]; } }
              }
            }
            prev_hi = lo + 8;
            __syncthreads();
            const int c0 = 16 * cq, kc0 = (cq == 0) ? 0 : (cq == 1) ? 8 : (cq == 2) ? 24 : 32;
            const int rs0 = min(max(r - 4, 0), 24);
            const size_t rowq = (size_t)b * SEQ + r * 64 + c0 + lm;
            bf16x8 qf[2], kmf[2]; s16x4 vmf[4];
#pragma unroll
            for (int ks = 0; ks < 2; ++ks) { qf[ks] = *(const bf16x8*)(QNA + rowq * 512 + h * 64 + 32 * ks + 8 * kq); kmf[ks] = *(const bf16x8*)(KNAm + lm * 512 + h * 64 + 32 * ks + 8 * kq); }
#pragma unroll
            for (int dt = 0; dt < 4; ++dt) vmf[dt] = *(const s16x4*)(VTm + (h * 64 + 16 * dt + lm) * 16 + 4 * kq);
            const int cqq = c0 + lm, cs = min(max(cqq - 8, 0), 48);
            f32x4 oa[4];
#pragma unroll
            for (int dt = 0; dt < 4; ++dt) oa[dt] = (f32x4){0.f, 0.f, 0.f, 0.f};
            float mrun = -3.0e38f, lsum = 0.f;
#pragma unroll
            for (int hf = 0; hf < 2; ++hf) {
                f32x4 sc[9]; bf16x8 vf[4][4];
                {   bf16x8 kf[4][2][2];
#pragma unroll
                    for (int j4 = 0; j4 < 4; ++j4)
#pragma unroll
                        for (int t = 0; t < 2; ++t) { const int kcol = kc0 + 8 * (lm >> 2) + 4 * t + (lm & 3); const size_t rowk = (size_t)b * SEQ + (rs0 + 4 * hf + j4) * 64 + kcol;
#pragma unroll
                            for (int ks = 0; ks < 2; ++ks) { const int kk = ((rs0 + 4 * hf + j4) % 9) * 64 + kcol; kf[j4][t][ks] = *(const LAS bf16x8*)(KS + kk * 128 + (((ks * 4 + kq) ^ (kk & 7)) * 16)); } (void)rowk; }
                    __builtin_amdgcn_sched_barrier(0);
#pragma unroll
                    for (int j4 = 0; j4 < 4; ++j4)
#pragma unroll
                        for (int t = 0; t < 2; ++t) { f32x4 a = (f32x4){0.f, 0.f, 0.f, 0.f};
#pragma unroll
                            for (int ks = 0; ks < 2; ++ks) a = __builtin_amdgcn_mfma_f32_16x16x32_bf16(kf[j4][t][ks], qf[ks], a, 0, 0, 0);
                            sc[2 * j4 + t] = a; }
                }
                __builtin_amdgcn_sched_barrier(0);
#pragma unroll
                for (int j4 = 0; j4 < 4; ++j4)
#pragma unroll
                    for (int dt = 0; dt < 4; ++dt) { const int vv = ((rs0 + 4 * hf + j4) % 9) * 64 + 16 * dt + lm; vf[j4][dt] = *(const LAS bf16x8*)(VS + vv * 128 + ((((kc0 >> 3) + kq) ^ (vv & 7)) * 16)); }
                __builtin_amdgcn_sched_barrier(0);
                if (hf == 1) { f32x4 a = (f32x4){0.f, 0.f, 0.f, 0.f};
#pragma unroll
                    for (int ks = 0; ks < 2; ++ks) a = __builtin_amdgcn_mfma_f32_16x16x32_bf16(kmf[ks], qf[ks], a, 0, 0, 0);
                    sc[8] = a; } else sc[8] = (f32x4){-1e30f, -1e30f, -1e30f, -1e30f};
                float mx = -3.0e38f;
#pragma unroll
                for (int j4 = 0; j4 < 4; ++j4)
#pragma unroll
                    for (int t = 0; t < 2; ++t)
#pragma unroll
                        for (int j = 0; j < 4; ++j) { const int kcol = kc0 + 8 * kq + 4 * t + j; const bool inw = (kcol >= cs) && (kcol < cs + 16);
                            const int dr = rs0 + 4 * hf + j4 - r, dc = min(max(kcol - cqq, -15), 15);
                            const float bias = rp[(dr + 7) * 31 + dc + 15];
                            const float s = inw ? sc[2 * j4 + t][j] + bias : -1e30f; sc[2 * j4 + t][j] = s; mx = fmaxf(mx, s); }
#pragma unroll
                for (int j = 0; j < 4; ++j) mx = fmaxf(mx, sc[8][j]);
                mx = fmaxf(mx, __shfl_xor(mx, 16)); mx = fmaxf(mx, __shfl_xor(mx, 32));
                const float mnew = fmaxf(mrun, mx), alpha = __expf(mrun - mnew);
                mrun = mnew; lsum *= alpha;
#pragma unroll
                for (int dt = 0; dt < 4; ++dt) oa[dt] = oa[dt] * alpha;
#pragma unroll
                for (int i = 0; i < 9; ++i)
#pragma unroll
                    for (int j = 0; j < 4; ++j) { const float p = __expf(sc[i][j] - mnew); sc[i][j] = p; lsum += p; }
#pragma unroll
                for (int j4 = 0; j4 < 4; ++j4) {
                    union { bf16x8 v; unsigned u[4]; } pf;
                    pf.u[0] = cvt_pk_bf16(sc[2 * j4][0], sc[2 * j4][1]); pf.u[1] = cvt_pk_bf16(sc[2 * j4][2], sc[2 * j4][3]);
                    pf.u[2] = cvt_pk_bf16(sc[2 * j4 + 1][0], sc[2 * j4 + 1][1]); pf.u[3] = cvt_pk_bf16(sc[2 * j4 + 1][2], sc[2 * j4 + 1][3]);
#pragma unroll
                    for (int dt = 0; dt < 4; ++dt) oa[dt] = __builtin_amdgcn_mfma_f32_16x16x32_bf16(vf[j4][dt], pf.v, oa[dt], 0, 0, 0); }
                if (hf == 1) { union { s16x4 v; unsigned u[2]; } pm; pm.u[0] = cvt_pk_bf16(sc[8][0], sc[8][1]); pm.u[1] = cvt_pk_bf16(sc[8][2], sc[8][3]);
#pragma unroll
                    for (int dt = 0; dt < 4; ++dt) oa[dt] = __builtin_amdgcn_mfma_f32_16x16x16bf16_1k(vmf[dt], pm.v, oa[dt], 0, 0, 0); }
            }
            lsum += __shfl_xor(lsum, 16); lsum += __shfl_xor(lsum, 32);
            const float inv = 1.0f / lsum;
#pragma unroll
            for (int dt = 0; dt < 4; ++dt) { v2u o; o.x = cvt_pk_bf16(oa[dt][0] * inv, oa[dt][1] * inv); o.y = cvt_pk_bf16(oa[dt][2] * inv, oa[dt][3] * inv);
                *(v2u*)(ONA + rowq * 512 + h * 64 + 16 * dt + 4 * kq) = o; }
        }
        __syncthreads();
    }
    PHASE_BAR();

    { const int it = xq * 32 + rk;
        const int seg = it & 7, h = (it >> 3) & 3, b = it >> 5;
        const int dir = wave >> 2, vq = wave & 3, sitem = ((b * 4 + h) * 2 + dir) * 8 + seg;
        LAS unsigned short* ob = (LAS unsigned short*)lds;
        LAS unsigned char* stg0 = lds + 65536 + dir * 17408;
        __syncthreads();
        f32x4 S[8][2], Dp[8];
        { const float* sp = SBUF + ((size_t)(sitem * 4 + vq) * 16) * 256 + lane * 4;
#pragma unroll
          for (int kt = 0; kt < 8; ++kt) { S[kt][0] = *(const f32x4*)(sp + (kt * 2 + 0) * 256); S[kt][1] = *(const f32x4*)(sp + (kt * 2 + 1) * 256); Dp[kt] = (f32x4){1.f, 1.f, 1.f, 1.f}; } }
        if (dir == 0 && seg == 0) hg_update<false>(S, Dp, KFTm, VHTm, GFm, (unsigned)(h * 128), vq, lm, kq);
        const bf16* Qn = dir ? QB : QF; const bf16* Kn = dir ? KB : KF; const bf16* KTp = dir ? KBT : KFT; const float* Gp = dir ? GB : GF;
        s16x4 qv[2][2], kv[2][2], vbn[2][2]; v2u g8 = (v2u){0u, 0u};
#define B3_LOADS(IT) do { _Pragma("unroll") for (int u = 0; u < 2; ++u) { const int cl_ = dir ? 15 - (2 * (IT) + u) : 2 * (IT) + u; const size_t cgi_ = (size_t)b * 128 + seg * 16 + cl_, row0_ = cgi_ * 16; const unsigned cb_ = (unsigned)(cgi_ * 512 + h * 128); \
            _Pragma("unroll") for (int kk = 0; kk < 2; ++kk) { const int kt_ = 2 * vq + kk; \
                qv[u][kk] = *(const s16x4*)(Qn + (row0_ + lm) * 512 + h * 128 + 16 * kt_ + 4 * kq); \
                kv[u][kk] = *(const s16x4*)(KTp + (unsigned)((cb_ + 16 * kt_ + lm) * 16 + 4 * kq)); } \
            _Pragma("unroll") for (int vt = 0; vt < 2; ++vt) vbn[u][vt] = *(const s16x4*)(VHT + (unsigned)((cb_ + 32 * vq + 16 * vt + lm) * 16 + 4 * kq)); \
            if (vq == u) g8 = *(const v2u*)(Gp + cb_ + 2 * lane); } } while (0)
#define B3_STORE(STG) do { _Pragma("unroll") for (int u = 0; u < 2; ++u) { \
            _Pragma("unroll") for (int kk = 0; kk < 2; ++kk) { const int f_ = u * 8 + 2 * vq + kk; \
                *(LAS s16x4*)((STG) + f_ * 512 + lane * 8) = qv[u][kk]; *(LAS s16x4*)((STG) + 8192 + f_ * 512 + lane * 8) = kv[u][kk]; } \
            if (vq == u) *(LAS v2u*)((STG) + 16384 + u * 512 + lane * 8) = g8; } } while (0)
        B3_LOADS(0);
        {
            LAS v2u* PA = (LAS v2u*)(lds + 135168);
            bf16x8 kn4[4][4], qn4[4][4];
#pragma unroll
            for (int q = 0; q < 4; ++q) { const size_t r0 = ((size_t)b * 128 + seg * 16 + vq + 4 * q) * 16;
#pragma unroll
                for (int ii = 0; ii < 4; ++ii) { const size_t o = (r0 + lm) * 512 + h * 128 + 32 * ii + 8 * kq; kn4[q][ii] = *(const bf16x8*)(Kn + o); qn4[q][ii] = *(const bf16x8*)(Qn + o); } }
#pragma unroll
            for (int q = 0; q < 4; ++q) { f32x4 at = (f32x4){0.f, 0.f, 0.f, 0.f};
#pragma unroll
                for (int ii = 0; ii < 4; ++ii) at = __builtin_amdgcn_mfma_f32_16x16x32_bf16(kn4[q][ii], qn4[q][ii], at, 0, 0, 0);
#pragma unroll
                for (int j = 0; j < 4; ++j) { const int s = 4 * kq + j; const bool keep = dir ? (s >= lm) : (s <= lm); at[j] = keep ? at[j] : 0.f; }
                v2u w; w.x = cvt_pk_bf16(at[0], at[1]); w.y = cvt_pk_bf16(at[2], at[3]);
                PA[(dir * 16 + vq + 4 * q) * 64 + lane] = w; }
        }
        __syncthreads();
        B3_STORE(stg0);
        s16x4 vbr[2][2];
#pragma unroll
        for (int u = 0; u < 2; ++u) { vbr[u][0] = vbn[u][0]; vbr[u][1] = vbn[u][1]; }
        for (int it = 0; it < 8; ++it) {
            __syncthreads();
            LAS unsigned char* stg = stg0 + (it & 1) * 34816;
            if (it < 7) B3_LOADS(it + 1);
            __builtin_amdgcn_sched_barrier(0);
#pragma unroll
            for (int u = 0; u < 2; ++u) { const int cl = dir ? 15 - (2 * it + u) : 2 * it + u;
                union { s16x4 v; v2u u2; } pa; pa.u2 = ((const LAS v2u*)(lds + 135168))[(dir * 16 + cl) * 64 + lane];
                f32x4 o2[2]; o2[0] = (f32x4){0.f, 0.f, 0.f, 0.f}; o2[1] = (f32x4){0.f, 0.f, 0.f, 0.f};
#pragma unroll
                for (int kt = 0; kt < 8; ++kt) { const s16x4 q4 = *(const LAS s16x4*)(stg + (u * 8 + kt) * 512 + lane * 8);
#pragma unroll
                    for (int vt = 0; vt < 2; ++vt) { union { s16x4 v; unsigned u[2]; } sb; sb.u[0] = cvt_pk_bf16(S[kt][vt][0], S[kt][vt][1]); sb.u[1] = cvt_pk_bf16(S[kt][vt][2], S[kt][vt][3]);
                        o2[vt] = __builtin_amdgcn_mfma_f32_16x16x16bf16_1k(q4, sb.v, o2[vt], 0, 0, 0); } }
#pragma unroll
                for (int vt = 0; vt < 2; ++vt) { o2[vt] = __builtin_amdgcn_mfma_f32_16x16x16bf16_1k(pa.v, vbr[u][vt], o2[vt], 0, 0, 0);
#pragma unroll
                    for (int j = 0; j < 4; ++j) { LAS unsigned short* op = ob + (16 * cl + 4 * kq + j) * 128 + 32 * vq + 16 * vt + lm;
                        const float val = (it < 4) ? o2[vt][j] : (bflo((unsigned)*op) + o2[vt][j]); *op = f2bf(val); } }
#pragma unroll
                for (int kt = 0; kt < 8; ++kt) { const s16x4 ka = *(const LAS s16x4*)(stg + 8192 + (u * 8 + kt) * 512 + lane * 8); const f32x4 g = *(const LAS f32x4*)(stg + 16384 + u * 512 + (16 * kt + 4 * kq) * 4);
#pragma unroll
                    for (int vt = 0; vt < 2; ++vt) { S[kt][vt] = __builtin_amdgcn_mfma_f32_16x16x16bf16_1k(ka, vbr[u][vt], S[kt][vt], 0, 0, 0); S[kt][vt] = S[kt][vt] * g; } }
            }
            __builtin_amdgcn_sched_barrier(0);
            if (it < 7) { B3_STORE(stg0 + ((it + 1) & 1) * 34816);
#pragma unroll
                for (int u = 0; u < 2; ++u) { vbr[u][0] = vbn[u][0]; vbr[u][1] = vbn[u][1]; } }
        }
#undef B3_LOADS
#undef B3_STORE
        v4u ggp[8];
#pragma unroll
        for (int i = 0; i < 8; ++i) ggp[i] = *(const v4u*)(GHG + ((size_t)b * SEQ + seg * 256 + wave * 32 + 4 * i + kq) * 512 + h * 128 + 8 * lm);
        __syncthreads();
#pragma unroll
        for (int i = 0; i < 8; ++i) { const int tl = wave * 32 + 4 * i + kq; const size_t row = (size_t)b * SEQ + seg * 256 + tl;
            const v4u ov = *(const LAS v4u*)(ob + tl * 128 + 8 * lm);
            const f32x4 v0 = (f32x4){bflo(ov.x), bfhi(ov.x), bflo(ov.y), bfhi(ov.y)}, v1 = (f32x4){bflo(ov.z), bfhi(ov.z), bflo(ov.w), bfhi(ov.w)};
            const v4u gg = ggp[i];
            float s = (v0.x * v0.x + v0.y * v0.y) + (v0.z * v0.z + v0.w * v0.w) + (v1.x * v1.x + v1.y * v1.y) + (v1.z * v1.z + v1.w * v1.w);
            s += __shfl_xor(s, 1); s += __shfl_xor(s, 2); s += __shfl_xor(s, 4); s += __shfl_xor(s, 8);
            const float rs = rsqrtf(s * (1.0f / 128.0f) + EPS);
            v4u o; o.x = cvt_pk_bf16(v0.x * rs * bflo(gg.x), v0.y * rs * bfhi(gg.x)); o.y = cvt_pk_bf16(v0.z * rs * bflo(gg.y), v0.w * rs * bfhi(gg.y));
            o.z = cvt_pk_bf16(v1.x * rs * bflo(gg.z), v1.y * rs * bfhi(gg.z)); o.w = cvt_pk_bf16(v1.z * rs * bflo(gg.w), v1.w * rs * bfhi(gg.w));
            *(v4u*)(OHG + row * 512 + h * 128 + 8 * lm) = o; }
        __syncthreads();
    }
    PHASE_BAR();

    {
        MK_EPI(E, pg8::EM_C1A)
        pg8::Gemm g{ONA, WT_na, 2 * M, 2 * D, 512}; pg8::PairOrder S; S.init(M, D, G, vb);
        pg8::gemm_phase<pg8::EpiAll<pg8::EM_C1A>, pg8::PairOrder, true, true>(lds, g, S, E);
    }
    PHASE_BAR();
    {
        MK_EPI(E, pg8::EM_C2)
        pg8::Gemm g{MIX, WT_o, M, D, D}; pg8::StaticOrder S; S.init(M, D, G, vb);
        pg8::gemm_phase<pg8::EpiAll<pg8::EM_C2>, pg8::StaticOrder, true, true>(lds, g, S, E);
    }
    PHASE_BAR();
    {
        MK_EPI(E, pg8::EM_C3)
        pg8::Gemm g{H1B, WT_up, M, FF, D}; pg8::StaticOrder S; S.init(M, FF, G, vb);
        pg8::gemm_phase<pg8::EpiAll<pg8::EM_C3>, pg8::StaticOrder, true, true>(lds, g, S, E);
    }
    PHASE_BAR();
    {
        MK_EPI(E, pg8::EM_C4)
        pg8::Gemm g{U, WT_dn, M, D, FF}; pg8::StaticOrder S; S.init(M, D, G, vb);
        pg8::gemm_phase<pg8::EpiAll<pg8::EM_C4>, pg8::StaticOrder, true, true>(lds, g, S, E);
    }

}

extern "C" void kernel_launch(void* const* d_in, const int* in_sizes, int n_in, void* d_out, int out_size, void* d_ws, size_t ws_size, hipStream_t stream) {
    static int grid = 0;
    if (grid == 0) {
        if (n_in != 14 || in_sizes[0] != M * D || out_size != M * D || ws_size < WS_END) { fprintf(stderr, "kernel_launch: unexpected shapes / workspace (n_in %d, in0 %d, out %d, ws %zu)\n", n_in, n_in > 0 ? in_sizes[0] : -1, out_size, ws_size); grid = -1; return; }
        int dev = 0, cus = 0, per_cu = 0;
        if (hipGetDevice(&dev) != hipSuccess || hipDeviceGetAttribute(&cus, hipDeviceAttributeMultiprocessorCount, dev) != hipSuccess) { grid = -1; return; }
        if (hipFuncSetAttribute((const void*)mk_fwd, hipFuncAttributeMaxDynamicSharedMemorySize, LDS_BYTES) != hipSuccess) { fprintf(stderr, "kernel_launch: hipFuncSetAttribute failed\n"); grid = -1; return; }
        if (hipOccupancyMaxActiveBlocksPerMultiprocessor(&per_cu, (const void*)mk_fwd, NWAVES * 64, LDS_BYTES) != hipSuccess || per_cu < 1) { fprintf(stderr, "kernel_launch: occupancy query failed (%d)\n", per_cu); (void)hipGetLastError(); per_cu = 1; }
        if (cus != 256) fprintf(stderr, "kernel_launch: built for a 256-CU device (found %d)\n", cus);
        grid = 256;
    }
    if (grid < 0) return;
    Args a{};
    for (int i = 0; i < 14; ++i) a.in[i] = (const float*)d_in[i];
    a.out = (float*)d_out; a.ws = (unsigned char*)d_ws;
    if (hipMemsetAsync((char*)d_ws + WS_BAR, 0, BAR_BYTES, stream) != hipSuccess) { fprintf(stderr, "kernel_launch: memset failed\n"); return; }
    hipLaunchKernelGGL(mk_fwd, dim3(grid), dim3(NWAVES * 64), LDS_BYTES, stream, a);
    const hipError_t e = hipPeekAtLastError();
    if (e != hipSuccess) fprintf(stderr, "kernel_launch: launch failed: %s (grid %d)\n", hipGetErrorName(e), grid);
}
```

```cpp
#include <hip/hip_runtime.h>
#include <cstdio>
#include <cstdint>
constexpr int NWAVES = 8;
constexpr int NB = 8, SEQ = 2048, D = 1024, M = NB * SEQ, NIN = 6144, FF = 4096;
constexpr float EPS = 1e-6f;
constexpr size_t MiB = 1u << 20, KiB = 1024;
constexpr size_t WS_SSQ1 = 245 * MiB, WS_SSQ2 = 246 * MiB,
                WS_KNAM = 128 * KiB, WS_VTM = 144 * KiB, WS_KFTM = 160 * KiB, WS_VHTM = 176 * KiB, WS_GFM = 192 * KiB, WS_LB = 196 * KiB, WS_DSEG = 256 * KiB;
constexpr size_t WS_WIN = 1 * MiB, WS_WNA = 13 * MiB, WS_WHG = 14 * MiB, WS_WO = 15 * MiB, WS_WUP = 17 * MiB, WS_WDN = 237 * MiB;
constexpr size_t WS_XN = 25 * MiB;
constexpr size_t WS_QNA = 57 * MiB, WS_KNA = 73 * MiB, WS_VT = 89 * MiB, WS_QF = 105 * MiB, WS_QB = 121 * MiB, WS_KF = 137 * MiB, WS_KFT = 153 * MiB, WS_KB = 169 * MiB, WS_KBT = 185 * MiB,
                 WS_VHT = 201 * MiB, WS_GHG = 217 * MiB, WS_GF = 233 * MiB, WS_GB = 235 * MiB;
constexpr size_t WS_OHG = WS_KNA;
constexpr size_t WS_T = WS_VT, WS_MIX = WS_KF, WS_U = WS_QNA, WS_END = 247 * MiB;
constexpr int LDS_BYTES = 163840, LDS_CTL = 162816;
constexpr size_t WS_C4CNT = 768 * 1024 + 16 * 1024;

namespace pg8 {
#define PG8_LAS __attribute__((address_space(3)))
typedef unsigned short bf16_t;
typedef short bf16x8 __attribute__((ext_vector_type(8)));
typedef float f32x4 __attribute__((ext_vector_type(4)));
typedef unsigned u32x4 __attribute__((ext_vector_type(4)));
constexpr int BM = 256, BK = 64, HALF = 128, HTB = HALF * BK * 2  , STAGE_BYTES = 8 * HTB, NXCD = 8, WGM = 8;

__host__ __device__ __forceinline__ int lds_byte(int r, int c) { const int st = (r >> 4) * 2 + (c >> 5), rr = r & 15, cc = c & 31, ob = rr * 64 + cc * 2; return st * 1024 + (ob ^ (((ob >> 9) & 1) << 5)); }
__host__ __device__ __forceinline__ void stage_rc(int b, int& R, int& C) { const int st = b / 1024, sb = b % 1024, swz = sb ^ (((sb >> 9) & 1) << 5); R = (st >> 1) * 16 + swz / 64; C = (st & 1) * 32 + (swz % 64) / 2; }
__host__ __device__ __forceinline__ int perm32(int rho) { const int n = rho >> 4, i = rho & 15; return 8 * (i >> 2) + 4 * n + (i & 3); }

struct Unit { int pm, pn; };
struct Gemm { const bf16_t* A; const bf16_t* Bt; int M, N, K; };

struct StaticOrder {
    int nM, nN, nwg, G, c;
    __host__ __device__ void init(int M, int N, int G_, int c_) { nM = M / BM; nN = N / BM; nwg = nM * nN; G = G_; c = c_; }
    __host__ __device__ bool next(int i, Unit& u) const {
        const long L = (long)i * G + c; if (L >= nwg) return false;
        int wgid = (int)L; { const int q = nwg / NXCD, r = nwg % NXCD, xcd = wgid % NXCD, off = wgid / NXCD; wgid = (xcd < r ? xcd * (q + 1) : r * (q + 1) + (xcd - r) * q) + off; }
        const int nig = WGM * nN, gid = wgid / nig, fm = gid * WGM, gsz = (nM - fm) < WGM ? (nM - fm) : WGM;
        u.pm = fm + ((wgid % nig) % gsz); u.pn = (wgid % nig) / gsz; return true;
    }
    __device__ __forceinline__ void a_ready(const Unit&) const {}
    __device__ __forceinline__ void done(const Unit&) const {}
};


struct PairOrder {
    StaticOrder base; Unit u0;
    __host__ __device__ void init(int M_, int N_, int G_, int c_) { base.init(M_, N_, G_, c_); base.next(0, u0); }
    __host__ __device__ bool next(int i, Unit& u) const { if (i >= 2) return false; u.pm = u0.pm + 64 * i; u.pn = u0.pn + 4 * i; return true; }
    __device__ __forceinline__ void a_ready(const Unit&) const {}
    __device__ __forceinline__ void done(const Unit&) const {}
};

typedef float cvt_f32x2_t __attribute__((ext_vector_type(2)));
typedef __bf16 cvt_bf16x2_t __attribute__((ext_vector_type(2)));
__device__ __forceinline__ unsigned cvt_pk_bf16(float lo, float hi) { const cvt_f32x2_t v = {lo, hi}; const cvt_bf16x2_t b = __builtin_convertvector(v, cvt_bf16x2_t); return __builtin_bit_cast(unsigned, b); }
__device__ __forceinline__ unsigned short f2bf(float f) { unsigned u = __builtin_bit_cast(unsigned, f); return (unsigned short)((u + 0x7fffu + ((u >> 16) & 1u)) >> 16); }
__device__ __forceinline__ float bflo(unsigned w) { return __builtin_bit_cast(float, w << 16); }
__device__ __forceinline__ float bfhi(unsigned w) { return __builtin_bit_cast(float, w & 0xffff0000u); }
__device__ __forceinline__ float sigm(float x) { return __builtin_amdgcn_rcpf(1.0f + __expf(-x)); }
template <int CTRL> __device__ __forceinline__ float dpp_mov(float v) { return __builtin_bit_cast(float, __builtin_amdgcn_update_dpp(0, __builtin_bit_cast(int, v), CTRL, 0xf, 0xf, true)); }
__device__ __forceinline__ float row_prefix16(float v, int fr) {
    v += dpp_mov<0x111>(v); v += dpp_mov<0x112>(v); v += dpp_mov<0x114>(v); v += dpp_mov<0x118>(v); (void)fr;
    return v;
}
__device__ __forceinline__ float row_suffix16(float v, int fr) {
    v += dpp_mov<0x101>(v); v += dpp_mov<0x102>(v); v += dpp_mov<0x104>(v); v += dpp_mov<0x108>(v); (void)fr;
    return v;
}

enum EpiMode { EM_IN = 0, EM_C1A = 1, EM_C1B = 2, EM_C2 = 3, EM_C3 = 4, EM_C4 = 5 };
template <int MODE> struct EpiAll {
    static constexpr bool PERM = true, AFTER_DRAIN = false;
    static constexpr int mode = MODE; unsigned char* ws; float* out; const float* x; const float* gain; const float* gfin;
    __device__ __forceinline__ void operator()(const f32x4 (&acc)[2][2][4][2], const Unit& u, int wr, int wc, int fr, int fq) const {
        const int pn = u.pn;
        const int row0 = u.pm * BM + wr * 64 + fr;
#define EP_B(off) ((bf16_t*)(ws + (off)))
#define EP_F(off) ((float*)(ws + (off)))
        bf16_t* const QNA = EP_B(WS_QNA); bf16_t* const KNA = EP_B(WS_KNA); bf16_t* const VT = EP_B(WS_VT); bf16_t* const QF = EP_B(WS_QF); bf16_t* const QB = EP_B(WS_QB); bf16_t* const KF = EP_B(WS_KF); bf16_t* const KB = EP_B(WS_KB);
        bf16_t* const KFT = EP_B(WS_KFT); bf16_t* const KBT = EP_B(WS_KBT); bf16_t* const VHT = EP_B(WS_VHT); bf16_t* const GHG = EP_B(WS_GHG); float* const GF = EP_F(WS_GF); float* const GB = EP_F(WS_GB); const float* const LB = EP_F(WS_LB);
        bf16_t* const SNA = (bf16_t*)out; bf16_t* const SHG = (bf16_t*)out + (size_t)M * D;
        bf16_t* const T = EP_B(WS_T); bf16_t* const MIX = EP_B(WS_MIX); bf16_t* const H1B = EP_B(WS_XN); bf16_t* const U = EP_B(WS_U); float* const ssq1 = EP_F(WS_SSQ1); float* const ssq2 = EP_F(WS_SSQ2);
#undef EP_B
#undef EP_F
        const int cl0 = wc * 32 + 8 * fq;
        if (mode == EM_IN) {
            if (pn < 4) {
                bf16_t* base = (pn < 2) ? QNA : KNA; const float sc = (pn < 2) ? 0.125f : 1.0f; const int colt = (pn & 1) * 256 + cl0;
#pragma unroll
                for (int ai = 0; ai < 2; ++ai)
#pragma unroll
                    for (int m = 0; m < 4; ++m) { bf16_t* rowp = base + (size_t)(row0 + ai * HALF + m * 16) * 512 + colt;
#pragma unroll
                        for (int bj = 0; bj < 2; ++bj) { const f32x4 v0 = acc[ai][bj][m][0] * sc, v1 = acc[ai][bj][m][1] * sc; u32x4 w;
                            w.x = cvt_pk_bf16(v0[0], v0[1]); w.y = cvt_pk_bf16(v0[2], v0[3]); w.z = cvt_pk_bf16(v1[0], v1[1]); w.w = cvt_pk_bf16(v1[2], v1[3]);
                            *(u32x4*)(rowp + bj * HALF) = w; } }
            } else if (pn < 6) {
                const int colt = (pn - 4) * 256 + cl0;
#pragma unroll
                for (int ai = 0; ai < 2; ++ai)
#pragma unroll
                    for (int m = 0; m < 4; ++m) { const int row = row0 + ai * HALF + m * 16; const int b = row >> 11, t = row & 2047, r = t >> 6, c = t & 63;
#pragma unroll
                        for (int bj = 0; bj < 2; ++bj) { const int col = colt + bj * HALF; const int h = col >> 6, d0 = col & 63;
                            bf16_t* bp = VT + ((((size_t)(b * 8 + h) * 32 + r) * 64 + d0) * 64 + c);
#pragma unroll
                            for (int n = 0; n < 2; ++n)
#pragma unroll
                                for (int j = 0; j < 4; ++j) bp[(4 * n + j) * 64] = f2bf(acc[ai][bj][m][n][j]); } }
            } else if (pn < 14) {
                const int ch0 = (pn - 6) * 64 + wc * 16 + fq * 4;
                const f32x4 lbf = *(const f32x4*)(LB + ch0), lbb = *(const f32x4*)(LB + 512 + ch0);
#pragma unroll
                for (int ai = 0; ai < 2; ++ai)
#pragma unroll
                    for (int m = 0; m < 4; ++m) { const int row = row0 + ai * HALF + m * 16; const int chunk = row >> 4;
                        const f32x4 q = acc[ai][0][m][0], zf = acc[ai][0][m][1], zb = acc[ai][1][m][0], iv = acc[ai][1][m][1];
                        float qfv[4], kfv[4], qbv[4], kbv[4]; f32x4 gfv, gbv;
#pragma unroll
                        for (int j = 0; j < 4; ++j) {
                            const float qs = q[j] * sigm(q[j]);
                            const float ff = lbf[j] + (1.0f - lbf[j]) * sigm(zf[j]);
                            const float fb = lbb[j] + (1.0f - lbb[j]) * sigm(zb[j]);
                            const float bf_ = row_prefix16(__builtin_amdgcn_logf(ff) * 0.69314718056f, fr), bb_ = row_suffix16(__builtin_amdgcn_logf(fb) * 0.69314718056f, fr);
                            const float ef = __expf(bf_), eb = __expf(bb_);
                            qfv[j] = qs * ef; kfv[j] = (1.0f - ff) * __expf(-bf_);
                            qbv[j] = qs * eb; kbv[j] = (1.0f - fb) * __expf(-bb_);
                            gfv[j] = ef; gbv[j] = eb;
                        }
                        typedef unsigned u32x2 __attribute__((ext_vector_type(2)));
                        const size_t ro = (size_t)row * 512 + ch0;
                        u32x2 w;
                        w.x = cvt_pk_bf16(qfv[0], qfv[1]); w.y = cvt_pk_bf16(qfv[2], qfv[3]); *(u32x2*)(QF + ro) = w;
                        w.x = cvt_pk_bf16(qbv[0], qbv[1]); w.y = cvt_pk_bf16(qbv[2], qbv[3]); *(u32x2*)(QB + ro) = w;
                        w.x = cvt_pk_bf16(kfv[0], kfv[1]); w.y = cvt_pk_bf16(kfv[2], kfv[3]); *(u32x2*)(KF + ro) = w;
                        w.x = cvt_pk_bf16(kbv[0], kbv[1]); w.y = cvt_pk_bf16(kbv[2], kbv[3]); *(u32x2*)(KB + ro) = w;
                        const size_t to = ((size_t)chunk * 512 + ch0) * 16 + fr;
#pragma unroll
                        for (int j = 0; j < 4; ++j) { KFT[to + j * 16] = f2bf(kfv[j]); KBT[to + j * 16] = f2bf(kbv[j]); VHT[to + j * 16] = f2bf(iv[j]); }
                        if (fr == 15) *(f32x4*)(GF + (size_t)chunk * 512 + ch0) = gfv;
                        if (fr == 0)  *(f32x4*)(GB + (size_t)chunk * 512 + ch0) = gbv;
                    }
            } else if (pn < 16) {
                const int colt = (pn - 14) * 256 + cl0;
#pragma unroll
                for (int bj = 0; bj < 2; ++bj) { const f32x4 g0 = *(const f32x4*)(gain + colt + bj * HALF), g1 = *(const f32x4*)(gain + colt + bj * HALF + 4);
#pragma unroll
                    for (int ai = 0; ai < 2; ++ai)
#pragma unroll
                        for (int m = 0; m < 4; ++m) { f32x4 v0 = acc[ai][bj][m][0], v1 = acc[ai][bj][m][1];
#pragma unroll
                            for (int j = 0; j < 4; ++j) { v0[j] = v0[j] * sigm(v0[j]) * g0[j]; v1[j] = v1[j] * sigm(v1[j]) * g1[j]; }
                            u32x4 w; w.x = cvt_pk_bf16(v0[0], v0[1]); w.y = cvt_pk_bf16(v0[2], v0[3]); w.z = cvt_pk_bf16(v1[0], v1[1]); w.w = cvt_pk_bf16(v1[2], v1[3]);
                            __builtin_nontemporal_store(w, (u32x4*)(GHG + (size_t)(row0 + ai * HALF + m * 16) * 512 + colt + bj * HALF)); } }
            } else {
                bf16_t* base = (pn < 20) ? SNA : SHG; const int colt = ((pn - 16) & 3) * 256 + cl0;
#pragma unroll
                for (int ai = 0; ai < 2; ++ai)
#pragma unroll
                    for (int m = 0; m < 4; ++m)
#pragma unroll
                        for (int bj = 0; bj < 2; ++bj) { f32x4 v0 = acc[ai][bj][m][0], v1 = acc[ai][bj][m][1];
#pragma unroll
                            for (int j = 0; j < 4; ++j) { v0[j] = sigm(v0[j]); v1[j] = sigm(v1[j]); }
                            u32x4 w; w.x = cvt_pk_bf16(v0[0], v0[1]); w.y = cvt_pk_bf16(v0[2], v0[3]); w.z = cvt_pk_bf16(v1[0], v1[1]); w.w = cvt_pk_bf16(v1[2], v1[3]);
                            __builtin_nontemporal_store(w, (u32x4*)(base + (size_t)(row0 + ai * HALF + m * 16) * 1024 + colt + bj * HALF)); }
            }
            return;
        }
        const int colt = (mode == EM_C1A ? (pn & 3) : pn) * BM + cl0;
        if (mode == EM_C1A || mode == EM_C1B) {
            const bool second = (mode == EM_C1B) || (pn >= 4); const int row0c = (mode == EM_C1A) ? (row0 & (M - 1)) : row0;
            const bf16_t* gate = second ? SHG : SNA; bf16_t* dst = second ? MIX : T;
#pragma unroll
            for (int ai = 0; ai < 2; ++ai) {
                u32x4 gv[4][2], tv[4][2];
#pragma unroll
                for (int m = 0; m < 4; ++m)
#pragma unroll
                    for (int bj = 0; bj < 2; ++bj) { const size_t off = (size_t)(row0c + ai * HALF + m * 16) * 1024 + colt + bj * HALF;
                        gv[m][bj] = *(const u32x4*)(gate + off); if (second) tv[m][bj] = *(const u32x4*)(T + off); else tv[m][bj] = (u32x4){0u, 0u, 0u, 0u}; }
#pragma unroll
                for (int m = 0; m < 4; ++m)
#pragma unroll
                    for (int bj = 0; bj < 2; ++bj) { const size_t off = (size_t)(row0c + ai * HALF + m * 16) * 1024 + colt + bj * HALF;
                        const u32x4 g = gv[m][bj], tt = tv[m][bj]; const f32x4 a0 = acc[ai][bj][m][0], a1 = acc[ai][bj][m][1];
                        const float r0 = a0[0] * bflo(g.x) + bflo(tt.x), r1 = a0[1] * bfhi(g.x) + bfhi(tt.x), r2 = a0[2] * bflo(g.y) + bflo(tt.y), r3 = a0[3] * bfhi(g.y) + bfhi(tt.y);
                        const float r4 = a1[0] * bflo(g.z) + bflo(tt.z), r5 = a1[1] * bfhi(g.z) + bfhi(tt.z), r6 = a1[2] * bflo(g.w) + bflo(tt.w), r7 = a1[3] * bfhi(g.w) + bfhi(tt.w);
                        u32x4 w; w.x = cvt_pk_bf16(r0, r1); w.y = cvt_pk_bf16(r2, r3); w.z = cvt_pk_bf16(r4, r5); w.w = cvt_pk_bf16(r6, r7);
                        *(u32x4*)(dst + off) = w; }
            }
        } else if (mode == EM_C4) {
            f32x4 (&hacc)[2][2][4][2] = const_cast<f32x4 (&)[2][2][4][2]>(acc);
#pragma unroll
            for (int ai = 0; ai < 2; ++ai)
#pragma unroll
                for (int mp = 0; mp < 2; ++mp) {
                    f32x4 pre[2][2][2];
#pragma unroll
                    for (int mm = 0; mm < 2; ++mm)
#pragma unroll
                        for (int bj = 0; bj < 2; ++bj) { const size_t off = (size_t)(row0 + ai * HALF + (2 * mp + mm) * 16) * 1024 + colt + bj * HALF;
                            const u32x4 hb = *(const u32x4*)(H1B + off);
                            pre[mm][bj][0] = (f32x4){bflo(hb.x), bfhi(hb.x), bflo(hb.y), bfhi(hb.y)}; pre[mm][bj][1] = (f32x4){bflo(hb.z), bfhi(hb.z), bflo(hb.w), bfhi(hb.w)}; }
#pragma unroll
                    for (int mm = 0; mm < 2; ++mm) { const int m = 2 * mp + mm; const int row = row0 + ai * HALF + m * 16; float s = 0.f;
#pragma unroll
                        for (int bj = 0; bj < 2; ++bj) { const f32x4 h0 = pre[mm][bj][0] + acc[ai][bj][m][0], h1 = pre[mm][bj][1] + acc[ai][bj][m][1];
                            hacc[ai][bj][m][0] = h0; hacc[ai][bj][m][1] = h1;
                            s += (h0[0] * h0[0] + h0[1] * h0[1]) + (h0[2] * h0[2] + h0[3] * h0[3]) + (h1[0] * h1[0] + h1[1] * h1[1]) + (h1[2] * h1[2] + h1[3] * h1[3]); }
                        s += __shfl_xor(s, 16); s += __shfl_xor(s, 32);
                        if (fq == 0) ssq2[(size_t)row * 16 + pn * 4 + wc] = s; }
                    asm volatile("" ::: "memory");
                }
            asm volatile("s_waitcnt vmcnt(0)" ::: "memory");
            __builtin_amdgcn_s_barrier();
            if (threadIdx.x == 0) {
                unsigned* cnt = (unsigned*)(ws + WS_C4CNT) + 16 * u.pm;
                __builtin_amdgcn_fence(__ATOMIC_RELEASE, "agent");
                asm volatile("s_waitcnt vmcnt(0)" ::: "memory");
                __hip_atomic_fetch_add(cnt, 1u, __ATOMIC_RELAXED, __HIP_MEMORY_SCOPE_AGENT);
                unsigned spins = 0;
                while (__hip_atomic_load(cnt, __ATOMIC_RELAXED, __HIP_MEMORY_SCOPE_AGENT) < 4u) { __builtin_amdgcn_s_sleep(2); if (++spins > (1u << 22)) break; }
                __builtin_amdgcn_fence(__ATOMIC_ACQUIRE, "agent");
                asm volatile("s_waitcnt vmcnt(0)" ::: "memory");
            }
            __builtin_amdgcn_s_barrier();
            asm volatile("" ::: "memory");
            const f32x4 gA0 = *(const f32x4*)(gfin + colt), gA1 = *(const f32x4*)(gfin + colt + 4), gB0 = *(const f32x4*)(gfin + colt + HALF), gB1 = *(const f32x4*)(gfin + colt + HALF + 4);
#pragma unroll
            for (int ai = 0; ai < 2; ++ai)
#pragma unroll
                for (int mp = 0; mp < 2; ++mp) {
                    f32x4 pp[2][4];
#pragma unroll
                    for (int mm = 0; mm < 2; ++mm)
#pragma unroll
                        for (int q = 0; q < 4; ++q) pp[mm][q] = *(const f32x4*)(ssq2 + (size_t)(row0 + ai * HALF + (2 * mp + mm) * 16) * 16 + 4 * q);
#pragma unroll
                    for (int mm = 0; mm < 2; ++mm) { const int m = 2 * mp + mm; const int row = row0 + ai * HALF + m * 16; const size_t off = (size_t)row * 1024 + colt;
                        const f32x4 p0 = pp[mm][0], p1 = pp[mm][1], p2 = pp[mm][2], p3 = pp[mm][3];
                        const float rs = rsqrtf(((((p0[0] + p0[1]) + (p0[2] + p0[3])) + ((p1[0] + p1[1]) + (p1[2] + p1[3]))) + (((p2[0] + p2[1]) + (p2[2] + p2[3])) + ((p3[0] + p3[1]) + (p3[2] + p3[3])))) * (1.0f / 1024.0f) + 1e-6f);
                        *(f32x4*)(out + off) = acc[ai][0][m][0] * rs * gA0; *(f32x4*)(out + off + 4) = acc[ai][0][m][1] * rs * gA1;
                        *(f32x4*)(out + off + HALF) = acc[ai][1][m][0] * rs * gB0; *(f32x4*)(out + off + HALF + 4) = acc[ai][1][m][1] * rs * gB1; }
                    asm volatile("" ::: "memory");
                }
        } else if (mode == EM_C2) {
            const float* base = (mode == EM_C2) ? x : (const float*)out; float* ssq = (mode == EM_C2) ? ssq1 : ssq2;
#pragma unroll
            for (int ai = 0; ai < 2; ++ai) {
                f32x4 pre[4][2][2];
#pragma unroll
                for (int m = 0; m < 4; ++m)
#pragma unroll
                    for (int bj = 0; bj < 2; ++bj) { const size_t off = (size_t)(row0 + ai * HALF + m * 16) * 1024 + colt + bj * HALF;
                        pre[m][bj][0] = __builtin_nontemporal_load((const f32x4*)(base + off)); pre[m][bj][1] = __builtin_nontemporal_load((const f32x4*)(base + off + 4)); }
#pragma unroll
                for (int m = 0; m < 4; ++m) { const int row = row0 + ai * HALF + m * 16; float s = 0.f;
#pragma unroll
                    for (int bj = 0; bj < 2; ++bj) { const size_t off = (size_t)row * 1024 + colt + bj * HALF;
                        const f32x4 h0 = pre[m][bj][0] + acc[ai][bj][m][0], h1 = pre[m][bj][1] + acc[ai][bj][m][1];
                        s += (h0[0] * h0[0] + h0[1] * h0[1]) + (h0[2] * h0[2] + h0[3] * h0[3]) + (h1[0] * h1[0] + h1[1] * h1[1]) + (h1[2] * h1[2] + h1[3] * h1[3]);
                        if (mode == EM_C2) { u32x4 w; w.x = cvt_pk_bf16(h0[0], h0[1]); w.y = cvt_pk_bf16(h0[2], h0[3]); w.z = cvt_pk_bf16(h1[0], h1[1]); w.w = cvt_pk_bf16(h1[2], h1[3]);
                            *(u32x4*)(H1B + off) = w; } }
                    s += __shfl_xor(s, 16); s += __shfl_xor(s, 32);
                    if (fq == 0) ssq[(size_t)row * 16 + pn * 4 + wc] = s; }
            }
        } else {
#pragma unroll
            for (int ai = 0; ai < 2; ++ai) {
                f32x4 pp[4][4];
#pragma unroll
                for (int m = 0; m < 4; ++m)
#pragma unroll
                    for (int q = 0; q < 4; ++q) pp[m][q] = *(const f32x4*)(ssq1 + (size_t)(row0 + ai * HALF + m * 16) * 16 + 4 * q);
#pragma unroll
                for (int m = 0; m < 4; ++m) { const int row = row0 + ai * HALF + m * 16;
                    const f32x4 p0 = pp[m][0], p1 = pp[m][1], p2 = pp[m][2], p3 = pp[m][3];
                    const float rs = rsqrtf(((((p0[0] + p0[1]) + (p0[2] + p0[3])) + ((p1[0] + p1[1]) + (p1[2] + p1[3]))) + (((p2[0] + p2[1]) + (p2[2] + p2[3])) + ((p3[0] + p3[1]) + (p3[2] + p3[3])))) * (1.0f / 1024.0f) + 1e-6f);
#pragma unroll
                    for (int bj = 0; bj < 2; ++bj) { f32x4 v0 = acc[ai][bj][m][0] * rs, v1 = acc[ai][bj][m][1] * rs;
#pragma unroll
                        for (int j = 0; j < 4; ++j) { const float a = fmaxf(v0[j], 0.f), b = fmaxf(v1[j], 0.f); v0[j] = a * a; v1[j] = b * b; }
                        u32x4 w; w.x = cvt_pk_bf16(v0[0], v0[1]); w.y = cvt_pk_bf16(v0[2], v0[3]); w.z = cvt_pk_bf16(v1[0], v1[1]); w.w = cvt_pk_bf16(v1[2], v1[3]);
                        *(u32x4*)(U + (size_t)row * 4096 + colt + bj * HALF) = w; } }
            }
        }
    }
};

template <class Epi, class Sched, bool ALIGN_EPI = false, bool SP2 = false>
__device__ __forceinline__ void gemm_phase(PG8_LAS unsigned char* lds, const Gemm g, const Sched& S, const Epi& E) {
    int tid_ = threadIdx.x; asm volatile("" : "+v"(tid_));
    const int tid = tid_, wid = __builtin_amdgcn_readfirstlane(tid >> 6), lane = tid & 63, wr = wid >> 2, wc = wid & 3, fr = lane & 15, fq = lane >> 4;
    const int K = g.K, nt = K / BK;
    unsigned voffA[2], voffB[2];
#pragma unroll
    for (int i = 0; i < 2; ++i) { int R, C; stage_rc(tid * 16 + i * 8192, R, C); const int Rb = Epi::PERM ? ((R & ~31) + perm32(R & 31)) : R;
        voffA[i] = (unsigned)(R * K + C) * 2u; voffB[i] = (unsigned)(Rb * K + C) * 2u; }
    const size_t kstep = (size_t)(BK * 2);
    const size_t hstep = (size_t)HALF * K * 2;
    const size_t tstep = 2 * hstep;
    const unsigned ldsw = (unsigned)wid * 1024u;
    const int aoff = lds_byte(wr * 64 + fr, fq * 8), boff = lds_byte(wc * 32 + fr, fq * 8);
#define PG8_SA(b, h) (((b) * 2 + (h)) * HTB)
#define PG8_SB(b, h) ((4 + (b) * 2 + (h)) * HTB)
#define PG8_STAGE(bufoff, gbase, voff) do { _Pragma("unroll") for (int _i = 0; _i < 2; ++_i) \
        __builtin_amdgcn_global_load_lds((const unsigned*)((const char*)(gbase) + (voff)[_i]), (PG8_LAS unsigned*)(lds + (bufoff) + ldsw + _i * 8192), 16, 0, 0); } while (0)
#define PG8_LDA(dst, b, h) do { _Pragma("unroll") for (int m = 0; m < 4; ++m) _Pragma("unroll") for (int k = 0; k < 2; ++k) dst[m][k] = *(const PG8_LAS bf16x8*)(lds + PG8_SA(b, h) + aoff + m * 2048 + k * 1024); } while (0)
#define PG8_LDB(dst, b, h) do { _Pragma("unroll") for (int n = 0; n < 2; ++n) _Pragma("unroll") for (int k = 0; k < 2; ++k) dst[n][k] = *(const PG8_LAS bf16x8*)(lds + PG8_SB(b, h) + boff + n * 2048 + k * 1024); } while (0)
#define PG8_MMA(ai, bj, At, Bt) do { __builtin_amdgcn_s_setprio(1); _Pragma("unroll") for (int m = 0; m < 4; ++m) _Pragma("unroll") for (int n = 0; n < 2; ++n) _Pragma("unroll") for (int k = 0; k < 2; ++k) \
        acc[ai][bj][m][n] = __builtin_amdgcn_mfma_f32_16x16x32_bf16(Bt[n][k], At[m][k], acc[ai][bj][m][n], 0, 0, 0); __builtin_amdgcn_s_setprio(0); } while (0)
#define PG8_WAIT_V(n) asm volatile("s_waitcnt vmcnt(" #n ")" ::: "memory")
#define PG8_WAIT_L(n) asm volatile("s_waitcnt lgkmcnt(" #n ")" ::: "memory")
#define PG8_BAR __builtin_amdgcn_s_barrier()
#define PG8_SCHED __builtin_amdgcn_sched_barrier(0)
    Unit cur, nxt; int ui = 0;
    if (!S.next(0, cur)) return;
    f32x4 acc[2][2][4][2];
#pragma unroll
    for (int a = 0; a < 2; ++a)
#pragma unroll
        for (int b = 0; b < 2; ++b)
#pragma unroll
            for (int m = 0; m < 4; ++m)
#pragma unroll
                for (int n = 0; n < 2; ++n) acc[a][b][m][n] = (f32x4){0.f, 0.f, 0.f, 0.f};
    bf16x8 At[4][2], B0[2][2], B1[2][2];
    const char* cA = (const char*)g.A + (size_t)cur.pm * tstep; const char* cB = (const char*)g.Bt + (size_t)cur.pn * tstep;
    S.a_ready(cur);
    if constexpr (SP2) {
        PG8_STAGE(PG8_SB(0, 0), cB, voffB); PG8_STAGE(PG8_SB(0, 1), cB + hstep, voffB); PG8_STAGE(PG8_SA(0, 0), cA, voffA); PG8_STAGE(PG8_SA(0, 1), cA + hstep, voffA);
        if (wr == 1) PG8_BAR;
        PG8_WAIT_V(2); PG8_BAR;
        PG8_STAGE(PG8_SB(1, 0), cB + kstep, voffB); PG8_STAGE(PG8_SA(1, 0), cA + kstep, voffA); PG8_STAGE(PG8_SB(1, 1), cB + hstep + kstep, voffB);
        PG8_WAIT_V(6); PG8_BAR;
    } else {
        PG8_STAGE(PG8_SB(0, 0), cB, voffB); PG8_STAGE(PG8_SA(0, 0), cA, voffA); PG8_STAGE(PG8_SB(0, 1), cB + hstep, voffB); PG8_STAGE(PG8_SA(0, 1), cA + hstep, voffA);
        if (wr == 1) PG8_BAR;
        PG8_WAIT_V(4); PG8_BAR;
        PG8_STAGE(PG8_SB(1, 0), cB + kstep, voffB); PG8_STAGE(PG8_SA(1, 0), cA + kstep, voffA); PG8_STAGE(PG8_SB(1, 1), cB + hstep + kstep, voffB);
        PG8_WAIT_V(6); PG8_BAR;
    }
    for (;;) {
        const bool has_next = S.next(ui + 1, nxt);
        const char* nA = has_next ? (const char*)g.A + (size_t)nxt.pm * tstep : cA; const char* nB = has_next ? (const char*)g.Bt + (size_t)nxt.pn * tstep : cB;
        for (int t = 0; t < nt; t += 2) {
            const bool last = (t == nt - 2);
            const char* a1 = cA + (size_t)(t + 1) * kstep;
            const char* a2 = last ? nA : cA + (size_t)(t + 2) * kstep; const char* b2 = last ? nB : cB + (size_t)(t + 2) * kstep;
            const char* a3 = a2 + kstep; const char* b3 = b2 + kstep;
            if (last && has_next) S.a_ready(nxt);
            if constexpr (SP2) {
            PG8_LDB(B0, 0, 0); PG8_LDB(B1, 0, 1); PG8_SCHED; PG8_LDA(At, 0, 0); PG8_STAGE(PG8_SA(1, 1), a1 + hstep, voffA);
            PG8_WAIT_V(8); PG8_WAIT_L(0); PG8_BAR; PG8_MMA(0, 0, At, B0); PG8_MMA(0, 1, At, B1); PG8_BAR; PG8_SCHED;
            PG8_LDA(At, 0, 1); PG8_STAGE(PG8_SB(0, 0), b2, voffB); PG8_STAGE(PG8_SB(0, 1), b2 + hstep, voffB); PG8_STAGE(PG8_SA(0, 0), a2, voffA);
            PG8_WAIT_V(8); PG8_WAIT_L(0); PG8_BAR; PG8_MMA(1, 0, At, B0); PG8_MMA(1, 1, At, B1); PG8_BAR; PG8_SCHED;
            PG8_LDB(B0, 1, 0); PG8_LDB(B1, 1, 1); PG8_SCHED; PG8_LDA(At, 1, 0); PG8_STAGE(PG8_SA(0, 1), a2 + hstep, voffA);
            PG8_WAIT_V(8); PG8_WAIT_L(0); PG8_BAR; PG8_MMA(0, 0, At, B0); PG8_MMA(0, 1, At, B1); PG8_BAR; PG8_SCHED;
            PG8_LDA(At, 1, 1); PG8_STAGE(PG8_SB(1, 0), b3, voffB); PG8_STAGE(PG8_SB(1, 1), b3 + hstep, voffB); PG8_STAGE(PG8_SA(1, 0), a3, voffA);
            PG8_WAIT_V(8); PG8_WAIT_L(0); PG8_BAR; PG8_MMA(1, 0, At, B0); PG8_MMA(1, 1, At, B1); PG8_BAR; PG8_SCHED;
            } else {
            PG8_LDB(B0, 0, 0); PG8_SCHED; PG8_LDA(At, 0, 0); PG8_STAGE(PG8_SA(1, 1), a1 + hstep, voffA);
            PG8_WAIT_L(8); PG8_BAR; PG8_WAIT_L(0); PG8_MMA(0, 0, At, B0); PG8_BAR; PG8_SCHED;
            PG8_LDB(B1, 0, 1); PG8_STAGE(PG8_SB(0, 0), b2, voffB);
            PG8_BAR; PG8_WAIT_L(0); PG8_MMA(0, 1, At, B1); PG8_BAR;
            PG8_LDA(At, 0, 1); PG8_STAGE(PG8_SA(0, 0), a2, voffA);
            PG8_BAR; PG8_WAIT_L(0); PG8_MMA(1, 0, At, B0); PG8_BAR; PG8_SCHED;
            PG8_STAGE(PG8_SB(0, 1), b2 + hstep, voffB);
            PG8_WAIT_V(6); PG8_BAR; PG8_MMA(1, 1, At, B1); PG8_BAR;
            PG8_LDB(B0, 1, 0); PG8_SCHED; PG8_LDA(At, 1, 0); PG8_STAGE(PG8_SA(0, 1), a2 + hstep, voffA);
            PG8_WAIT_L(8); PG8_BAR; PG8_WAIT_L(0); PG8_MMA(0, 0, At, B0); PG8_BAR; PG8_SCHED;
            PG8_LDB(B1, 1, 1); PG8_STAGE(PG8_SB(1, 0), b3, voffB);
            PG8_BAR; PG8_WAIT_L(0); PG8_MMA(0, 1, At, B1); PG8_BAR;
            PG8_LDA(At, 1, 1); PG8_STAGE(PG8_SA(1, 0), a3, voffA);
            PG8_BAR; PG8_WAIT_L(0); PG8_MMA(1, 0, At, B0); PG8_BAR; PG8_SCHED;
            PG8_STAGE(PG8_SB(1, 1), b3 + hstep, voffB);
            PG8_WAIT_V(6); PG8_BAR; PG8_MMA(1, 1, At, B1); PG8_BAR;
            }
        }
        if constexpr (ALIGN_EPI) { if (wr == 0) PG8_BAR; }
        if constexpr (!Epi::AFTER_DRAIN) { E(acc, cur, wr, wc, fr, fq); S.done(cur); }
        if (!has_next) break;
#pragma unroll
        for (int a = 0; a < 2; ++a)
#pragma unroll
            for (int b = 0; b < 2; ++b)
#pragma unroll
                for (int m = 0; m < 4; ++m)
#pragma unroll
                    for (int n = 0; n < 2; ++n) acc[a][b][m][n] = (f32x4){0.f, 0.f, 0.f, 0.f};
        cur = nxt; cA = nA; cB = nB; ++ui;
        if constexpr (ALIGN_EPI) { if (wr == 1) PG8_BAR; }
    }
    PG8_WAIT_V(0);
    if constexpr (!ALIGN_EPI) { if (wr == 0) PG8_BAR; }
    PG8_BAR;
    if constexpr (Epi::AFTER_DRAIN) { E.fused(acc, cur, wr, wc, fr, fq, lds, wid, lane); S.done(cur); }
#undef PG8_SA
#undef PG8_SB
#undef PG8_STAGE
#undef PG8_LDA
#undef PG8_LDB
#undef PG8_MMA
#undef PG8_WAIT_V
#undef PG8_WAIT_L
#undef PG8_BAR
#undef PG8_SCHED
}
}

#define GAS __attribute__((address_space(1)))
#define LAS __attribute__((address_space(3)))
typedef unsigned short bf16;
typedef unsigned v4u __attribute__((ext_vector_type(4)));
typedef unsigned v2u __attribute__((ext_vector_type(2)));
typedef float f32x4 __attribute__((ext_vector_type(4)));
typedef float f32x2 __attribute__((ext_vector_type(2)));
typedef short bf16x8 __attribute__((ext_vector_type(8)));
typedef short s16x4 __attribute__((ext_vector_type(4)));
using pg8::f2bf; using pg8::cvt_pk_bf16; using pg8::bflo; using pg8::bfhi;


__device__ __forceinline__ float wave_sum(float v) {
#pragma unroll
    for (int o = 1; o < 64; o <<= 1) v += __shfl_xor(v, o);
    return v;
}
__device__ __forceinline__ unsigned pk2(float lo, float hi) { return (unsigned)f2bf(lo) | ((unsigned)f2bf(hi) << 16); }

#define XB_TMO      128
#define XB_XCNT(j)  (256  + 64 * (j))
#define XB_XSUB(j)  (1280 + 64 * (j))
#define XB_XGEN(j)  (2304 + 64 * (j))
#define XB_TOP      3328
#define XB_TOPGEN   3392
#define XCD_BAR_WORDS 3456
#define XB_SPIN_CAP (1u << 18)

__device__ __forceinline__ unsigned xb_ld(unsigned* p)              { return __hip_atomic_load(p, __ATOMIC_RELAXED, __HIP_MEMORY_SCOPE_AGENT); }
__device__ __forceinline__ unsigned xb_add(unsigned* p, unsigned v) { return __hip_atomic_fetch_add(p, v, __ATOMIC_RELAXED, __HIP_MEMORY_SCOPE_AGENT); }
__device__ __forceinline__ unsigned xb_xcc_id() { return (unsigned)__builtin_amdgcn_s_getreg((3 << 11) | 20) & 0xFu; }
#define XB_SPIN(cond, bar) do { unsigned _sp = 0; while (cond) { __builtin_amdgcn_s_sleep(1); \
    if ((++_sp & 255u) == 0u) { if (xb_ld(&(bar)[XB_TMO])) break; if (_sp > XB_SPIN_CAP) { atomicAdd(&(bar)[XB_TMO], 1u); break; } } } } while (0)

struct XcdBarrier {
    unsigned* bar; unsigned x;
    volatile LAS unsigned* st;
};

__device__ __forceinline__ XcdBarrier xcd_barrier_post(unsigned* bar, volatile LAS unsigned* st) {
    XcdBarrier b; b.bar = bar; b.x = xb_xcc_id(); b.st = st;
    if (threadIdx.x == 0) (void)xb_add(&bar[XB_XCNT(b.x)], 1u);
    return b;
}
__device__ __forceinline__ void xcd_barrier_complete(unsigned* bar, unsigned x, unsigned& nloc, unsigned& nx) {
    const unsigned G = gridDim.x * gridDim.y * gridDim.z;
    unsigned sum, cnt, mine, sp = 0u;
    for (;;) {
        sum = 0u; cnt = 0u; mine = 0u;
#pragma unroll
        for (unsigned j = 0; j < 16; ++j) { const unsigned c = xb_ld(&bar[XB_XCNT(j)]); sum += c; cnt += (c > 0u) ? 1u : 0u; mine = (j == x) ? c : mine; }
        if (sum == G) break;
        __builtin_amdgcn_s_sleep(1);
        if ((++sp & 255u) == 0u) { if (xb_ld(&bar[XB_TMO])) break; if (sp > XB_SPIN_CAP) { atomicAdd(&bar[XB_TMO], 1u); break; } }
    }
    nloc = mine > 0u ? mine : 1u; nx = cnt > 0u ? cnt : 1u;
}

__device__ __forceinline__ void xcd_barrier(const XcdBarrier& b) {
    asm volatile("s_waitcnt vmcnt(0)" ::: "memory");
    __syncthreads();
    if (threadIdx.x == 0) {
        unsigned* bar = b.bar;
        __builtin_amdgcn_s_waitcnt(0);
        unsigned nloc = b.st[0], nx = b.st[1];
        if (nloc == 0u) { xcd_barrier_complete(bar, b.x, nloc, nx); b.st[0] = nloc; b.st[1] = nx; }
        const unsigned old = xb_add(&bar[XB_XSUB(b.x)], 1u);
        const unsigned gen = old / nloc;
        if (old + 1u == (gen + 1u) * nloc) {
            __builtin_amdgcn_fence(__ATOMIC_RELEASE, "agent");
            asm volatile("s_waitcnt vmcnt(0)" ::: "memory");
            const unsigned og = xb_add(&bar[XB_TOP], 1u);
            const unsigned tg = og / nx;
            if (og + 1u == (tg + 1u) * nx) xb_add(&bar[XB_TOPGEN], 1u);
            else XB_SPIN(xb_ld(&bar[XB_TOPGEN]) == tg, bar);
            __builtin_amdgcn_fence(__ATOMIC_ACQUIRE, "agent");
            xb_add(&bar[XB_XGEN(b.x)], 1u);
            asm volatile("s_waitcnt vmcnt(0)" ::: "memory");
        } else {
            XB_SPIN(xb_ld(&bar[XB_XGEN(b.x)]) == gen, bar);
            __builtin_amdgcn_fence(__ATOMIC_ACQUIRE, "agent");
            asm volatile("s_waitcnt vmcnt(0)" ::: "memory");
        }
    }
    __syncthreads();
}

#define XL_SUB(j) (5120 + 64 * (j))
#define XL_GEN(j) (5632 + 64 * (j))
__device__ __forceinline__ void xcd_local_barrier(const XcdBarrier& b) {
    asm volatile("s_waitcnt vmcnt(0)" ::: "memory");
    __syncthreads();
    if (threadIdx.x == 0) {
        unsigned* bar = b.bar; const unsigned nloc = b.st[0];
        const unsigned old = xb_add(&bar[XL_SUB(b.x)], 1u), gen = old / nloc;
        if (old + 1u == (gen + 1u) * nloc) xb_add(&bar[XL_GEN(b.x)], 1u);
        else XB_SPIN(xb_ld(&bar[XL_GEN(b.x)]) == gen, bar);
        __builtin_amdgcn_fence(__ATOMIC_ACQUIRE, "agent");
        asm volatile("s_waitcnt vmcnt(0)" ::: "memory");
    }
    __syncthreads();
}
constexpr size_t WS_BAR = 768 * KiB, BAR_BYTES = 24 * KiB;
struct Args { const float* in[14]; float* out; unsigned char* ws; };

template <class CM>
__device__ __forceinline__ void tr_item(const float* W, int K, int N, bf16* WT, const float* kscale, LAS float* scr, int item, int lane, CM cmap) {
    const int nblk = N / 32, kb = item / nblk, nb = item % nblk, k0 = 64 * kb, n0 = 32 * nb;
    const int src = cmap(n0 + (lane & 31));
    float tv[32];
#pragma unroll
    for (int i = 0; i < 32; ++i) tv[i] = __builtin_nontemporal_load(W + (size_t)(k0 + 2 * i + (lane >> 5)) * N + src);
#pragma unroll
    for (int i = 0; i < 32; ++i) { const int kk = 2 * i + (lane >> 5); float v = tv[i]; if (kscale) v *= kscale[k0 + kk]; scr[kk * 33 + (lane & 31)] = v; }
    asm volatile("s_waitcnt lgkmcnt(0)" ::: "memory");
    const int c = lane & 7;
#pragma unroll
    for (int j = 0; j < 4; ++j) { const int n = (lane >> 3) + 8 * j; const LAS float* s = scr + (8 * c) * 33 + n;
        v4u o; o.x = pk2(s[0 * 33], s[1 * 33]); o.y = pk2(s[2 * 33], s[3 * 33]); o.z = pk2(s[4 * 33], s[5 * 33]); o.w = pk2(s[6 * 33], s[7 * 33]);
        *(v4u*)(WT + (size_t)(n0 + n) * K + k0 + 8 * c) = o; }
    asm volatile("s_waitcnt lgkmcnt(0)" ::: "memory");
}
struct CmId { __device__ __forceinline__ int operator()(int n) const { return n; } };
struct CmIn {
    __device__ __forceinline__ int operator()(int n) const {
        if (n < 1536 || n >= 3584) return n;
        const int q = n - 1536, j = q >> 8, cl = q & 255;
        const int sel = 2 * (cl >> 7) + ((cl >> 2) & 1), ch = 64 * j + 16 * ((cl >> 5) & 3) + 4 * ((cl >> 3) & 3) + (cl & 3);
        return 1536 + 512 * sel + ch;
    }
};

struct HgOps { s16x4 vb[2]; s16x4 ka[8]; f32x4 g[8]; };
__device__ __forceinline__ void hg_load(HgOps& o, const bf16* KT, const bf16* VTt, const float* G, unsigned cb, int vq, int lm, int kq) {
#pragma unroll
    for (int vt = 0; vt < 2; ++vt) o.vb[vt] = *(const s16x4*)(VTt + (unsigned)((cb + 32 * vq + 16 * vt + lm) * 16 + 4 * kq));
#pragma unroll
    for (int kt = 0; kt < 8; ++kt) { o.ka[kt] = *(const s16x4*)(KT + (unsigned)((cb + 16 * kt + lm) * 16 + 4 * kq)); o.g[kt] = *(const f32x4*)(G + (unsigned)(cb + 16 * kt + 4 * kq)); }
}
template <bool TRACKD>
__device__ __forceinline__ void hg_apply(f32x4 (&S)[8][2], f32x4 (&Dp)[8], const HgOps& o) {
#pragma unroll
    for (int kt = 0; kt < 8; ++kt) {
#pragma unroll
        for (int vt = 0; vt < 2; ++vt) { S[kt][vt] = __builtin_amdgcn_mfma_f32_16x16x16bf16_1k(o.ka[kt], o.vb[vt], S[kt][vt], 0, 0, 0); S[kt][vt] = S[kt][vt] * o.g[kt]; }
        if (TRACKD) Dp[kt] = Dp[kt] * o.g[kt];
    }
}
template <bool TRACKD>
__device__ __forceinline__ void hg_update(f32x4 (&S)[8][2], f32x4 (&Dp)[8], const bf16* KT, const bf16* VTt, const float* G, unsigned cb, int vq, int lm, int kq) {
    HgOps o; hg_load(o, KT, VTt, G, cb, vq, lm, kq); hg_apply<TRACKD>(S, Dp, o);
}

__global__ void __launch_bounds__(NWAVES * 64, 2) mk_fwd(Args args) {
    extern __shared__ __attribute__((aligned(16))) unsigned char lds_raw[];
    LAS unsigned char* lds = (LAS unsigned char*)lds_raw;
    const int tid = threadIdx.x, lane = tid & 63, wave = __builtin_amdgcn_readfirstlane(tid >> 6);
    const int G = gridDim.x, bx = blockIdx.x;
    const int gw = bx * NWAVES + wave, NGW = G * NWAVES;
    const int lm = lane & 15, kq = lane >> 4;
    unsigned char* ws = args.ws;
    if (tid < 16) ((LAS unsigned*)(lds + LDS_CTL))[tid] = 0u;
    __syncthreads();
    const XcdBarrier bar = xcd_barrier_post((unsigned*)(ws + WS_BAR), (volatile LAS unsigned*)(lds + LDS_CTL + 32));
    if (tid == 0) ((LAS unsigned*)(lds + LDS_CTL))[0] = xb_add((unsigned*)(ws + WS_BAR) + 3520 + 64 * bar.x, 1u);
    __syncthreads();
    const unsigned my_rank = ((volatile LAS unsigned*)(lds + LDS_CTL))[0];
    const float* x = args.in[0]; const float* meta = args.in[1]; const float* w_in = args.in[2]; const float* w_na = args.in[3]; const float* w_hg = args.in[4];
    const float* w_o = args.in[5]; const float* w_up = args.in[6]; const float* w_dn = args.in[7]; const float* g_mix = args.in[8]; const float* g_mlp = args.in[9];
    const float* g_fin = args.in[10]; const float* hg_gain = args.in[11]; const float* rpb = args.in[12]; const float* lb_logits = args.in[13];
    float* out = args.out;
    float* ssq1 = (float*)(ws + WS_SSQ1); float* ssq2 = (float*)(ws + WS_SSQ2);
    bf16* KNAm = (bf16*)(ws + WS_KNAM); bf16* VTm = (bf16*)(ws + WS_VTM); bf16* KFTm = (bf16*)(ws + WS_KFTM); bf16* VHTm = (bf16*)(ws + WS_VHTM);
    float* GFm = (float*)(ws + WS_GFM); float* LB = (float*)(ws + WS_LB); float* DSEG = (float*)(ws + WS_DSEG);
    bf16* WT_in = (bf16*)(ws + WS_WIN); bf16* WT_na = (bf16*)(ws + WS_WNA); bf16* WT_hg = (bf16*)(ws + WS_WHG); bf16* WT_o = (bf16*)(ws + WS_WO); bf16* WT_up = (bf16*)(ws + WS_WUP); bf16* WT_dn = (bf16*)(ws + WS_WDN);
    bf16* XN = (bf16*)(ws + WS_XN); float* SBUF = (float*)(ws + WS_XN); bf16* H1B = (bf16*)(ws + WS_XN);
    bf16* QNA = (bf16*)(ws + WS_QNA); bf16* KNA = (bf16*)(ws + WS_KNA); bf16* VT = (bf16*)(ws + WS_VT); bf16* QF = (bf16*)(ws + WS_QF); bf16* QB = (bf16*)(ws + WS_QB);
    bf16* KF = (bf16*)(ws + WS_KF); bf16* KFT = (bf16*)(ws + WS_KFT); bf16* KB = (bf16*)(ws + WS_KB); bf16* KBT = (bf16*)(ws + WS_KBT); bf16* VHT = (bf16*)(ws + WS_VHT);
    bf16* GHG = (bf16*)(ws + WS_GHG); float* GF = (float*)(ws + WS_GF); float* GB = (float*)(ws + WS_GB);
    bf16* SNA = (bf16*)out; bf16* SHG = (bf16*)out + (size_t)M * D;
    bf16* ONA = QNA; bf16* OHG = (bf16*)(ws + WS_OHG); bf16* Tb = (bf16*)(ws + WS_T); bf16* MIX = (bf16*)(ws + WS_MIX); bf16* U = (bf16*)(ws + WS_U);

    {
        f32x4 xv0[4][4];
#pragma unroll
        for (int q = 0; q < 4; ++q)
#pragma unroll
            for (int j = 0; j < 4; ++j) xv0[q][j] = __builtin_nontemporal_load((const f32x4*)(x + (size_t)(gw + q * NGW) * D + 4 * lane + 256 * j));
        {
            LAS float* mT = (LAS float*)lds;
            LAS float* red = (LAS float*)(lds + 65536);
            LAS float* fin = (LAS float*)(lds + 65536 + 32768);
#pragma unroll
            for (int rr = 0; rr < 2; ++rr) { const int r = 2 * wave + rr; const float* mr = meta + (size_t)r * D;
                f32x4 v[4]; float s = 0.f;
#pragma unroll
                for (int j = 0; j < 4; ++j) { v[j] = *(const f32x4*)(mr + 4 * lane + 256 * j); s += (v[j].x * v[j].x + v[j].y * v[j].y) + (v[j].z * v[j].z + v[j].w * v[j].w); }
                const float rs = rsqrtf(wave_sum(s) * (1.0f / D) + EPS);
#pragma unroll
                for (int j = 0; j < 4; ++j) { const f32x4 g = *(const f32x4*)(g_mix + 4 * lane + 256 * j); const int k = 4 * lane + 256 * j;
                    mT[(k + 0) * 16 + r] = v[j].x * rs * g.x; mT[(k + 1) * 16 + r] = v[j].y * rs * g.y; mT[(k + 2) * 16 + r] = v[j].z * rs * g.z; mT[(k + 3) * 16 + r] = v[j].w * rs * g.w; } }
            __syncthreads();
            for (int cbk = bx; cbk < 256; cbk += G) {
                const int c = tid & 7, ks = tid >> 3, grp = cbk >> 6, cl0 = (cbk & 63) * 8;
                const int src = (grp == 0 ? 512 : grp == 1 ? 1024 : grp == 2 ? 2048 : 3072) + cl0 + c;
                float a[16];
#pragma unroll
                for (int r = 0; r < 16; ++r) a[r] = 0.f;
                float wv[16];
#pragma unroll
                for (int kk = 0; kk < 16; ++kk) wv[kk] = w_in[(size_t)(ks * 16 + kk) * NIN + src];
#pragma unroll
                for (int kk = 0; kk < 16; ++kk) { const int k = ks * 16 + kk; const float w = wv[kk];
                    const f32x4 m0 = *(const LAS f32x4*)(mT + k * 16), m1 = *(const LAS f32x4*)(mT + k * 16 + 4), m2 = *(const LAS f32x4*)(mT + k * 16 + 8), m3 = *(const LAS f32x4*)(mT + k * 16 + 12);
                    a[0] += w * m0.x; a[1] += w * m0.y; a[2] += w * m0.z; a[3] += w * m0.w; a[4] += w * m1.x; a[5] += w * m1.y; a[6] += w * m1.z; a[7] += w * m1.w;
                    a[8] += w * m2.x; a[9] += w * m2.y; a[10] += w * m2.z; a[11] += w * m2.w; a[12] += w * m3.x; a[13] += w * m3.y; a[14] += w * m3.z; a[15] += w * m3.w; }
#pragma unroll
                for (int r = 0; r < 16; ++r) red[(ks * 16 + r) * 8 + c] = a[r];
                __syncthreads();
                if (tid < 128) { float s = 0.f;
                    for (int q = 0; q < 64; ++q) s += red[q * 128 + tid];
                    fin[tid] = s; }
                __syncthreads();
                if (tid < 8) { const int cl = cl0 + tid;
#pragma unroll
                    for (int r = 0; r < 16; ++r) a[r] = fin[r * 8 + tid];
                    if (grp == 0) {
#pragma unroll
                        for (int r = 0; r < 16; ++r) KNAm[r * 512 + cl] = f2bf(a[r]);
                    } else if (grp == 1) { const int h = cl >> 6, d = cl & 63;
#pragma unroll
                        for (int r = 0; r < 16; ++r) VTm[(h * 64 + d) * 16 + r] = f2bf(a[r]);
                    } else if (grp == 2) {
                        const float l0 = lb_logits[cl], l1 = lb_logits[512 + cl]; const float lb = 1.0f / (1.0f + expf(l1 - l0));
                        float bsum = 0.f;
#pragma unroll
                        for (int r = 0; r < 16; ++r) { const float f = lb + (1.0f - lb) * __builtin_amdgcn_rcpf(1.0f + __expf(-a[r])); bsum += __builtin_amdgcn_logf(f) * 0.69314718056f; KFTm[cl * 16 + r] = f2bf((1.0f - f) * __expf(-bsum)); }
                        GFm[cl] = __expf(bsum);
                    } else {
#pragma unroll
                        for (int r = 0; r < 16; ++r) VHTm[cl * 16 + r] = f2bf(a[r]);
                    }
                }
                __syncthreads();
            }
        }
        for (int i = bx * 4 + tid; tid < 4 && i < 1024; i += G * 4) {
            const int dir = i >> 9, c = i & 511; const float l0 = lb_logits[dir * 1024 + c], l1 = lb_logits[dir * 1024 + 512 + c]; LB[i] = 1.0f / (1.0f + expf(l1 - l0)); }
        LAS float* scr = (LAS float*)(lds + wave * 16384);
        constexpr int I_IN = (D / 64) * (NIN / 32), I_NA = (512 / 64) * (D / 32), I_O = (D / 64) * (D / 32), I_UP = (D / 64) * (FF / 32), I_DN = (FF / 64) * (D / 32);
        constexpr int NITEMS = I_IN + 2 * I_NA + I_O + I_UP + I_DN;
        for (int it = gw; it < NITEMS; it += NGW) {
            int r = it;
            if (r < I_IN) { tr_item(w_in, D, NIN, WT_in, (const float*)nullptr, scr, r, lane, CmIn()); continue; } r -= I_IN;
            if (r < I_NA) { tr_item(w_na, 512, D, WT_na, (const float*)nullptr, scr, r, lane, CmId()); continue; } r -= I_NA;
            if (r < I_NA) { tr_item(w_hg, 512, D, WT_hg, (const float*)nullptr, scr, r, lane, CmId()); continue; } r -= I_NA;
            if (r < I_O) { tr_item(w_o, D, D, WT_o, (const float*)nullptr, scr, r, lane, CmId()); continue; } r -= I_O;
            if (r < I_UP) { tr_item(w_up, D, FF, WT_up, g_mlp, scr, r, lane, CmId()); continue; } r -= I_UP;
            tr_item(w_dn, FF, D, WT_dn, (const float*)nullptr, scr, r, lane, CmId());
        }
        for (int m0 = gw; m0 < M; m0 += 4 * NGW) {
            f32x4 v[4][4];
            if (m0 == gw) {
#pragma unroll
                for (int q = 0; q < 4; ++q)
#pragma unroll
                    for (int j = 0; j < 4; ++j) v[q][j] = xv0[q][j];
            } else {
#pragma unroll
                for (int q = 0; q < 4; ++q)
#pragma unroll
                    for (int j = 0; j < 4; ++j) v[q][j] = __builtin_nontemporal_load((const f32x4*)(x + (size_t)(m0 + q * NGW) * D + 4 * lane + 256 * j));
            }
#pragma unroll
            for (int q = 0; q < 4; ++q) { const int m = m0 + q * NGW; float s = 0.f;
#pragma unroll
                for (int j = 0; j < 4; ++j) s += (v[q][j].x * v[q][j].x + v[q][j].y * v[q][j].y) + (v[q][j].z * v[q][j].z + v[q][j].w * v[q][j].w);
                const float rs = rsqrtf(wave_sum(s) * (1.0f / D) + EPS);
#pragma unroll
                for (int j = 0; j < 4; ++j) { const f32x4 g = *(const f32x4*)(g_mix + 4 * lane + 256 * j);
                    v2u o; o.x = pk2(v[q][j].x * rs * g.x, v[q][j].y * rs * g.y); o.y = pk2(v[q][j].z * rs * g.z, v[q][j].w * rs * g.w);
                    *(v2u*)(XN + (size_t)m * D + 4 * lane + 256 * j) = o; } } }
    }
    xcd_barrier(bar);

    int vb = bx; bool xl = false;
    { const unsigned nloc = ((volatile LAS unsigned*)(lds + LDS_CTL + 32))[0], nx = ((volatile LAS unsigned*)(lds + LDS_CTL + 32))[1];
      bool even = (G == 256 && nloc == 32u && nx == 8u && bar.x < 8u && my_rank < 32u);
#pragma unroll
      for (int j = 0; j < 8; ++j) even = even && (xb_ld((unsigned*)(ws + WS_BAR) + XB_XCNT(j)) == 32u);
      if (even) { vb = (int)(my_rank * 8u + bar.x); xl = true; } }
    vb = __builtin_amdgcn_readfirstlane(vb);
#define PHASE_BAR() do { if (xl) xcd_local_barrier(bar); else xcd_barrier(bar); } while (0)
    const int xq = vb & 7, rk = vb >> 3, lw = rk * 8 + wave;
#define MK_EPI(NAME, MODE) pg8::EpiAll<MODE> NAME; NAME.ws = ws; NAME.out = out; NAME.x = x; NAME.gain = hg_gain; NAME.gfin = g_fin;
    {
        MK_EPI(E, pg8::EM_IN)
        pg8::Gemm g{XN, WT_in, M, NIN, D}; pg8::StaticOrder S; S.init(M, NIN, G, vb);
        pg8::gemm_phase<pg8::EpiAll<pg8::EM_IN>, pg8::StaticOrder, true, true>(lds, g, S, E);
    }
    PHASE_BAR();

    { const int wi = xq * 256 + lw;
        const int item = wi >> 2, vq = wi & 3, seg = item & 7, dir = (item >> 3) & 1, h = (item >> 4) & 3, b = item >> 6;
        f32x4 S[8][2], Dp[8];
#pragma unroll
        for (int kt = 0; kt < 8; ++kt) { S[kt][0] = (f32x4){0.f, 0.f, 0.f, 0.f}; S[kt][1] = (f32x4){0.f, 0.f, 0.f, 0.f}; Dp[kt] = (f32x4){1.f, 1.f, 1.f, 1.f}; }
        if (dir == 0 && seg == 0) hg_update<false>(S, Dp, KFTm, VHTm, GFm, (unsigned)(h * 128), vq, lm, kq);
        const bf16* KTp = dir ? KBT : KFT; const float* Gp = dir ? GB : GF;
        const int cstep = dir ? -512 : 512; const int cb0 = (b * 128 + seg * 16 + (dir ? 15 : 0)) * 512 + h * 128;
        {
            LAS unsigned char* stg0 = lds + (wave >> 2) * 9216;
            s16x4 kv[2][2], vbn[2][2], vbr[2][2]; v2u g8 = (v2u){0u, 0u};
#define B1_LOADS(IT) do { _Pragma("unroll") for (int u = 0; u < 2; ++u) { const unsigned cb_ = (unsigned)(cb0 + (2 * (IT) + u) * cstep); \
                _Pragma("unroll") for (int kk = 0; kk < 2; ++kk) kv[u][kk] = *(const s16x4*)(KTp + (unsigned)((cb_ + 16 * (2 * vq + kk) + lm) * 16 + 4 * kq)); \
                _Pragma("unroll") for (int vt = 0; vt < 2; ++vt) vbn[u][vt] = *(const s16x4*)(VHT + (unsigned)((cb_ + 32 * vq + 16 * vt + lm) * 16 + 4 * kq)); \
                if (vq == u) g8 = *(const v2u*)(Gp + cb_ + 2 * lane); } } while (0)
#define B1_STORE(STG) do { _Pragma("unroll") for (int u = 0; u < 2; ++u) { \
                _Pragma("unroll") for (int kk = 0; kk < 2; ++kk) *(LAS s16x4*)((STG) + (u * 8 + 2 * vq + kk) * 512 + lane * 8) = kv[u][kk]; \
                if (vq == u) *(LAS v2u*)((STG) + 8192 + u * 512 + lane * 8) = g8; } } while (0)
            __syncthreads();
            B1_LOADS(0);
            B1_STORE(stg0);
#pragma unroll
            for (int u = 0; u < 2; ++u) { vbr[u][0] = vbn[u][0]; vbr[u][1] = vbn[u][1]; }
            for (int it = 0; it < 8; ++it) {
                __syncthreads();
                LAS unsigned char* stg = stg0 + (it & 1) * 18432;
                if (it < 7) B1_LOADS(it + 1);
                __builtin_amdgcn_sched_barrier(0);
#pragma unroll
                for (int u = 0; u < 2; ++u)
#pragma unroll
                    for (int kt = 0; kt < 8; ++kt) { const s16x4 ka = *(const LAS s16x4*)(stg + (u * 8 + kt) * 512 + lane * 8); const f32x4 g = *(const LAS f32x4*)(stg + 8192 + u * 512 + (16 * kt + 4 * kq) * 4);
#pragma unroll
                        for (int vt = 0; vt < 2; ++vt) { S[kt][vt] = __builtin_amdgcn_mfma_f32_16x16x16bf16_1k(ka, vbr[u][vt], S[kt][vt], 0, 0, 0); S[kt][vt] = S[kt][vt] * g; }
                        Dp[kt] = Dp[kt] * g; }
                __builtin_amdgcn_sched_barrier(0);
                if (it < 7) { B1_STORE(stg0 + ((it + 1) & 1) * 18432);
#pragma unroll
                    for (int u = 0; u < 2; ++u) { vbr[u][0] = vbn[u][0]; vbr[u][1] = vbn[u][1]; } }
            }
#undef B1_LOADS
#undef B1_STORE
        }
        float* sp = SBUF + ((size_t)(item * 4 + vq) * 16) * 256 + lane * 4;
#pragma unroll
        for (int kt = 0; kt < 8; ++kt) { *(f32x4*)(sp + (kt * 2 + 0) * 256) = S[kt][0]; *(f32x4*)(sp + (kt * 2 + 1) * 256) = S[kt][1]; }
        if (vq == 0 && lm == 0) {
#pragma unroll
            for (int kt = 0; kt < 8; ++kt) *(f32x4*)(DSEG + item * 128 + 16 * kt + 4 * kq) = Dp[kt];
        }
    }
    PHASE_BAR();

    for (int i2 = 0; i2 < 2; ++i2) { const int tl = rk * 512 + tid + 16384 * i2;
        const int bhd = xq * 8 + (tl >> 12), e4 = tl & 4095, dir = bhd & 1; const int kt = (e4 >> 7) & 7, ln = e4 & 63; const int k0 = 16 * kt + 4 * (ln >> 4);
        f32x4 carry = (f32x4){0.f, 0.f, 0.f, 0.f}, locv[8], dv[8];
#pragma unroll
        for (int s = 0; s < 8; ++s) { const int seg = dir ? 7 - s : s, item = bhd * 8 + seg;
            locv[s] = *(const f32x4*)(SBUF + (size_t)item * 16384 + e4 * 4); dv[s] = *(const f32x4*)(DSEG + item * 128 + k0); }
#pragma unroll
        for (int s = 0; s < 8; ++s) { const int seg = dir ? 7 - s : s, item = bhd * 8 + seg;
            *(f32x4*)(SBUF + (size_t)item * 16384 + e4 * 4) = carry; carry = dv[s] * carry + locv[s]; }
    }
    {
        LAS float* rp = (LAS float*)lds;
        __syncthreads();
        if (tid < 465) rp[tid] = rpb[(rk >> 2) * 465 + tid];
        __syncthreads();
        LAS unsigned char* KS = lds + 15360; LAS unsigned char* VS = lds + 15360 + 73728;
        int prev_hi = -1;
        for (int i4 = 0; i4 < 4; ++i4) {
            const int hh = rk >> 2, rg = rk & 3, rpair = 8 * rg + 2 * i4;
            const int cq = wave & 3, r = rpair + (wave >> 2), h = hh, b = xq;
            const int lo = min(max(rpair - 4, 0), 24);
            __syncthreads();
            { const int c = tid >> 3, q = tid & 7;
              if (i4 == 0) {
                v4u kreg[9], vreg[9];
#pragma unroll
                for (int e9 = 0; e9 < 9; ++e9) { const int row = min(lo + e9, 31);
                    kreg[e9] = *(const v4u*)(KNA + ((size_t)b * SEQ + row * 64 + c) * 512 + h * 64 + q * 8);
                    vreg[e9] = *(const v4u*)(VT + ((((size_t)(b * 8 + h) * 32 + row) * 64 + c) * 64 + q * 8)); }
#pragma unroll
                for (int e9 = 0; e9 < 9; ++e9) { const int kk = ((lo + e9) % 9) * 64 + c;
                    *(LAS v4u*)(KS + kk * 128 + ((q ^ (kk & 7)) * 16)) = kreg[e9]; *(LAS v4u*)(VS + kk * 128 + ((q ^ (kk & 7)) * 16)) = vreg[e9]; }
              } else {
                v4u kreg[2], vreg[2];
#pragma unroll
                for (int e2 = 0; e2 < 2; ++e2) { const int row = min(prev_hi + 1 + e2, 31);
                    kreg[e2] = *(const v4u*)(KNA + ((size_t)b * SEQ + row * 64 + c) * 512 + h * 64 + q * 8);
                    vreg[e2] = *(const v4u*)(VT + ((((size_t)(b * 8 + h) * 32 + row) * 64 + c) * 64 + q * 8)); }
#pragma unroll
                for (int e2 = 0; e2 < 2; ++e2) { const int row = prev_hi + 1 + e2;
                    if (row <= lo + 8 && row < 32) { const int kk = (row % 9) * 64 + c;
                        *(LAS v4u*)(KS + kk * 128 + ((q ^ (kk & 7)) * 16)) = kreg[e2]; *(LAS v4u*)(VS + kk * 128 + ((q ^ (kk & 7)) * 16)) = vreg[e2]; } }
              }
            }
            prev_hi = lo + 8;
            __syncthreads();
            const int c0 = 16 * cq, kc0 = (cq == 0) ? 0 : (cq == 1) ? 8 : (cq == 2) ? 24 : 32;
            const int rs0 = min(max(r - 4, 0), 24);
            const size_t rowq = (size_t)b * SEQ + r * 64 + c0 + lm;
            bf16x8 qf[2], kmf[2]; s16x4 vmf[4];
#pragma unroll
            for (int ks = 0; ks < 2; ++ks) { qf[ks] = *(const bf16x8*)(QNA + rowq * 512 + h * 64 + 32 * ks + 8 * kq); kmf[ks] = *(const bf16x8*)(KNAm + lm * 512 + h * 64 + 32 * ks + 8 * kq); }
#pragma unroll
            for (int dt = 0; dt < 4; ++dt) vmf[dt] = *(const s16x4*)(VTm + (h * 64 + 16 * dt + lm) * 16 + 4 * kq);
            const int cqq = c0 + lm, cs = min(max(cqq - 8, 0), 48);
            f32x4 oa[4];
#pragma unroll
            for (int dt = 0; dt < 4; ++dt) oa[dt] = (f32x4){0.f, 0.f, 0.f, 0.f};
            float mrun = -3.0e38f, lsum = 0.f;
#pragma unroll
            for (int hf = 0; hf < 2; ++hf) {
                f32x4 sc[9]; bf16x8 vf[4][4];
                {   bf16x8 kf[4][2][2];
#pragma unroll
                    for (int j4 = 0; j4 < 4; ++j4)
#pragma unroll
                        for (int t = 0; t < 2; ++t) { const int kcol = kc0 + 8 * (lm >> 2) + 4 * t + (lm & 3); const size_t rowk = (size_t)b * SEQ + (rs0 + 4 * hf + j4) * 64 + kcol;
#pragma unroll
                            for (int ks = 0; ks < 2; ++ks) { const int kk = ((rs0 + 4 * hf + j4) % 9) * 64 + kcol; kf[j4][t][ks] = *(const LAS bf16x8*)(KS + kk * 128 + (((ks * 4 + kq) ^ (kk & 7)) * 16)); } (void)rowk; }
                    __builtin_amdgcn_sched_barrier(0);
#pragma unroll
                    for (int j4 = 0; j4 < 4; ++j4)
#pragma unroll
                        for (int t = 0; t < 2; ++t) { f32x4 a = (f32x4){0.f, 0.f, 0.f, 0.f};
#pragma unroll
                            for (int ks = 0; ks < 2; ++ks) a = __builtin_amdgcn_mfma_f32_16x16x32_bf16(kf[j4][t][ks], qf[ks], a, 0, 0, 0);
                            sc[2 * j4 + t] = a; }
                }
                __builtin_amdgcn_sched_barrier(0);
#pragma unroll
                for (int j4 = 0; j4 < 4; ++j4)
#pragma unroll
                    for (int dt = 0; dt < 4; ++dt) { const int vv = ((rs0 + 4 * hf + j4) % 9) * 64 + 16 * dt + lm; vf[j4][dt] = *(const LAS bf16x8*)(VS + vv * 128 + ((((kc0 >> 3) + kq) ^ (vv & 7)) * 16)); }
                __builtin_amdgcn_sched_barrier(0);
                if (hf == 1) { f32x4 a = (f32x4){0.f, 0.f, 0.f, 0.f};
#pragma unroll
                    for (int ks = 0; ks < 2; ++ks) a = __builtin_amdgcn_mfma_f32_16x16x32_bf16(kmf[ks], qf[ks], a, 0, 0, 0);
                    sc[8] = a; } else sc[8] = (f32x4){-1e30f, -1e30f, -1e30f, -1e30f};
                float mx = -3.0e38f;
#pragma unroll
                for (int j4 = 0; j4 < 4; ++j4)
#pragma unroll
                    for (int t = 0; t < 2; ++t)
#pragma unroll
                        for (int j = 0; j < 4; ++j) { const int kcol = kc0 + 8 * kq + 4 * t + j; const bool inw = (kcol >= cs) && (kcol < cs + 16);
                            const int dr = rs0 + 4 * hf + j4 - r, dc = min(max(kcol - cqq, -15), 15);
                            const float bias = rp[(dr + 7) * 31 + dc + 15];
                            const float s = inw ? sc[2 * j4 + t][j] + bias : -1e30f; sc[2 * j4 + t][j] = s; mx = fmaxf(mx, s); }
#pragma unroll
                for (int j = 0; j < 4; ++j) mx = fmaxf(mx, sc[8][j]);
                mx = fmaxf(mx, __shfl_xor(mx, 16)); mx = fmaxf(mx, __shfl_xor(mx, 32));
                const float mnew = fmaxf(mrun, mx), alpha = __expf(mrun - mnew);
                mrun = mnew; lsum *= alpha;
#pragma unroll
                for (int dt = 0; dt < 4; ++dt) oa[dt] = oa[dt] * alpha;
#pragma unroll
                for (int i = 0; i < 9; ++i)
#pragma unroll
                    for (int j = 0; j < 4; ++j) { const float p = __expf(sc[i][j] - mnew); sc[i][j] = p; lsum += p; }
#pragma unroll
                for (int j4 = 0; j4 < 4; ++j4) {
                    union { bf16x8 v; unsigned u[4]; } pf;
                    pf.u[0] = cvt_pk_bf16(sc[2 * j4][0], sc[2 * j4][1]); pf.u[1] = cvt_pk_bf16(sc[2 * j4][2], sc[2 * j4][3]);
                    pf.u[2] = cvt_pk_bf16(sc[2 * j4 + 1][0], sc[2 * j4 + 1][1]); pf.u[3] = cvt_pk_bf16(sc[2 * j4 + 1][2], sc[2 * j4 + 1][3]);
#pragma unroll
                    for (int dt = 0; dt < 4; ++dt) oa[dt] = __builtin_amdgcn_mfma_f32_16x16x32_bf16(vf[j4][dt], pf.v, oa[dt], 0, 0, 0); }
                if (hf == 1) { union { s16x4 v; unsigned u[2]; } pm; pm.u[0] = cvt_pk_bf16(sc[8][0], sc[8][1]); pm.u[1] = cvt_pk_bf16(sc[8][2], sc[8][3]);
#pragma unroll
                    for (int dt = 0; dt < 4; ++dt) oa[dt] = __builtin_amdgcn_mfma_f32_16x16x16bf16_1k(vmf[dt], pm.v, oa[dt], 0, 0, 0); }
            }
            lsum += __shfl_xor(lsum, 16); lsum += __shfl_xor(lsum, 32);
            const float inv = 1.0f / lsum;
#pragma unroll
            for (int dt = 0; dt < 4; ++dt) { v2u o; o.x = cvt_pk_bf16(oa[dt][0] * inv, oa[dt][1] * inv); o.y = cvt_pk_bf16(oa[dt][2] * inv, oa[dt][3] * inv);
                *(v2u*)(ONA + rowq * 512 + h * 64 + 16 * dt + 4 * kq) = o; }
        }
        __syncthreads();
    }
    PHASE_BAR();

    { const int it = xq * 32 + rk;
        const int seg = it & 7, h = (it >> 3) & 3, b = it >> 5;
        const int dir = wave >> 2, vq = wave & 3, sitem = ((b * 4 + h) * 2 + dir) * 8 + seg;
        LAS unsigned short* ob = (LAS unsigned short*)lds;
        LAS unsigned char* stg0 = lds + 65536 + dir * 17408;
        __syncthreads();
        f32x4 S[8][2], Dp[8];
        { const float* sp = SBUF + ((size_t)(sitem * 4 + vq) * 16) * 256 + lane * 4;
#pragma unroll
          for (int kt = 0; kt < 8; ++kt) { S[kt][0] = *(const f32x4*)(sp + (kt * 2 + 0) * 256); S[kt][1] = *(const f32x4*)(sp + (kt * 2 + 1) * 256); Dp[kt] = (f32x4){1.f, 1.f, 1.f, 1.f}; } }
        if (dir == 0 && seg == 0) hg_update<false>(S, Dp, KFTm, VHTm, GFm, (unsigned)(h * 128), vq, lm, kq);
        const bf16* Qn = dir ? QB : QF; const bf16* Kn = dir ? KB : KF; const bf16* KTp = dir ? KBT : KFT; const float* Gp = dir ? GB : GF;
        s16x4 qv[2][2], kv[2][2], vbn[2][2]; v2u g8 = (v2u){0u, 0u};
#define B3_LOADS(IT) do { _Pragma("unroll") for (int u = 0; u < 2; ++u) { const int cl_ = dir ? 15 - (2 * (IT) + u) : 2 * (IT) + u; const size_t cgi_ = (size_t)b * 128 + seg * 16 + cl_, row0_ = cgi_ * 16; const unsigned cb_ = (unsigned)(cgi_ * 512 + h * 128); \
            _Pragma("unroll") for (int kk = 0; kk < 2; ++kk) { const int kt_ = 2 * vq + kk; \
                qv[u][kk] = *(const s16x4*)(Qn + (row0_ + lm) * 512 + h * 128 + 16 * kt_ + 4 * kq); \
                kv[u][kk] = *(const s16x4*)(KTp + (unsigned)((cb_ + 16 * kt_ + lm) * 16 + 4 * kq)); } \
            _Pragma("unroll") for (int vt = 0; vt < 2; ++vt) vbn[u][vt] = *(const s16x4*)(VHT + (unsigned)((cb_ + 32 * vq + 16 * vt + lm) * 16 + 4 * kq)); \
            if (vq == u) g8 = *(const v2u*)(Gp + cb_ + 2 * lane); } } while (0)
#define B3_STORE(STG) do { _Pragma("unroll") for (int u = 0; u < 2; ++u) { \
            _Pragma("unroll") for (int kk = 0; kk < 2; ++kk) { const int f_ = u * 8 + 2 * vq + kk; \
                *(LAS s16x4*)((STG) + f_ * 512 + lane * 8) = qv[u][kk]; *(LAS s16x4*)((STG) + 8192 + f_ * 512 + lane * 8) = kv[u][kk]; } \
            if (vq == u) *(LAS v2u*)((STG) + 16384 + u * 512 + lane * 8) = g8; } } while (0)
        B3_LOADS(0);
        {
            LAS v2u* PA = (LAS v2u*)(lds + 135168);
            bf16x8 kn4[4][4], qn4[4][4];
#pragma unroll
            for (int q = 0; q < 4; ++q) { const size_t r0 = ((size_t)b * 128 + seg * 16 + vq + 4 * q) * 16;
#pragma unroll
                for (int ii = 0; ii < 4; ++ii) { const size_t o = (r0 + lm) * 512 + h * 128 + 32 * ii + 8 * kq; kn4[q][ii] = *(const bf16x8*)(Kn + o); qn4[q][ii] = *(const bf16x8*)(Qn + o); } }
#pragma unroll
            for (int q = 0; q < 4; ++q) { f32x4 at = (f32x4){0.f, 0.f, 0.f, 0.f};
#pragma unroll
                for (int ii = 0; ii < 4; ++ii) at = __builtin_amdgcn_mfma_f32_16x16x32_bf16(kn4[q][ii], qn4[q][ii], at, 0, 0, 0);
#pragma unroll
                for (int j = 0; j < 4; ++j) { const int s = 4 * kq + j; const bool keep = dir ? (s >= lm) : (s <= lm); at[j] = keep ? at[j] : 0.f; }
                v2u w; w.x = cvt_pk_bf16(at[0], at[1]); w.y = cvt_pk_bf16(at[2], at[3]);
                PA[(dir * 16 + vq + 4 * q) * 64 + lane] = w; }
        }
        __syncthreads();
        B3_STORE(stg0);
        s16x4 vbr[2][2];
#pragma unroll
        for (int u = 0; u < 2; ++u) { vbr[u][0] = vbn[u][0]; vbr[u][1] = vbn[u][1]; }
        for (int it = 0; it < 8; ++it) {
            __syncthreads();
            LAS unsigned char* stg = stg0 + (it & 1) * 34816;
            if (it < 7) B3_LOADS(it + 1);
            __builtin_amdgcn_sched_barrier(0);
#pragma unroll
            for (int u = 0; u < 2; ++u) { const int cl = dir ? 15 - (2 * it + u) : 2 * it + u;
                union { s16x4 v; v2u u2; } pa; pa.u2 = ((const LAS v2u*)(lds + 135168))[(dir * 16 + cl) * 64 + lane];
                f32x4 o2[2]; o2[0] = (f32x4){0.f, 0.f, 0.f, 0.f}; o2[1] = (f32x4){0.f, 0.f, 0.f, 0.f};
#pragma unroll
                for (int kt = 0; kt < 8; ++kt) { const s16x4 q4 = *(const LAS s16x4*)(stg + (u * 8 + kt) * 512 + lane * 8);
#pragma unroll
                    for (int vt = 0; vt < 2; ++vt) { union { s16x4 v; unsigned u[2]; } sb; sb.u[0] = cvt_pk_bf16(S[kt][vt][0], S[kt][vt][1]); sb.u[1] = cvt_pk_bf16(S[kt][vt][2], S[kt][vt][3]);
                        o2[vt] = __builtin_amdgcn_mfma_f32_16x16x16bf16_1k(q4, sb.v, o2[vt], 0, 0, 0); } }
#pragma unroll
                for (int vt = 0; vt < 2; ++vt) { o2[vt] = __builtin_amdgcn_mfma_f32_16x16x16bf16_1k(pa.v, vbr[u][vt], o2[vt], 0, 0, 0);
#pragma unroll
                    for (int j = 0; j < 4; ++j) { LAS unsigned short* op = ob + (16 * cl + 4 * kq + j) * 128 + 32 * vq + 16 * vt + lm;
                        const float val = (it < 4) ? o2[vt][j] : (bflo((unsigned)*op) + o2[vt][j]); *op = f2bf(val); } }
#pragma unroll
                for (int kt = 0; kt < 8; ++kt) { const s16x4 ka = *(const LAS s16x4*)(stg + 8192 + (u * 8 + kt) * 512 + lane * 8); const f32x4 g = *(const LAS f32x4*)(stg + 16384 + u * 512 + (16 * kt + 4 * kq) * 4);
#pragma unroll
                    for (int vt = 0; vt < 2; ++vt) { S[kt][vt] = __builtin_amdgcn_mfma_f32_16x16x16bf16_1k(ka, vbr[u][vt], S[kt][vt], 0, 0, 0); S[kt][vt] = S[kt][vt] * g; } }
            }
            __builtin_amdgcn_sched_barrier(0);
            if (it < 7) { B3_STORE(stg0 + ((it + 1) & 1) * 34816);
#pragma unroll
                for (int u = 0; u < 2; ++u) { vbr[u][0] = vbn[u][0]; vbr[u][1] = vbn[u][1]; } }
        }
#undef B3_LOADS
#undef B3_STORE
        v4u ggp[8];
#pragma unroll
        for (int i = 0; i < 8; ++i) ggp[i] = *(const v4u*)(GHG + ((size_t)b * SEQ + seg * 256 + wave * 32 + 4 * i + kq) * 512 + h * 128 + 8 * lm);
        __syncthreads();
#pragma unroll
        for (int i = 0; i < 8; ++i) { const int tl = wave * 32 + 4 * i + kq; const size_t row = (size_t)b * SEQ + seg * 256 + tl;
            const v4u ov = *(const LAS v4u*)(ob + tl * 128 + 8 * lm);
            const f32x4 v0 = (f32x4){bflo(ov.x), bfhi(ov.x), bflo(ov.y), bfhi(ov.y)}, v1 = (f32x4){bflo(ov.z), bfhi(ov.z), bflo(ov.w), bfhi(ov.w)};
            const v4u gg = ggp[i];
            float s = (v0.x * v0.x + v0.y * v0.y) + (v0.z * v0.z + v0.w * v0.w) + (v1.x * v1.x + v1.y * v1.y) + (v1.z * v1.z + v1.w * v1.w);
            s += __shfl_xor(s, 1); s += __shfl_xor(s, 2); s += __shfl_xor(s, 4); s += __shfl_xor(s, 8);
            const float rs = rsqrtf(s * (1.0f / 128.0f) + EPS);
            v4u o; o.x = cvt_pk_bf16(v0.x * rs * bflo(gg.x), v0.y * rs * bfhi(gg.x)); o.y = cvt_pk_bf16(v0.z * rs * bflo(gg.y), v0.w * rs * bfhi(gg.y));
            o.z = cvt_pk_bf16(v1.x * rs * bflo(gg.z), v1.y * rs * bfhi(gg.z)); o.w = cvt_pk_bf16(v1.z * rs * bflo(gg.w), v1.w * rs * bfhi(gg.w));
            *(v4u*)(OHG + row * 512 + h * 128 + 8 * lm) = o; }
        __syncthreads();
    }
    PHASE_BAR();

    {
        MK_EPI(E, pg8::EM_C1A)
        pg8::Gemm g{ONA, WT_na, 2 * M, 2 * D, 512}; pg8::PairOrder S; S.init(M, D, G, vb);
        pg8::gemm_phase<pg8::EpiAll<pg8::EM_C1A>, pg8::PairOrder, true, true>(lds, g, S, E);
    }
    PHASE_BAR();
    {
        MK_EPI(E, pg8::EM_C2)
        pg8::Gemm g{MIX, WT_o, M, D, D}; pg8::StaticOrder S; S.init(M, D, G, vb);
        pg8::gemm_phase<pg8::EpiAll<pg8::EM_C2>, pg8::StaticOrder, true, true>(lds, g, S, E);
    }
    PHASE_BAR();
    {
        MK_EPI(E, pg8::EM_C3)
        pg8::Gemm g{H1B, WT_up, M, FF, D}; pg8::StaticOrder S; S.init(M, FF, G, vb);
        pg8::gemm_phase<pg8::EpiAll<pg8::EM_C3>, pg8::StaticOrder, true, true>(lds, g, S, E);
    }
    PHASE_BAR();
    {
        MK_EPI(E, pg8::EM_C4)
        pg8::Gemm g{U, WT_dn, M, D, FF}; pg8::StaticOrder S; S.init(M, D, G, vb);
        pg8::gemm_phase<pg8::EpiAll<pg8::EM_C4>, pg8::StaticOrder, true, true>(lds, g, S, E);
    }

}

extern "C" void kernel_launch(void* const* d_in, const int* in_sizes, int n_in, void* d_out, int out_size, void* d_ws, size_t ws_size, hipStream_t stream) {
    static int grid = 0;
    if (grid == 0) {
        if (n_in != 14 || in_sizes[0] != M * D || out_size != M * D || ws_size < WS_END) { fprintf(stderr, "kernel_launch: unexpected shapes / workspace (n_in %d, in0 %d, out %d, ws %zu)\n", n_in, n_in > 0 ? in_sizes[0] : -1, out_size, ws_size); grid = -1; return; }
        int dev = 0, cus = 0, per_cu = 0;
        if (hipGetDevice(&dev) != hipSuccess || hipDeviceGetAttribute(&cus, hipDeviceAttributeMultiprocessorCount, dev) != hipSuccess) { grid = -1; return; }
        if (hipFuncSetAttribute((const void*)mk_fwd, hipFuncAttributeMaxDynamicSharedMemorySize, LDS_BYTES) != hipSuccess) { fprintf(stderr, "kernel_launch: hipFuncSetAttribute failed\n"); grid = -1; return; }
        if (hipOccupancyMaxActiveBlocksPerMultiprocessor(&per_cu, (const void*)mk_fwd, NWAVES * 64, LDS_BYTES) != hipSuccess || per_cu < 1) { fprintf(stderr, "kernel_launch: occupancy query failed (%d)\n", per_cu); (void)hipGetLastError(); per_cu = 1; }
        if (cus != 256) fprintf(stderr, "kernel_launch: built for a 256-CU device (found %d)\n", cus);
        grid = 256;
    }
    if (grid < 0) return;
    Args a{};
    for (int i = 0; i < 14; ++i) a.in[i] = (const float*)d_in[i];
    a.out = (float*)d_out; a.ws = (unsigned char*)d_ws;
    if (hipMemsetAsync((char*)d_ws + WS_BAR, 0, BAR_BYTES, stream) != hipSuccess) { fprintf(stderr, "kernel_launch: memset failed\n"); return; }
    hipLaunchKernelGGL(mk_fwd, dim3(grid), dim3(NWAVES * 64), LDS_BYTES, stream, a);
    const hipError_t e = hipPeekAtLastError();
    if (e != hipSuccess) fprintf(stderr, "kernel_launch: launch failed: %s (grid %d)\n", hipGetErrorName(e), grid);
}
```

```cpp
#include <hip/hip_runtime.h>
#include <cstdio>
#include <cstdint>
constexpr int NWAVES = 8;
constexpr int NB = 8, SEQ = 2048, D = 1024, M = NB * SEQ, NIN = 6144, FF = 4096;
constexpr float EPS = 1e-6f;
constexpr size_t MiB = 1u << 20, KiB = 1024;
constexpr size_t WS_SSQ1 = 245 * MiB, WS_SSQ2 = 246 * MiB,
                WS_KNAM = 128 * KiB, WS_VTM = 144 * KiB, WS_KFTM = 160 * KiB, WS_VHTM = 176 * KiB, WS_GFM = 192 * KiB, WS_LB = 196 * KiB, WS_DSEG = 256 * KiB;
constexpr size_t WS_WIN = 1 * MiB, WS_WNA = 13 * MiB, WS_WHG = 14 * MiB, WS_WO = 15 * MiB, WS_WUP = 17 * MiB, WS_WDN = 237 * MiB;
constexpr size_t WS_XN = 25 * MiB;
constexpr size_t WS_QNA = 57 * MiB, WS_KNA = 73 * MiB, WS_VT = 89 * MiB, WS_QF = 105 * MiB, WS_QB = 121 * MiB, WS_KF = 137 * MiB, WS_KFT = 153 * MiB, WS_KB = 169 * MiB, WS_KBT = 185 * MiB,
                 WS_VHT = 201 * MiB, WS_GHG = 217 * MiB, WS_GF = 233 * MiB, WS_GB = 235 * MiB;
constexpr size_t WS_OHG = WS_KNA;
constexpr size_t WS_T = WS_VT, WS_MIX = WS_KF, WS_U = WS_QNA, WS_END = 247 * MiB;
constexpr int LDS_BYTES = 163840, LDS_CTL = 162816;
constexpr size_t WS_C4CNT = 768 * 1024 + 16 * 1024;

namespace pg8 {
#define PG8_LAS __attribute__((address_space(3)))
typedef unsigned short bf16_t;
typedef short bf16x8 __attribute__((ext_vector_type(8)));
typedef float f32x4 __attribute__((ext_vector_type(4)));
typedef unsigned u32x4 __attribute__((ext_vector_type(4)));
constexpr int BM = 256, BK = 64, HALF = 128, HTB = HALF * BK * 2  , STAGE_BYTES = 8 * HTB, NXCD = 8, WGM = 8;

__host__ __device__ __forceinline__ int lds_byte(int r, int c) { const int st = (r >> 4) * 2 + (c >> 5), rr = r & 15, cc = c & 31, ob = rr * 64 + cc * 2; return st * 1024 + (ob ^ (((ob >> 9) & 1) << 5)); }
__host__ __device__ __forceinline__ void stage_rc(int b, int& R, int& C) { const int st = b / 1024, sb = b % 1024, swz = sb ^ (((sb >> 9) & 1) << 5); R = (st >> 1) * 16 + swz / 64; C = (st & 1) * 32 + (swz % 64) / 2; }
__host__ __device__ __forceinline__ int perm32(int rho) { const int n = rho >> 4, i = rho & 15; return 8 * (i >> 2) + 4 * n + (i & 3); }

struct Unit { int pm, pn; };
struct Gemm { const bf16_t* A; const bf16_t* Bt; int M, N, K; };

struct StaticOrder {
    int nM, nN, nwg, G, c;
    __host__ __device__ void init(int M, int N, int G_, int c_) { nM = M / BM; nN = N / BM; nwg = nM * nN; G = G_; c = c_; }
    __host__ __device__ bool next(int i, Unit& u) const {
        const long L = (long)i * G + c; if (L >= nwg) return false;
        int wgid = (int)L; { const int q = nwg / NXCD, r = nwg % NXCD, xcd = wgid % NXCD, off = wgid / NXCD; wgid = (xcd < r ? xcd * (q + 1) : r * (q + 1) + (xcd - r) * q) + off; }
        const int nig = WGM * nN, gid = wgid / nig, fm = gid * WGM, gsz = (nM - fm) < WGM ? (nM - fm) : WGM;
        u.pm = fm + ((wgid % nig) % gsz); u.pn = (wgid % nig) / gsz; return true;
    }
    __device__ __forceinline__ void a_ready(const Unit&) const {}
    __device__ __forceinline__ void done(const Unit&) const {}
};


struct PairOrder {
    StaticOrder base; Unit u0;
    __host__ __device__ void init(int M_, int N_, int G_, int c_) { base.init(M_, N_, G_, c_); base.next(0, u0); }
    __host__ __device__ bool next(int i, Unit& u) const { if (i >= 2) return false; u.pm = u0.pm + 64 * i; u.pn = u0.pn + 4 * i; return true; }
    __device__ __forceinline__ void a_ready(const Unit&) const {}
    __device__ __forceinline__ void done(const Unit&) const {}
};

typedef float cvt_f32x2_t __attribute__((ext_vector_type(2)));
typedef __bf16 cvt_bf16x2_t __attribute__((ext_vector_type(2)));
__device__ __forceinline__ unsigned cvt_pk_bf16(float lo, float hi) { const cvt_f32x2_t v = {lo, hi}; const cvt_bf16x2_t b = __builtin_convertvector(v, cvt_bf16x2_t); return __builtin_bit_cast(unsigned, b); }
__device__ __forceinline__ unsigned short f2bf(float f) { unsigned u = __builtin_bit_cast(unsigned, f); return (unsigned short)((u + 0x7fffu + ((u >> 16) & 1u)) >> 16); }
__device__ __forceinline__ float bflo(unsigned w) { return __builtin_bit_cast(float, w << 16); }
__device__ __forceinline__ float bfhi(unsigned w) { return __builtin_bit_cast(float, w & 0xffff0000u); }
__device__ __forceinline__ float sigm(float x) { return __builtin_amdgcn_rcpf(1.0f + __expf(-x)); }
template <int CTRL> __device__ __forceinline__ float dpp_mov(float v) { return __builtin_bit_cast(float, __builtin_amdgcn_update_dpp(0, __builtin_bit_cast(int, v), CTRL, 0xf, 0xf, true)); }
__device__ __forceinline__ float row_prefix16(float v, int fr) {
    v += dpp_mov<0x111>(v); v += dpp_mov<0x112>(v); v += dpp_mov<0x114>(v); v += dpp_mov<0x118>(v); (void)fr;
    return v;
}
__device__ __forceinline__ float row_suffix16(float v, int fr) {
    v += dpp_mov<0x101>(v); v += dpp_mov<0x102>(v); v += dpp_mov<0x104>(v); v += dpp_mov<0x108>(v); (void)fr;
    return v;
}

enum EpiMode { EM_IN = 0, EM_C1A = 1, EM_C1B = 2, EM_C2 = 3, EM_C3 = 4, EM_C4 = 5 };
template <int MODE> struct EpiAll {
    static constexpr bool PERM = true, AFTER_DRAIN = false;
    static constexpr int mode = MODE; unsigned char* ws; float* out; const float* x; const float* gain; const float* gfin;
    __device__ __forceinline__ void operator()(const f32x4 (&acc)[2][2][4][2], const Unit& u, int wr, int wc, int fr, int fq) const {
        const int pn = u.pn;
        const int row0 = u.pm * BM + wr * 64 + fr;
#define EP_B(off) ((bf16_t*)(ws + (off)))
#define EP_F(off) ((float*)(ws + (off)))
        bf16_t* const QNA = EP_B(WS_QNA); bf16_t* const KNA = EP_B(WS_KNA); bf16_t* const VT = EP_B(WS_VT); bf16_t* const QF = EP_B(WS_QF); bf16_t* const QB = EP_B(WS_QB); bf16_t* const KF = EP_B(WS_KF); bf16_t* const KB = EP_B(WS_KB);
        bf16_t* const KFT = EP_B(WS_KFT); bf16_t* const KBT = EP_B(WS_KBT); bf16_t* const VHT = EP_B(WS_VHT); bf16_t* const GHG = EP_B(WS_GHG); float* const GF = EP_F(WS_GF); float* const GB = EP_F(WS_GB); const float* const LB = EP_F(WS_LB);
        bf16_t* const SNA = (bf16_t*)out; bf16_t* const SHG = (bf16_t*)out + (size_t)M * D;
        bf16_t* const T = EP_B(WS_T); bf16_t* const MIX = EP_B(WS_MIX); bf16_t* const H1B = EP_B(WS_XN); bf16_t* const U = EP_B(WS_U); float* const ssq1 = EP_F(WS_SSQ1); float* const ssq2 = EP_F(WS_SSQ2);
#undef EP_B
#undef EP_F
        const int cl0 = wc * 32 + 8 * fq;
        if (mode == EM_IN) {
            if (pn < 4) {
                bf16_t* base = (pn < 2) ? QNA : KNA; const float sc = (pn < 2) ? 0.125f : 1.0f; const int colt = (pn & 1) * 256 + cl0;
#pragma unroll
                for (int ai = 0; ai < 2; ++ai)
#pragma unroll
                    for (int m = 0; m < 4; ++m) { bf16_t* rowp = base + (size_t)(row0 + ai * HALF + m * 16) * 512 + colt;
#pragma unroll
                        for (int bj = 0; bj < 2; ++bj) { const f32x4 v0 = acc[ai][bj][m][0] * sc, v1 = acc[ai][bj][m][1] * sc; u32x4 w;
                            w.x = cvt_pk_bf16(v0[0], v0[1]); w.y = cvt_pk_bf16(v0[2], v0[3]); w.z = cvt_pk_bf16(v1[0], v1[1]); w.w = cvt_pk_bf16(v1[2], v1[3]);
                            *(u32x4*)(rowp + bj * HALF) = w; } }
            } else if (pn < 6) {
                const int colt = (pn - 4) * 256 + cl0;
#pragma unroll
                for (int ai = 0; ai < 2; ++ai)
#pragma unroll
                    for (int m = 0; m < 4; ++m) { const int row = row0 + ai * HALF + m * 16; const int b = row >> 11, t = row & 2047, r = t >> 6, c = t & 63;
#pragma unroll
                        for (int bj = 0; bj < 2; ++bj) { const int col = colt + bj * HALF; const int h = col >> 6, d0 = col & 63;
                            bf16_t* bp = VT + ((((size_t)(b * 8 + h) * 32 + r) * 64 + d0) * 64 + c);
#pragma unroll
                            for (int n = 0; n < 2; ++n)
#pragma unroll
                                for (int j = 0; j < 4; ++j) bp[(4 * n + j) * 64] = f2bf(acc[ai][bj][m][n][j]); } }
            } else if (pn < 14) {
                const int ch0 = (pn - 6) * 64 + wc * 16 + fq * 4;
                const f32x4 lbf = *(const f32x4*)(LB + ch0), lbb = *(const f32x4*)(LB + 512 + ch0);
#pragma unroll
                for (int ai = 0; ai < 2; ++ai)
#pragma unroll
                    for (int m = 0; m < 4; ++m) { const int row = row0 + ai * HALF + m * 16; const int chunk = row >> 4;
                        const f32x4 q = acc[ai][0][m][0], zf = acc[ai][0][m][1], zb = acc[ai][1][m][0], iv = acc[ai][1][m][1];
                        float qfv[4], kfv[4], qbv[4], kbv[4]; f32x4 gfv, gbv;
#pragma unroll
                        for (int j = 0; j < 4; ++j) {
                            const float qs = q[j] * sigm(q[j]);
                            const float ff = lbf[j] + (1.0f - lbf[j]) * sigm(zf[j]);
                            const float fb = lbb[j] + (1.0f - lbb[j]) * sigm(zb[j]);
                            const float bf_ = row_prefix16(__builtin_amdgcn_logf(ff) * 0.69314718056f, fr), bb_ = row_suffix16(__builtin_amdgcn_logf(fb) * 0.69314718056f, fr);
                            const float ef = __expf(bf_), eb = __expf(bb_);
                            qfv[j] = qs * ef; kfv[j] = (1.0f - ff) * __expf(-bf_);
                            qbv[j] = qs * eb; kbv[j] = (1.0f - fb) * __expf(-bb_);
                            gfv[j] = ef; gbv[j] = eb;
                        }
                        typedef unsigned u32x2 __attribute__((ext_vector_type(2)));
                        const size_t ro = (size_t)row * 512 + ch0;
                        u32x2 w;
                        w.x = cvt_pk_bf16(qfv[0], qfv[1]); w.y = cvt_pk_bf16(qfv[2], qfv[3]); *(u32x2*)(QF + ro) = w;
                        w.x = cvt_pk_bf16(qbv[0], qbv[1]); w.y = cvt_pk_bf16(qbv[2], qbv[3]); *(u32x2*)(QB + ro) = w;
                        w.x = cvt_pk_bf16(kfv[0], kfv[1]); w.y = cvt_pk_bf16(kfv[2], kfv[3]); *(u32x2*)(KF + ro) = w;
                        w.x = cvt_pk_bf16(kbv[0], kbv[1]); w.y = cvt_pk_bf16(kbv[2], kbv[3]); *(u32x2*)(KB + ro) = w;
                        const size_t to = ((size_t)chunk * 512 + ch0) * 16 + fr;
#pragma unroll
                        for (int j = 0; j < 4; ++j) { KFT[to + j * 16] = f2bf(kfv[j]); KBT[to + j * 16] = f2bf(kbv[j]); VHT[to + j * 16] = f2bf(iv[j]); }
                        if (fr == 15) *(f32x4*)(GF + (size_t)chunk * 512 + ch0) = gfv;
                        if (fr == 0)  *(f32x4*)(GB + (size_t)chunk * 512 + ch0) = gbv;
                    }
            } else if (pn < 16) {
                const int colt = (pn - 14) * 256 + cl0;
#pragma unroll
                for (int bj = 0; bj < 2; ++bj) { const f32x4 g0 = *(const f32x4*)(gain + colt + bj * HALF), g1 = *(const f32x4*)(gain + colt + bj * HALF + 4);
#pragma unroll
                    for (int ai = 0; ai < 2; ++ai)
#pragma unroll
                        for (int m = 0; m < 4; ++m) { f32x4 v0 = acc[ai][bj][m][0], v1 = acc[ai][bj][m][1];
#pragma unroll
                            for (int j = 0; j < 4; ++j) { v0[j] = v0[j] * sigm(v0[j]) * g0[j]; v1[j] = v1[j] * sigm(v1[j]) * g1[j]; }
                            u32x4 w; w.x = cvt_pk_bf16(v0[0], v0[1]); w.y = cvt_pk_bf16(v0[2], v0[3]); w.z = cvt_pk_bf16(v1[0], v1[1]); w.w = cvt_pk_bf16(v1[2], v1[3]);
                            __builtin_nontemporal_store(w, (u32x4*)(GHG + (size_t)(row0 + ai * HALF + m * 16) * 512 + colt + bj * HALF)); } }
            } else {
                bf16_t* base = (pn < 20) ? SNA : SHG; const int colt = ((pn - 16) & 3) * 256 + cl0;
#pragma unroll
                for (int ai = 0; ai < 2; ++ai)
#pragma unroll
                    for (int m = 0; m < 4; ++m)
#pragma unroll
                        for (int bj = 0; bj < 2; ++bj) { f32x4 v0 = acc[ai][bj][m][0], v1 = acc[ai][bj][m][1];
#pragma unroll
                            for (int j = 0; j < 4; ++j) { v0[j] = sigm(v0[j]); v1[j] = sigm(v1[j]); }
                            u32x4 w; w.x = cvt_pk_bf16(v0[0], v0[1]); w.y = cvt_pk_bf16(v0[2], v0[3]); w.z = cvt_pk_bf16(v1[0], v1[1]); w.w = cvt_pk_bf16(v1[2], v1[3]);
                            __builtin_nontemporal_store(w, (u32x4*)(base + (size_t)(row0 + ai * HALF + m * 16) * 1024 + colt + bj * HALF)); }
            }
            return;
        }
        const int colt = (mode == EM_C1A ? (pn & 3) : pn) * BM + cl0;
        if (mode == EM_C1A || mode == EM_C1B) {
            const bool second = (mode == EM_C1B) || (pn >= 4); const int row0c = (mode == EM_C1A) ? (row0 & (M - 1)) : row0;
            const bf16_t* gate = second ? SHG : SNA; bf16_t* dst = second ? MIX : T;
#pragma unroll
            for (int ai = 0; ai < 2; ++ai) {
                u32x4 gv[4][2], tv[4][2];
#pragma unroll
                for (int m = 0; m < 4; ++m)
#pragma unroll
                    for (int bj = 0; bj < 2; ++bj) { const size_t off = (size_t)(row0c + ai * HALF + m * 16) * 1024 + colt + bj * HALF;
                        gv[m][bj] = __builtin_nontemporal_load((const u32x4*)(gate + off)); if (second) tv[m][bj] = *(const u32x4*)(T + off); else tv[m][bj] = (u32x4){0u, 0u, 0u, 0u}; }
#pragma unroll
                for (int m = 0; m < 4; ++m)
#pragma unroll
                    for (int bj = 0; bj < 2; ++bj) { const size_t off = (size_t)(row0c + ai * HALF + m * 16) * 1024 + colt + bj * HALF;
                        const u32x4 g = gv[m][bj], tt = tv[m][bj]; const f32x4 a0 = acc[ai][bj][m][0], a1 = acc[ai][bj][m][1];
                        const float r0 = a0[0] * bflo(g.x) + bflo(tt.x), r1 = a0[1] * bfhi(g.x) + bfhi(tt.x), r2 = a0[2] * bflo(g.y) + bflo(tt.y), r3 = a0[3] * bfhi(g.y) + bfhi(tt.y);
                        const float r4 = a1[0] * bflo(g.z) + bflo(tt.z), r5 = a1[1] * bfhi(g.z) + bfhi(tt.z), r6 = a1[2] * bflo(g.w) + bflo(tt.w), r7 = a1[3] * bfhi(g.w) + bfhi(tt.w);
                        u32x4 w; w.x = cvt_pk_bf16(r0, r1); w.y = cvt_pk_bf16(r2, r3); w.z = cvt_pk_bf16(r4, r5); w.w = cvt_pk_bf16(r6, r7);
                        *(u32x4*)(dst + off) = w; }
            }
        } else if (mode == EM_C4) {
            f32x4 (&hacc)[2][2][4][2] = const_cast<f32x4 (&)[2][2][4][2]>(acc);
#pragma unroll
            for (int ai = 0; ai < 2; ++ai)
#pragma unroll
                for (int mp = 0; mp < 2; ++mp) {
                    f32x4 pre[2][2][2];
#pragma unroll
                    for (int mm = 0; mm < 2; ++mm)
#pragma unroll
                        for (int bj = 0; bj < 2; ++bj) { const size_t off = (size_t)(row0 + ai * HALF + (2 * mp + mm) * 16) * 1024 + colt + bj * HALF;
                            const u32x4 hb = *(const u32x4*)(H1B + off);
                            pre[mm][bj][0] = (f32x4){bflo(hb.x), bfhi(hb.x), bflo(hb.y), bfhi(hb.y)}; pre[mm][bj][1] = (f32x4){bflo(hb.z), bfhi(hb.z), bflo(hb.w), bfhi(hb.w)}; }
#pragma unroll
                    for (int mm = 0; mm < 2; ++mm) { const int m = 2 * mp + mm; const int row = row0 + ai * HALF + m * 16; float s = 0.f;
#pragma unroll
                        for (int bj = 0; bj < 2; ++bj) { const f32x4 h0 = pre[mm][bj][0] + acc[ai][bj][m][0], h1 = pre[mm][bj][1] + acc[ai][bj][m][1];
                            hacc[ai][bj][m][0] = h0; hacc[ai][bj][m][1] = h1;
                            s += (h0[0] * h0[0] + h0[1] * h0[1]) + (h0[2] * h0[2] + h0[3] * h0[3]) + (h1[0] * h1[0] + h1[1] * h1[1]) + (h1[2] * h1[2] + h1[3] * h1[3]); }
                        s += __shfl_xor(s, 16); s += __shfl_xor(s, 32);
                        if (fq == 0) ssq2[(size_t)row * 16 + pn * 4 + wc] = s; }
                    asm volatile("" ::: "memory");
                }
            asm volatile("s_waitcnt vmcnt(0)" ::: "memory");
            __builtin_amdgcn_s_barrier();
            if (threadIdx.x == 0) {
                unsigned* cnt = (unsigned*)(ws + WS_C4CNT) + 16 * u.pm;
                __builtin_amdgcn_fence(__ATOMIC_RELEASE, "agent");
                asm volatile("s_waitcnt vmcnt(0)" ::: "memory");
                __hip_atomic_fetch_add(cnt, 1u, __ATOMIC_RELAXED, __HIP_MEMORY_SCOPE_AGENT);
                unsigned spins = 0;
                while (__hip_atomic_load(cnt, __ATOMIC_RELAXED, __HIP_MEMORY_SCOPE_AGENT) < 4u) { __builtin_amdgcn_s_sleep(2); if (++spins > (1u << 22)) break; }
                __builtin_amdgcn_fence(__ATOMIC_ACQUIRE, "agent");
                asm volatile("s_waitcnt vmcnt(0)" ::: "memory");
            }
            __builtin_amdgcn_s_barrier();
            asm volatile("" ::: "memory");
            const f32x4 gA0 = *(const f32x4*)(gfin + colt), gA1 = *(const f32x4*)(gfin + colt + 4), gB0 = *(const f32x4*)(gfin + colt + HALF), gB1 = *(const f32x4*)(gfin + colt + HALF + 4);
#pragma unroll
            for (int ai = 0; ai < 2; ++ai)
#pragma unroll
                for (int mp = 0; mp < 2; ++mp) {
                    f32x4 pp[2][4];
#pragma unroll
                    for (int mm = 0; mm < 2; ++mm)
#pragma unroll
                        for (int q = 0; q < 4; ++q) pp[mm][q] = *(const f32x4*)(ssq2 + (size_t)(row0 + ai * HALF + (2 * mp + mm) * 16) * 16 + 4 * q);
#pragma unroll
                    for (int mm = 0; mm < 2; ++mm) { const int m = 2 * mp + mm; const int row = row0 + ai * HALF + m * 16; const size_t off = (size_t)row * 1024 + colt;
                        const f32x4 p0 = pp[mm][0], p1 = pp[mm][1], p2 = pp[mm][2], p3 = pp[mm][3];
                        const float rs = rsqrtf(((((p0[0] + p0[1]) + (p0[2] + p0[3])) + ((p1[0] + p1[1]) + (p1[2] + p1[3]))) + (((p2[0] + p2[1]) + (p2[2] + p2[3])) + ((p3[0] + p3[1]) + (p3[2] + p3[3])))) * (1.0f / 1024.0f) + 1e-6f);
                        *(f32x4*)(out + off) = acc[ai][0][m][0] * rs * gA0; *(f32x4*)(out + off + 4) = acc[ai][0][m][1] * rs * gA1;
                        *(f32x4*)(out + off + HALF) = acc[ai][1][m][0] * rs * gB0; *(f32x4*)(out + off + HALF + 4) = acc[ai][1][m][1] * rs * gB1; }
                    asm volatile("" ::: "memory");
                }
        } else if (mode == EM_C2) {
            const float* base = (mode == EM_C2) ? x : (const float*)out; float* ssq = (mode == EM_C2) ? ssq1 : ssq2;
#pragma unroll
            for (int ai = 0; ai < 2; ++ai) {
                f32x4 pre[4][2][2];
#pragma unroll
                for (int m = 0; m < 4; ++m)
#pragma unroll
                    for (int bj = 0; bj < 2; ++bj) { const size_t off = (size_t)(row0 + ai * HALF + m * 16) * 1024 + colt + bj * HALF;
                        pre[m][bj][0] = __builtin_nontemporal_load((const f32x4*)(base + off)); pre[m][bj][1] = __builtin_nontemporal_load((const f32x4*)(base + off + 4)); }
#pragma unroll
                for (int m = 0; m < 4; ++m) { const int row = row0 + ai * HALF + m * 16; float s = 0.f;
#pragma unroll
                    for (int bj = 0; bj < 2; ++bj) { const size_t off = (size_t)row * 1024 + colt + bj * HALF;
                        const f32x4 h0 = pre[m][bj][0] + acc[ai][bj][m][0], h1 = pre[m][bj][1] + acc[ai][bj][m][1];
                        s += (h0[0] * h0[0] + h0[1] * h0[1]) + (h0[2] * h0[2] + h0[3] * h0[3]) + (h1[0] * h1[0] + h1[1] * h1[1]) + (h1[2] * h1[2] + h1[3] * h1[3]);
                        if (mode == EM_C2) { u32x4 w; w.x = cvt_pk_bf16(h0[0], h0[1]); w.y = cvt_pk_bf16(h0[2], h0[3]); w.z = cvt_pk_bf16(h1[0], h1[1]); w.w = cvt_pk_bf16(h1[2], h1[3]);
                            *(u32x4*)(H1B + off) = w; } }
                    s += __shfl_xor(s, 16); s += __shfl_xor(s, 32);
                    if (fq == 0) ssq[(size_t)row * 16 + pn * 4 + wc] = s; }
            }
        } else {
#pragma unroll
            for (int ai = 0; ai < 2; ++ai) {
                f32x4 pp[4][4];
#pragma unroll
                for (int m = 0; m < 4; ++m)
#pragma unroll
                    for (int q = 0; q < 4; ++q) pp[m][q] = *(const f32x4*)(ssq1 + (size_t)(row0 + ai * HALF + m * 16) * 16 + 4 * q);
#pragma unroll
                for (int m = 0; m < 4; ++m) { const int row = row0 + ai * HALF + m * 16;
                    const f32x4 p0 = pp[m][0], p1 = pp[m][1], p2 = pp[m][2], p3 = pp[m][3];
                    const float rs = rsqrtf(((((p0[0] + p0[1]) + (p0[2] + p0[3])) + ((p1[0] + p1[1]) + (p1[2] + p1[3]))) + (((p2[0] + p2[1]) + (p2[2] + p2[3])) + ((p3[0] + p3[1]) + (p3[2] + p3[3])))) * (1.0f / 1024.0f) + 1e-6f);
#pragma unroll
                    for (int bj = 0; bj < 2; ++bj) { f32x4 v0 = acc[ai][bj][m][0] * rs, v1 = acc[ai][bj][m][1] * rs;
#pragma unroll
                        for (int j = 0; j < 4; ++j) { const float a = fmaxf(v0[j], 0.f), b = fmaxf(v1[j], 0.f); v0[j] = a * a; v1[j] = b * b; }
                        u32x4 w; w.x = cvt_pk_bf16(v0[0], v0[1]); w.y = cvt_pk_bf16(v0[2], v0[3]); w.z = cvt_pk_bf16(v1[0], v1[1]); w.w = cvt_pk_bf16(v1[2], v1[3]);
                        *(u32x4*)(U + (size_t)row * 4096 + colt + bj * HALF) = w; } }
            }
        }
    }
};

template <class Epi, class Sched, bool ALIGN_EPI = false, bool SP2 = false>
__device__ __forceinline__ void gemm_phase(PG8_LAS unsigned char* lds, const Gemm g, const Sched& S, const Epi& E) {
    int tid_ = threadIdx.x; asm volatile("" : "+v"(tid_));
    const int tid = tid_, wid = __builtin_amdgcn_readfirstlane(tid >> 6), lane = tid & 63, wr = wid >> 2, wc = wid & 3, fr = lane & 15, fq = lane >> 4;
    const int K = g.K, nt = K / BK;
    unsigned voffA[2], voffB[2];
#pragma unroll
    for (int i = 0; i < 2; ++i) { int R, C; stage_rc(tid * 16 + i * 8192, R, C); const int Rb = Epi::PERM ? ((R & ~31) + perm32(R & 31)) : R;
        voffA[i] = (unsigned)(R * K + C) * 2u; voffB[i] = (unsigned)(Rb * K + C) * 2u; }
    const size_t kstep = (size_t)(BK * 2);
    const size_t hstep = (size_t)HALF * K * 2;
    const size_t tstep = 2 * hstep;
    const unsigned ldsw = (unsigned)wid * 1024u;
    const int aoff = lds_byte(wr * 64 + fr, fq * 8), boff = lds_byte(wc * 32 + fr, fq * 8);
#define PG8_SA(b, h) (((b) * 2 + (h)) * HTB)
#define PG8_SB(b, h) ((4 + (b) * 2 + (h)) * HTB)
#define PG8_STAGE(bufoff, gbase, voff) do { _Pragma("unroll") for (int _i = 0; _i < 2; ++_i) \
        __builtin_amdgcn_global_load_lds((const unsigned*)((const char*)(gbase) + (voff)[_i]), (PG8_LAS unsigned*)(lds + (bufoff) + ldsw + _i * 8192), 16, 0, 0); } while (0)
#define PG8_LDA(dst, b, h) do { _Pragma("unroll") for (int m = 0; m < 4; ++m) _Pragma("unroll") for (int k = 0; k < 2; ++k) dst[m][k] = *(const PG8_LAS bf16x8*)(lds + PG8_SA(b, h) + aoff + m * 2048 + k * 1024); } while (0)
#define PG8_LDB(dst, b, h) do { _Pragma("unroll") for (int n = 0; n < 2; ++n) _Pragma("unroll") for (int k = 0; k < 2; ++k) dst[n][k] = *(const PG8_LAS bf16x8*)(lds + PG8_SB(b, h) + boff + n * 2048 + k * 1024); } while (0)
#define PG8_MMA(ai, bj, At, Bt) do { __builtin_amdgcn_s_setprio(1); _Pragma("unroll") for (int m = 0; m < 4; ++m) _Pragma("unroll") for (int n = 0; n < 2; ++n) _Pragma("unroll") for (int k = 0; k < 2; ++k) \
        acc[ai][bj][m][n] = __builtin_amdgcn_mfma_f32_16x16x32_bf16(Bt[n][k], At[m][k], acc[ai][bj][m][n], 0, 0, 0); __builtin_amdgcn_s_setprio(0); } while (0)
#define PG8_WAIT_V(n) asm volatile("s_waitcnt vmcnt(" #n ")" ::: "memory")
#define PG8_WAIT_L(n) asm volatile("s_waitcnt lgkmcnt(" #n ")" ::: "memory")
#define PG8_BAR __builtin_amdgcn_s_barrier()
#define PG8_SCHED __builtin_amdgcn_sched_barrier(0)
    Unit cur, nxt; int ui = 0;
    if (!S.next(0, cur)) return;
    f32x4 acc[2][2][4][2];
#pragma unroll
    for (int a = 0; a < 2; ++a)
#pragma unroll
        for (int b = 0; b < 2; ++b)
#pragma unroll
            for (int m = 0; m < 4; ++m)
#pragma unroll
                for (int n = 0; n < 2; ++n) acc[a][b][m][n] = (f32x4){0.f, 0.f, 0.f, 0.f};
    bf16x8 At[4][2], B0[2][2], B1[2][2];
    const char* cA = (const char*)g.A + (size_t)cur.pm * tstep; const char* cB = (const char*)g.Bt + (size_t)cur.pn * tstep;
    S.a_ready(cur);
    if constexpr (SP2) {
        PG8_STAGE(PG8_SB(0, 0), cB, voffB); PG8_STAGE(PG8_SB(0, 1), cB + hstep, voffB); PG8_STAGE(PG8_SA(0, 0), cA, voffA); PG8_STAGE(PG8_SA(0, 1), cA + hstep, voffA);
        if (wr == 1) PG8_BAR;
        PG8_WAIT_V(2); PG8_BAR;
        PG8_STAGE(PG8_SB(1, 0), cB + kstep, voffB); PG8_STAGE(PG8_SA(1, 0), cA + kstep, voffA); PG8_STAGE(PG8_SB(1, 1), cB + hstep + kstep, voffB);
        PG8_WAIT_V(6); PG8_BAR;
    } else {
        PG8_STAGE(PG8_SB(0, 0), cB, voffB); PG8_STAGE(PG8_SA(0, 0), cA, voffA); PG8_STAGE(PG8_SB(0, 1), cB + hstep, voffB); PG8_STAGE(PG8_SA(0, 1), cA + hstep, voffA);
        if (wr == 1) PG8_BAR;
        PG8_WAIT_V(4); PG8_BAR;
        PG8_STAGE(PG8_SB(1, 0), cB + kstep, voffB); PG8_STAGE(PG8_SA(1, 0), cA + kstep, voffA); PG8_STAGE(PG8_SB(1, 1), cB + hstep + kstep, voffB);
        PG8_WAIT_V(6); PG8_BAR;
    }
    for (;;) {
        const bool has_next = S.next(ui + 1, nxt);
        const char* nA = has_next ? (const char*)g.A + (size_t)nxt.pm * tstep : cA; const char* nB = has_next ? (const char*)g.Bt + (size_t)nxt.pn * tstep : cB;
        for (int t = 0; t < nt; t += 2) {
            const bool last = (t == nt - 2);
            const char* a1 = cA + (size_t)(t + 1) * kstep;
            const char* a2 = last ? nA : cA + (size_t)(t + 2) * kstep; const char* b2 = last ? nB : cB + (size_t)(t + 2) * kstep;
            const char* a3 = a2 + kstep; const char* b3 = b2 + kstep;
            if (last && has_next) S.a_ready(nxt);
            if constexpr (SP2) {
            PG8_LDB(B0, 0, 0); PG8_LDB(B1, 0, 1); PG8_SCHED; PG8_LDA(At, 0, 0); PG8_STAGE(PG8_SA(1, 1), a1 + hstep, voffA);
            PG8_WAIT_V(8); PG8_WAIT_L(0); PG8_BAR; PG8_MMA(0, 0, At, B0); PG8_MMA(0, 1, At, B1); PG8_BAR; PG8_SCHED;
            PG8_LDA(At, 0, 1); PG8_STAGE(PG8_SB(0, 0), b2, voffB); PG8_STAGE(PG8_SB(0, 1), b2 + hstep, voffB); PG8_STAGE(PG8_SA(0, 0), a2, voffA);
            PG8_WAIT_V(8); PG8_WAIT_L(0); PG8_BAR; PG8_MMA(1, 0, At, B0); PG8_MMA(1, 1, At, B1); PG8_BAR; PG8_SCHED;
            PG8_LDB(B0, 1, 0); PG8_LDB(B1, 1, 1); PG8_SCHED; PG8_LDA(At, 1, 0); PG8_STAGE(PG8_SA(0, 1), a2 + hstep, voffA);
            PG8_WAIT_V(8); PG8_WAIT_L(0); PG8_BAR; PG8_MMA(0, 0, At, B0); PG8_MMA(0, 1, At, B1); PG8_BAR; PG8_SCHED;
            PG8_LDA(At, 1, 1); PG8_STAGE(PG8_SB(1, 0), b3, voffB); PG8_STAGE(PG8_SB(1, 1), b3 + hstep, voffB); PG8_STAGE(PG8_SA(1, 0), a3, voffA);
            PG8_WAIT_V(8); PG8_WAIT_L(0); PG8_BAR; PG8_MMA(1, 0, At, B0); PG8_MMA(1, 1, At, B1); PG8_BAR; PG8_SCHED;
            } else {
            PG8_LDB(B0, 0, 0); PG8_SCHED; PG8_LDA(At, 0, 0); PG8_STAGE(PG8_SA(1, 1), a1 + hstep, voffA);
            PG8_WAIT_L(8); PG8_BAR; PG8_WAIT_L(0); PG8_MMA(0, 0, At, B0); PG8_BAR; PG8_SCHED;
            PG8_LDB(B1, 0, 1); PG8_STAGE(PG8_SB(0, 0), b2, voffB);
            PG8_BAR; PG8_WAIT_L(0); PG8_MMA(0, 1, At, B1); PG8_BAR;
            PG8_LDA(At, 0, 1); PG8_STAGE(PG8_SA(0, 0), a2, voffA);
            PG8_BAR; PG8_WAIT_L(0); PG8_MMA(1, 0, At, B0); PG8_BAR; PG8_SCHED;
            PG8_STAGE(PG8_SB(0, 1), b2 + hstep, voffB);
            PG8_WAIT_V(6); PG8_BAR; PG8_MMA(1, 1, At, B1); PG8_BAR;
            PG8_LDB(B0, 1, 0); PG8_SCHED; PG8_LDA(At, 1, 0); PG8_STAGE(PG8_SA(0, 1), a2 + hstep, voffA);
            PG8_WAIT_L(8); PG8_BAR; PG8_WAIT_L(0); PG8_MMA(0, 0, At, B0); PG8_BAR; PG8_SCHED;
            PG8_LDB(B1, 1, 1); PG8_STAGE(PG8_SB(1, 0), b3, voffB);
            PG8_BAR; PG8_WAIT_L(0); PG8_MMA(0, 1, At, B1); PG8_BAR;
            PG8_LDA(At, 1, 1); PG8_STAGE(PG8_SA(1, 0), a3, voffA);
            PG8_BAR; PG8_WAIT_L(0); PG8_MMA(1, 0, At, B0); PG8_BAR; PG8_SCHED;
            PG8_STAGE(PG8_SB(1, 1), b3 + hstep, voffB);
            PG8_WAIT_V(6); PG8_BAR; PG8_MMA(1, 1, At, B1); PG8_BAR;
            }
        }
        if constexpr (ALIGN_EPI) { if (wr == 0) PG8_BAR; }
        if constexpr (!Epi::AFTER_DRAIN) { E(acc, cur, wr, wc, fr, fq); S.done(cur); }
        if (!has_next) break;
#pragma unroll
        for (int a = 0; a < 2; ++a)
#pragma unroll
            for (int b = 0; b < 2; ++b)
#pragma unroll
                for (int m = 0; m < 4; ++m)
#pragma unroll
                    for (int n = 0; n < 2; ++n) acc[a][b][m][n] = (f32x4){0.f, 0.f, 0.f, 0.f};
        cur = nxt; cA = nA; cB = nB; ++ui;
        if constexpr (ALIGN_EPI) { if (wr == 1) PG8_BAR; }
    }
    PG8_WAIT_V(0);
    if constexpr (!ALIGN_EPI) { if (wr == 0) PG8_BAR; }
    PG8_BAR;
    if constexpr (Epi::AFTER_DRAIN) { E.fused(acc, cur, wr, wc, fr, fq, lds, wid, lane); S.done(cur); }
#undef PG8_SA
#undef PG8_SB
#undef PG8_STAGE
#undef PG8_LDA
#undef PG8_LDB
#undef PG8_MMA
#undef PG8_WAIT_V
#undef PG8_WAIT_L
#undef PG8_BAR
#undef PG8_SCHED
}
}

#define GAS __attribute__((address_space(1)))
#define LAS __attribute__((address_space(3)))
typedef unsigned short bf16;
typedef unsigned v4u __attribute__((ext_vector_type(4)));
typedef unsigned v2u __attribute__((ext_vector_type(2)));
typedef float f32x4 __attribute__((ext_vector_type(4)));
typedef float f32x2 __attribute__((ext_vector_type(2)));
typedef short bf16x8 __attribute__((ext_vector_type(8)));
typedef short s16x4 __attribute__((ext_vector_type(4)));
using pg8::f2bf; using pg8::cvt_pk_bf16; using pg8::bflo; using pg8::bfhi;


__device__ __forceinline__ float wave_sum(float v) {
#pragma unroll
    for (int o = 1; o < 64; o <<= 1) v += __shfl_xor(v, o);
    return v;
}
__device__ __forceinline__ unsigned pk2(float lo, float hi) { return (unsigned)f2bf(lo) | ((unsigned)f2bf(hi) << 16); }

#define XB_TMO      128
#define XB_XCNT(j)  (256  + 64 * (j))
#define XB_XSUB(j)  (1280 + 64 * (j))
#define XB_XGEN(j)  (2304 + 64 * (j))
#define XB_TOP      3328
#define XB_TOPGEN   3392
#define XCD_BAR_WORDS 3456
#define XB_SPIN_CAP (1u << 18)

__device__ __forceinline__ unsigned xb_ld(unsigned* p)              { return __hip_atomic_load(p, __ATOMIC_RELAXED, __HIP_MEMORY_SCOPE_AGENT); }
__device__ __forceinline__ unsigned xb_add(unsigned* p, unsigned v) { return __hip_atomic_fetch_add(p, v, __ATOMIC_RELAXED, __HIP_MEMORY_SCOPE_AGENT); }
__device__ __forceinline__ unsigned xb_xcc_id() { return (unsigned)__builtin_amdgcn_s_getreg((3 << 11) | 20) & 0xFu; }
#define XB_SPIN(cond, bar) do { unsigned _sp = 0; while (cond) { __builtin_amdgcn_s_sleep(1); \
    if ((++_sp & 255u) == 0u) { if (xb_ld(&(bar)[XB_TMO])) break; if (_sp > XB_SPIN_CAP) { atomicAdd(&(bar)[XB_TMO], 1u); break; } } } } while (0)

struct XcdBarrier {
    unsigned* bar; unsigned x;
    volatile LAS unsigned* st;
};

__device__ __forceinline__ XcdBarrier xcd_barrier_post(unsigned* bar, volatile LAS unsigned* st) {
    XcdBarrier b; b.bar = bar; b.x = xb_xcc_id(); b.st = st;
    if (threadIdx.x == 0) (void)xb_add(&bar[XB_XCNT(b.x)], 1u);
    return b;
}
__device__ __forceinline__ void xcd_barrier_complete(unsigned* bar, unsigned x, unsigned& nloc, unsigned& nx) {
    const unsigned G = gridDim.x * gridDim.y * gridDim.z;
    unsigned sum, cnt, mine, sp = 0u;
    for (;;) {
        sum = 0u; cnt = 0u; mine = 0u;
#pragma unroll
        for (unsigned j = 0; j < 16; ++j) { const unsigned c = xb_ld(&bar[XB_XCNT(j)]); sum += c; cnt += (c > 0u) ? 1u : 0u; mine = (j == x) ? c : mine; }
        if (sum == G) break;
        __builtin_amdgcn_s_sleep(1);
        if ((++sp & 255u) == 0u) { if (xb_ld(&bar[XB_TMO])) break; if (sp > XB_SPIN_CAP) { atomicAdd(&bar[XB_TMO], 1u); break; } }
    }
    nloc = mine > 0u ? mine : 1u; nx = cnt > 0u ? cnt : 1u;
}

__device__ __forceinline__ void xcd_barrier(const XcdBarrier& b) {
    asm volatile("s_waitcnt vmcnt(0)" ::: "memory");
    __syncthreads();
    if (threadIdx.x == 0) {
        unsigned* bar = b.bar;
        __builtin_amdgcn_s_waitcnt(0);
        unsigned nloc = b.st[0], nx = b.st[1];
        if (nloc == 0u) { xcd_barrier_complete(bar, b.x, nloc, nx); b.st[0] = nloc; b.st[1] = nx; }
        const unsigned old = xb_add(&bar[XB_XSUB(b.x)], 1u);
        const unsigned gen = old / nloc;
        if (old + 1u == (gen + 1u) * nloc) {
            __builtin_amdgcn_fence(__ATOMIC_RELEASE, "agent");
            asm volatile("s_waitcnt vmcnt(0)" ::: "memory");
            const unsigned og = xb_add(&bar[XB_TOP], 1u);
            const unsigned tg = og / nx;
            if (og + 1u == (tg + 1u) * nx) xb_add(&bar[XB_TOPGEN], 1u);
            else XB_SPIN(xb_ld(&bar[XB_TOPGEN]) == tg, bar);
            __builtin_amdgcn_fence(__ATOMIC_ACQUIRE, "agent");
            xb_add(&bar[XB_XGEN(b.x)], 1u);
            asm volatile("s_waitcnt vmcnt(0)" ::: "memory");
        } else {
            XB_SPIN(xb_ld(&bar[XB_XGEN(b.x)]) == gen, bar);
            __builtin_amdgcn_fence(__ATOMIC_ACQUIRE, "agent");
            asm volatile("s_waitcnt vmcnt(0)" ::: "memory");
        }
    }
    __syncthreads();
}

#define XL_SUB(j) (5120 + 64 * (j))
#define XL_GEN(j) (5632 + 64 * (j))
__device__ __forceinline__ void xcd_local_barrier(const XcdBarrier& b) {
    asm volatile("s_waitcnt vmcnt(0)" ::: "memory");
    __syncthreads();
    if (threadIdx.x == 0) {
        unsigned* bar = b.bar; const unsigned nloc = b.st[0];
        const unsigned old = xb_add(&bar[XL_SUB(b.x)], 1u), gen = old / nloc;
        if (old + 1u == (gen + 1u) * nloc) xb_add(&bar[XL_GEN(b.x)], 1u);
        else XB_SPIN(xb_ld(&bar[XL_GEN(b.x)]) == gen, bar);
        __builtin_amdgcn_fence(__ATOMIC_ACQUIRE, "agent");
        asm volatile("s_waitcnt vmcnt(0)" ::: "memory");
    }
    __syncthreads();
}
constexpr size_t WS_BAR = 768 * KiB, BAR_BYTES = 24 * KiB;
struct Args { const float* in[14]; float* out; unsigned char* ws; };

template <class CM>
__device__ __forceinline__ void tr_item(const float* W, int K, int N, bf16* WT, const float* kscale, LAS float* scr, int item, int lane, CM cmap) {
    const int nblk = N / 32, kb = item / nblk, nb = item % nblk, k0 = 64 * kb, n0 = 32 * nb;
    const int src = cmap(n0 + (lane & 31));
    float tv[32];
#pragma unroll
    for (int i = 0; i < 32; ++i) tv[i] = __builtin_nontemporal_load(W + (size_t)(k0 + 2 * i + (lane >> 5)) * N + src);
#pragma unroll
    for (int i = 0; i < 32; ++i) { const int kk = 2 * i + (lane >> 5); float v = tv[i]; if (kscale) v *= kscale[k0 + kk]; scr[kk * 33 + (lane & 31)] = v; }
    asm volatile("s_waitcnt lgkmcnt(0)" ::: "memory");
    const int c = lane & 7;
#pragma unroll
    for (int j = 0; j < 4; ++j) { const int n = (lane >> 3) + 8 * j; const LAS float* s = scr + (8 * c) * 33 + n;
        v4u o; o.x = pk2(s[0 * 33], s[1 * 33]); o.y = pk2(s[2 * 33], s[3 * 33]); o.z = pk2(s[4 * 33], s[5 * 33]); o.w = pk2(s[6 * 33], s[7 * 33]);
        *(v4u*)(WT + (size_t)(n0 + n) * K + k0 + 8 * c) = o; }
    asm volatile("s_waitcnt lgkmcnt(0)" ::: "memory");
}
struct CmId { __device__ __forceinline__ int operator()(int n) const { return n; } };
struct CmIn {
    __device__ __forceinline__ int operator()(int n) const {
        if (n < 1536 || n >= 3584) return n;
        const int q = n - 1536, j = q >> 8, cl = q & 255;
        const int sel = 2 * (cl >> 7) + ((cl >> 2) & 1), ch = 64 * j + 16 * ((cl >> 5) & 3) + 4 * ((cl >> 3) & 3) + (cl & 3);
        return 1536 + 512 * sel + ch;
    }
};

struct HgOps { s16x4 vb[2]; s16x4 ka[8]; f32x4 g[8]; };
__device__ __forceinline__ void hg_load(HgOps& o, const bf16* KT, const bf16* VTt, const float* G, unsigned cb, int vq, int lm, int kq) {
#pragma unroll
    for (int vt = 0; vt < 2; ++vt) o.vb[vt] = *(const s16x4*)(VTt + (unsigned)((cb + 32 * vq + 16 * vt + lm) * 16 + 4 * kq));
#pragma unroll
    for (int kt = 0; kt < 8; ++kt) { o.ka[kt] = *(const s16x4*)(KT + (unsigned)((cb + 16 * kt + lm) * 16 + 4 * kq)); o.g[kt] = *(const f32x4*)(G + (unsigned)(cb + 16 * kt + 4 * kq)); }
}
template <bool TRACKD>
__device__ __forceinline__ void hg_apply(f32x4 (&S)[8][2], f32x4 (&Dp)[8], const HgOps& o) {
#pragma unroll
    for (int kt = 0; kt < 8; ++kt) {
#pragma unroll
        for (int vt = 0; vt < 2; ++vt) { S[kt][vt] = __builtin_amdgcn_mfma_f32_16x16x16bf16_1k(o.ka[kt], o.vb[vt], S[kt][vt], 0, 0, 0); S[kt][vt] = S[kt][vt] * o.g[kt]; }
        if (TRACKD) Dp[kt] = Dp[kt] * o.g[kt];
    }
}
template <bool TRACKD>
__device__ __forceinline__ void hg_update(f32x4 (&S)[8][2], f32x4 (&Dp)[8], const bf16* KT, const bf16* VTt, const float* G, unsigned cb, int vq, int lm, int kq) {
    HgOps o; hg_load(o, KT, VTt, G, cb, vq, lm, kq); hg_apply<TRACKD>(S, Dp, o);
}

__global__ void __launch_bounds__(NWAVES * 64, 2) mk_fwd(Args args) {
    extern __shared__ __attribute__((aligned(16))) unsigned char lds_raw[];
    LAS unsigned char* lds = (LAS unsigned char*)lds_raw;
    const int tid = threadIdx.x, lane = tid & 63, wave = __builtin_amdgcn_readfirstlane(tid >> 6);
    const int G = gridDim.x, bx = blockIdx.x;
    const int gw = bx * NWAVES + wave, NGW = G * NWAVES;
    const int lm = lane & 15, kq = lane >> 4;
    unsigned char* ws = args.ws;
    if (tid < 16) ((LAS unsigned*)(lds + LDS_CTL))[tid] = 0u;
    __syncthreads();
    const XcdBarrier bar = xcd_barrier_post((unsigned*)(ws + WS_BAR), (volatile LAS unsigned*)(lds + LDS_CTL + 32));
    if (tid == 0) ((LAS unsigned*)(lds + LDS_CTL))[0] = xb_add((unsigned*)(ws + WS_BAR) + 3520 + 64 * bar.x, 1u);
    __syncthreads();
    const unsigned my_rank = ((volatile LAS unsigned*)(lds + LDS_CTL))[0];
    const float* x = args.in[0]; const float* meta = args.in[1]; const float* w_in = args.in[2]; const float* w_na = args.in[3]; const float* w_hg = args.in[4];
    const float* w_o = args.in[5]; const float* w_up = args.in[6]; const float* w_dn = args.in[7]; const float* g_mix = args.in[8]; const float* g_mlp = args.in[9];
    const float* g_fin = args.in[10]; const float* hg_gain = args.in[11]; const float* rpb = args.in[12]; const float* lb_logits = args.in[13];
    float* out = args.out;
    float* ssq1 = (float*)(ws + WS_SSQ1); float* ssq2 = (float*)(ws + WS_SSQ2);
    bf16* KNAm = (bf16*)(ws + WS_KNAM); bf16* VTm = (bf16*)(ws + WS_VTM); bf16* KFTm = (bf16*)(ws + WS_KFTM); bf16* VHTm = (bf16*)(ws + WS_VHTM);
    float* GFm = (float*)(ws + WS_GFM); float* LB = (float*)(ws + WS_LB); float* DSEG = (float*)(ws + WS_DSEG);
    bf16* WT_in = (bf16*)(ws + WS_WIN); bf16* WT_na = (bf16*)(ws + WS_WNA); bf16* WT_hg = (bf16*)(ws + WS_WHG); bf16* WT_o = (bf16*)(ws + WS_WO); bf16* WT_up = (bf16*)(ws + WS_WUP); bf16* WT_dn = (bf16*)(ws + WS_WDN);
    bf16* XN = (bf16*)(ws + WS_XN); float* SBUF = (float*)(ws + WS_XN); bf16* H1B = (bf16*)(ws + WS_XN);
    bf16* QNA = (bf16*)(ws + WS_QNA); bf16* KNA = (bf16*)(ws + WS_KNA); bf16* VT = (bf16*)(ws + WS_VT); bf16* QF = (bf16*)(ws + WS_QF); bf16* QB = (bf16*)(ws + WS_QB);
    bf16* KF = (bf16*)(ws + WS_KF); bf16* KFT = (bf16*)(ws + WS_KFT); bf16* KB = (bf16*)(ws + WS_KB); bf16* KBT = (bf16*)(ws + WS_KBT); bf16* VHT = (bf16*)(ws + WS_VHT);
    bf16* GHG = (bf16*)(ws + WS_GHG); float* GF = (float*)(ws + WS_GF); float* GB = (float*)(ws + WS_GB);
    bf16* SNA = (bf16*)out; bf16* SHG = (bf16*)out + (size_t)M * D;
    bf16* ONA = QNA; bf16* OHG = (bf16*)(ws + WS_OHG); bf16* Tb = (bf16*)(ws + WS_T); bf16* MIX = (bf16*)(ws + WS_MIX); bf16* U = (bf16*)(ws + WS_U);

    {
        f32x4 xv0[4][4];
#pragma unroll
        for (int q = 0; q < 4; ++q)
#pragma unroll
            for (int j = 0; j < 4; ++j) xv0[q][j] = __builtin_nontemporal_load((const f32x4*)(x + (size_t)(gw + q * NGW) * D + 4 * lane + 256 * j));
        {
            LAS float* mT = (LAS float*)lds;
            LAS float* red = (LAS float*)(lds + 65536);
            LAS float* fin = (LAS float*)(lds + 65536 + 32768);
#pragma unroll
            for (int rr = 0; rr < 2; ++rr) { const int r = 2 * wave + rr; const float* mr = meta + (size_t)r * D;
                f32x4 v[4]; float s = 0.f;
#pragma unroll
                for (int j = 0; j < 4; ++j) { v[j] = *(const f32x4*)(mr + 4 * lane + 256 * j); s += (v[j].x * v[j].x + v[j].y * v[j].y) + (v[j].z * v[j].z + v[j].w * v[j].w); }
                const float rs = rsqrtf(wave_sum(s) * (1.0f / D) + EPS);
#pragma unroll
                for (int j = 0; j < 4; ++j) { const f32x4 g = *(const f32x4*)(g_mix + 4 * lane + 256 * j); const int k = 4 * lane + 256 * j;
                    mT[(k + 0) * 16 + r] = v[j].x * rs * g.x; mT[(k + 1) * 16 + r] = v[j].y * rs * g.y; mT[(k + 2) * 16 + r] = v[j].z * rs * g.z; mT[(k + 3) * 16 + r] = v[j].w * rs * g.w; } }
            __syncthreads();
            for (int cbk = bx; cbk < 256; cbk += G) {
                const int c = tid & 7, ks = tid >> 3, grp = cbk >> 6, cl0 = (cbk & 63) * 8;
                const int src = (grp == 0 ? 512 : grp == 1 ? 1024 : grp == 2 ? 2048 : 3072) + cl0 + c;
                float a[16];
#pragma unroll
                for (int r = 0; r < 16; ++r) a[r] = 0.f;
                float wv[16];
#pragma unroll
                for (int kk = 0; kk < 16; ++kk) wv[kk] = w_in[(size_t)(ks * 16 + kk) * NIN + src];
#pragma unroll
                for (int kk = 0; kk < 16; ++kk) { const int k = ks * 16 + kk; const float w = wv[kk];
                    const f32x4 m0 = *(const LAS f32x4*)(mT + k * 16), m1 = *(const LAS f32x4*)(mT + k * 16 + 4), m2 = *(const LAS f32x4*)(mT + k * 16 + 8), m3 = *(const LAS f32x4*)(mT + k * 16 + 12);
                    a[0] += w * m0.x; a[1] += w * m0.y; a[2] += w * m0.z; a[3] += w * m0.w; a[4] += w * m1.x; a[5] += w * m1.y; a[6] += w * m1.z; a[7] += w * m1.w;
                    a[8] += w * m2.x; a[9] += w * m2.y; a[10] += w * m2.z; a[11] += w * m2.w; a[12] += w * m3.x; a[13] += w * m3.y; a[14] += w * m3.z; a[15] += w * m3.w; }
#pragma unroll
                for (int r = 0; r < 16; ++r) red[(ks * 16 + r) * 8 + c] = a[r];
                __syncthreads();
                if (tid < 128) { float s = 0.f;
                    for (int q = 0; q < 64; ++q) s += red[q * 128 + tid];
                    fin[tid] = s; }
                __syncthreads();
                if (tid < 8) { const int cl = cl0 + tid;
#pragma unroll
                    for (int r = 0; r < 16; ++r) a[r] = fin[r * 8 + tid];
                    if (grp == 0) {
#pragma unroll
                        for (int r = 0; r < 16; ++r) KNAm[r * 512 + cl] = f2bf(a[r]);
                    } else if (grp == 1) { const int h = cl >> 6, d = cl & 63;
#pragma unroll
                        for (int r = 0; r < 16; ++r) VTm[(h * 64 + d) * 16 + r] = f2bf(a[r]);
                    } else if (grp == 2) {
                        const float l0 = lb_logits[cl], l1 = lb_logits[512 + cl]; const float lb = 1.0f / (1.0f + expf(l1 - l0));
                        float bsum = 0.f;
#pragma unroll
                        for (int r = 0; r < 16; ++r) { const float f = lb + (1.0f - lb) * __builtin_amdgcn_rcpf(1.0f + __expf(-a[r])); bsum += __builtin_amdgcn_logf(f) * 0.69314718056f; KFTm[cl * 16 + r] = f2bf((1.0f - f) * __expf(-bsum)); }
                        GFm[cl] = __expf(bsum);
                    } else {
#pragma unroll
                        for (int r = 0; r < 16; ++r) VHTm[cl * 16 + r] = f2bf(a[r]);
                    }
                }
                __syncthreads();
            }
        }
        for (int i = bx * 4 + tid; tid < 4 && i < 1024; i += G * 4) {
            const int dir = i >> 9, c = i & 511; const float l0 = lb_logits[dir * 1024 + c], l1 = lb_logits[dir * 1024 + 512 + c]; LB[i] = 1.0f / (1.0f + expf(l1 - l0)); }
        LAS float* scr = (LAS float*)(lds + wave * 16384);
        constexpr int I_IN = (D / 64) * (NIN / 32), I_NA = (512 / 64) * (D / 32), I_O = (D / 64) * (D / 32), I_UP = (D / 64) * (FF / 32), I_DN = (FF / 64) * (D / 32);
        constexpr int NITEMS = I_IN + 2 * I_NA + I_O + I_UP + I_DN;
        for (int it = gw; it < NITEMS; it += NGW) {
            int r = it;
            if (r < I_IN) { tr_item(w_in, D, NIN, WT_in, (const float*)nullptr, scr, r, lane, CmIn()); continue; } r -= I_IN;
            if (r < I_NA) { tr_item(w_na, 512, D, WT_na, (const float*)nullptr, scr, r, lane, CmId()); continue; } r -= I_NA;
            if (r < I_NA) { tr_item(w_hg, 512, D, WT_hg, (const float*)nullptr, scr, r, lane, CmId()); continue; } r -= I_NA;
            if (r < I_O) { tr_item(w_o, D, D, WT_o, (const float*)nullptr, scr, r, lane, CmId()); continue; } r -= I_O;
            if (r < I_UP) { tr_item(w_up, D, FF, WT_up, g_mlp, scr, r, lane, CmId()); continue; } r -= I_UP;
            tr_item(w_dn, FF, D, WT_dn, (const float*)nullptr, scr, r, lane, CmId());
        }
        for (int m0 = gw; m0 < M; m0 += 4 * NGW) {
            f32x4 v[4][4];
            if (m0 == gw) {
#pragma unroll
                for (int q = 0; q < 4; ++q)
#pragma unroll
                    for (int j = 0; j < 4; ++j) v[q][j] = xv0[q][j];
            } else {
#pragma unroll
                for (int q = 0; q < 4; ++q)
#pragma unroll
                    for (int j = 0; j < 4; ++j) v[q][j] = __builtin_nontemporal_load((const f32x4*)(x + (size_t)(m0 + q * NGW) * D + 4 * lane + 256 * j));
            }
#pragma unroll
            for (int q = 0; q < 4; ++q) { const int m = m0 + q * NGW; float s = 0.f;
#pragma unroll
                for (int j = 0; j < 4; ++j) s += (v[q][j].x * v[q][j].x + v[q][j].y * v[q][j].y) + (v[q][j].z * v[q][j].z + v[q][j].w * v[q][j].w);
                const float rs = rsqrtf(wave_sum(s) * (1.0f / D) + EPS);
#pragma unroll
                for (int j = 0; j < 4; ++j) { const f32x4 g = *(const f32x4*)(g_mix + 4 * lane + 256 * j);
                    v2u o; o.x = pk2(v[q][j].x * rs * g.x, v[q][j].y * rs * g.y); o.y = pk2(v[q][j].z * rs * g.z, v[q][j].w * rs * g.w);
                    *(v2u*)(XN + (size_t)m * D + 4 * lane + 256 * j) = o; } } }
    }
    xcd_barrier(bar);

    int vb = bx; bool xl = false;
    { const unsigned nloc = ((volatile LAS unsigned*)(lds + LDS_CTL + 32))[0], nx = ((volatile LAS unsigned*)(lds + LDS_CTL + 32))[1];
      bool even = (G == 256 && nloc == 32u && nx == 8u && bar.x < 8u && my_rank < 32u);
#pragma unroll
      for (int j = 0; j < 8; ++j) even = even && (xb_ld((unsigned*)(ws + WS_BAR) + XB_XCNT(j)) == 32u);
      if (even) { vb = (int)(my_rank * 8u + bar.x); xl = true; } }
    vb = __builtin_amdgcn_readfirstlane(vb);
#define PHASE_BAR() do { if (xl) xcd_local_barrier(bar); else xcd_barrier(bar); } while (0)
    const int xq = vb & 7, rk = vb >> 3, lw = rk * 8 + wave;
#define MK_EPI(NAME, MODE) pg8::EpiAll<MODE> NAME; NAME.ws = ws; NAME.out = out; NAME.x = x; NAME.gain = hg_gain; NAME.gfin = g_fin;
    {
        MK_EPI(E, pg8::EM_IN)
        pg8::Gemm g{XN, WT_in, M, NIN, D}; pg8::StaticOrder S; S.init(M, NIN, G, vb);
        pg8::gemm_phase<pg8::EpiAll<pg8::EM_IN>, pg8::StaticOrder, true, true>(lds, g, S, E);
    }
    PHASE_BAR();

    { const int wi = xq * 256 + lw;
        const int item = wi >> 2, vq = wi & 3, seg = item & 7, dir = (item >> 3) & 1, h = (item >> 4) & 3, b = item >> 6;
        f32x4 S[8][2], Dp[8];
#pragma unroll
        for (int kt = 0; kt < 8; ++kt) { S[kt][0] = (f32x4){0.f, 0.f, 0.f, 0.f}; S[kt][1] = (f32x4){0.f, 0.f, 0.f, 0.f}; Dp[kt] = (f32x4){1.f, 1.f, 1.f, 1.f}; }
        if (dir == 0 && seg == 0) hg_update<false>(S, Dp, KFTm, VHTm, GFm, (unsigned)(h * 128), vq, lm, kq);
        const bf16* KTp = dir ? KBT : KFT; const float* Gp = dir ? GB : GF;
        const int cstep = dir ? -512 : 512; const int cb0 = (b * 128 + seg * 16 + (dir ? 15 : 0)) * 512 + h * 128;
        {
            LAS unsigned char* stg0 = lds + (wave >> 2) * 9216;
            s16x4 kv[2][2], vbn[2][2], vbr[2][2]; v2u g8 = (v2u){0u, 0u};
#define B1_LOADS(IT) do { _Pragma("unroll") for (int u = 0; u < 2; ++u) { const unsigned cb_ = (unsigned)(cb0 + (2 * (IT) + u) * cstep); \
                _Pragma("unroll") for (int kk = 0; kk < 2; ++kk) kv[u][kk] = *(const s16x4*)(KTp + (unsigned)((cb_ + 16 * (2 * vq + kk) + lm) * 16 + 4 * kq)); \
                _Pragma("unroll") for (int vt = 0; vt < 2; ++vt) vbn[u][vt] = *(const s16x4*)(VHT + (unsigned)((cb_ + 32 * vq + 16 * vt + lm) * 16 + 4 * kq)); \
                if (vq == u) g8 = *(const v2u*)(Gp + cb_ + 2 * lane); } } while (0)
#define B1_STORE(STG) do { _Pragma("unroll") for (int u = 0; u < 2; ++u) { \
                _Pragma("unroll") for (int kk = 0; kk < 2; ++kk) *(LAS s16x4*)((STG) + (u * 8 + 2 * vq + kk) * 512 + lane * 8) = kv[u][kk]; \
                if (vq == u) *(LAS v2u*)((STG) + 8192 + u * 512 + lane * 8) = g8; } } while (0)
            __syncthreads();
            B1_LOADS(0);
            B1_STORE(stg0);
#pragma unroll
            for (int u = 0; u < 2; ++u) { vbr[u][0] = vbn[u][0]; vbr[u][1] = vbn[u][1]; }
            for (int it = 0; it < 8; ++it) {
                __syncthreads();
                LAS unsigned char* stg = stg0 + (it & 1) * 18432;
                if (it < 7) B1_LOADS(it + 1);
                __builtin_amdgcn_sched_barrier(0);
#pragma unroll
                for (int u = 0; u < 2; ++u)
#pragma unroll
                    for (int kt = 0; kt < 8; ++kt) { const s16x4 ka = *(const LAS s16x4*)(stg + (u * 8 + kt) * 512 + lane * 8); const f32x4 g = *(const LAS f32x4*)(stg + 8192 + u * 512 + (16 * kt + 4 * kq) * 4);
#pragma unroll
                        for (int vt = 0; vt < 2; ++vt) { S[kt][vt] = __builtin_amdgcn_mfma_f32_16x16x16bf16_1k(ka, vbr[u][vt], S[kt][vt], 0, 0, 0); S[kt][vt] = S[kt][vt] * g; }
                        Dp[kt] = Dp[kt] * g; }
                __builtin_amdgcn_sched_barrier(0);
                if (it < 7) { B1_STORE(stg0 + ((it + 1) & 1) * 18432);
#pragma unroll
                    for (int u = 0; u < 2; ++u) { vbr[u][0] = vbn[u][0]; vbr[u][1] = vbn[u][1]; } }
            }
#undef B1_LOADS
#undef B1_STORE
        }
        float* sp = SBUF + ((size_t)(item * 4 + vq) * 16) * 256 + lane * 4;
#pragma unroll
        for (int kt = 0; kt < 8; ++kt) { *(f32x4*)(sp + (kt * 2 + 0) * 256) = S[kt][0]; *(f32x4*)(sp + (kt * 2 + 1) * 256) = S[kt][1]; }
        if (vq == 0 && lm == 0) {
#pragma unroll
            for (int kt = 0; kt < 8; ++kt) *(f32x4*)(DSEG + item * 128 + 16 * kt + 4 * kq) = Dp[kt];
        }
    }
    PHASE_BAR();

    for (int i2 = 0; i2 < 2; ++i2) { const int tl = rk * 512 + tid + 16384 * i2;
        const int bhd = xq * 8 + (tl >> 12), e4 = tl & 4095, dir = bhd & 1; const int kt = (e4 >> 7) & 7, ln = e4 & 63; const int k0 = 16 * kt + 4 * (ln >> 4);
        f32x4 carry = (f32x4){0.f, 0.f, 0.f, 0.f}, locv[8], dv[8];
#pragma unroll
        for (int s = 0; s < 8; ++s) { const int seg = dir ? 7 - s : s, item = bhd * 8 + seg;
            locv[s] = *(const f32x4*)(SBUF + (size_t)item * 16384 + e4 * 4); dv[s] = *(const f32x4*)(DSEG + item * 128 + k0); }
#pragma unroll
        for (int s = 0; s < 8; ++s) { const int seg = dir ? 7 - s : s, item = bhd * 8 + seg;
            *(f32x4*)(SBUF + (size_t)item * 16384 + e4 * 4) = carry; carry = dv[s] * carry + locv[s]; }
    }
    {
        LAS float* rp = (LAS float*)lds;
        __syncthreads();
        if (tid < 465) rp[tid] = rpb[(rk >> 2) * 465 + tid];
        __syncthreads();
        LAS unsigned char* KS = lds + 15360; LAS unsigned char* VS = lds + 15360 + 73728;
        int prev_hi = -1;
        for (int i4 = 0; i4 < 4; ++i4) {
            const int hh = rk >> 2, rg = rk & 3, rpair = 8 * rg + 2 * i4;
            const int cq = wave & 3, r = rpair + (wave >> 2), h = hh, b = xq;
            const int lo = min(max(rpair - 4, 0), 24);
            __syncthreads();
            { const int c = tid >> 3, q = tid & 7;
              if (i4 == 0) {
                v4u kreg[9], vreg[9];
#pragma unroll
                for (int e9 = 0; e9 < 9; ++e9) { const int row = min(lo + e9, 31);
                    kreg[e9] = *(const v4u*)(KNA + ((size_t)b * SEQ + row * 64 + c) * 512 + h * 64 + q * 8);
                    vreg[e9] = *(const v4u*)(VT + ((((size_t)(b * 8 + h) * 32 + row) * 64 + c) * 64 + q * 8)); }
#pragma unroll
                for (int e9 = 0; e9 < 9; ++e9) { const int kk = ((lo + e9) % 9) * 64 + c;
                    *(LAS v4u*)(KS + kk * 128 + ((q ^ (kk & 7)) * 16)) = kreg[e9]; *(LAS v4u*)(VS + kk * 128 + ((q ^ (kk & 7)) * 16)) = vreg[e9]; }
              } else {
                v4u kreg[2], vreg[2];
#pragma unroll
                for (int e2 = 0; e2 < 2; ++e2) { const int row = min(prev_hi + 1 + e2, 31);
                    kreg[e2] = *(const v4u*)(KNA + ((size_t)b * SEQ + row * 64 + c) * 512 + h * 64 + q * 8);
                    vreg[e2] = *(const v4u*)(VT + ((((size_t)(b * 8 + h) * 32 + row) * 64 + c) * 64 + q * 8)); }
#pragma unroll
                for (int e2 = 0; e2 < 2; ++e2) { const int row = prev_hi + 1 + e2;
                    if (row <= lo + 8 && row < 32) { const int kk = (row % 9) * 64 + c;
                        *(LAS v4u*)(KS + kk * 128 + ((q ^ (kk & 7)) * 16)) = kreg[e2]; *(LAS v4u*)(VS + kk * 128 + ((q ^ (kk & 7)) * 16)) = vreg[e2]; } }
              }
            }
            prev_hi = lo + 8;
            __syncthreads();
            const int c0 = 16 * cq, kc0 = (cq == 0) ? 0 : (cq == 1) ? 8 : (cq == 2) ? 24 : 32;
            const int rs0 = min(max(r - 4, 0), 24);
            const size_t rowq = (size_t)b * SEQ + r * 64 + c0 + lm;
            bf16x8 qf[2], kmf[2]; s16x4 vmf[4];
#pragma unroll
            for (int ks = 0; ks < 2; ++ks) { qf[ks] = *(const bf16x8*)(QNA + rowq * 512 + h * 64 + 32 * ks + 8 * kq); kmf[ks] = *(const bf16x8*)(KNAm + lm * 512 + h * 64 + 32 * ks + 8 * kq); }
#pragma unroll
            for (int dt = 0; dt < 4; ++dt) vmf[dt] = *(const s16x4*)(VTm + (h * 64 + 16 * dt + lm) * 16 + 4 * kq);
            const int cqq = c0 + lm, cs = min(max(cqq - 8, 0), 48);
            f32x4 oa[4];
#pragma unroll
            for (int dt = 0; dt < 4; ++dt) oa[dt] = (f32x4){0.f, 0.f, 0.f, 0.f};
            float mrun = -3.0e38f, lsum = 0.f;
#pragma unroll
            for (int hf = 0; hf < 2; ++hf) {
                f32x4 sc[9]; bf16x8 vf[4][4];
                {   bf16x8 kf[4][2][2];
#pragma unroll
                    for (int j4 = 0; j4 < 4; ++j4)
#pragma unroll
                        for (int t = 0; t < 2; ++t) { const int kcol = kc0 + 8 * (lm >> 2) + 4 * t + (lm & 3); const size_t rowk = (size_t)b * SEQ + (rs0 + 4 * hf + j4) * 64 + kcol;
#pragma unroll
                            for (int ks = 0; ks < 2; ++ks) { const int kk = ((rs0 + 4 * hf + j4) % 9) * 64 + kcol; kf[j4][t][ks] = *(const LAS bf16x8*)(KS + kk * 128 + (((ks * 4 + kq) ^ (kk & 7)) * 16)); } (void)rowk; }
                    __builtin_amdgcn_sched_barrier(0);
#pragma unroll
                    for (int j4 = 0; j4 < 4; ++j4)
#pragma unroll
                        for (int t = 0; t < 2; ++t) { f32x4 a = (f32x4){0.f, 0.f, 0.f, 0.f};
#pragma unroll
                            for (int ks = 0; ks < 2; ++ks) a = __builtin_amdgcn_mfma_f32_16x16x32_bf16(kf[j4][t][ks], qf[ks], a, 0, 0, 0);
                            sc[2 * j4 + t] = a; }
                }
                __builtin_amdgcn_sched_barrier(0);
#pragma unroll
                for (int j4 = 0; j4 < 4; ++j4)
#pragma unroll
                    for (int dt = 0; dt < 4; ++dt) { const int vv = ((rs0 + 4 * hf + j4) % 9) * 64 + 16 * dt + lm; vf[j4][dt] = *(const LAS bf16x8*)(VS + vv * 128 + ((((kc0 >> 3) + kq) ^ (vv & 7)) * 16)); }
                __builtin_amdgcn_sched_barrier(0);
                if (hf == 1) { f32x4 a = (f32x4){0.f, 0.f, 0.f, 0.f};
#pragma unroll
                    for (int ks = 0; ks < 2; ++ks) a = __builtin_amdgcn_mfma_f32_16x16x32_bf16(kmf[ks], qf[ks], a, 0, 0, 0);
                    sc[8] = a; } else sc[8] = (f32x4){-1e30f, -1e30f, -1e30f, -1e30f};
                float mx = -3.0e38f;
#pragma unroll
                for (int j4 = 0; j4 < 4; ++j4)
#pragma unroll
                    for (int t = 0; t < 2; ++t)
#pragma unroll
                        for (int j = 0; j < 4; ++j) { const int kcol = kc0 + 8 * kq + 4 * t + j; const bool inw = (kcol >= cs) && (kcol < cs + 16);
                            const int dr = rs0 + 4 * hf + j4 - r, dc = min(max(kcol - cqq, -15), 15);
                            const float bias = rp[(dr + 7) * 31 + dc + 15];
                            const float s = inw ? sc[2 * j4 + t][j] + bias : -1e30f; sc[2 * j4 + t][j] = s; mx = fmaxf(mx, s); }
#pragma unroll
                for (int j = 0; j < 4; ++j) mx = fmaxf(mx, sc[8][j]);
                mx = fmaxf(mx, __shfl_xor(mx, 16)); mx = fmaxf(mx, __shfl_xor(mx, 32));
                const float mnew = fmaxf(mrun, mx), alpha = __expf(mrun - mnew);
                mrun = mnew; lsum *= alpha;
#pragma unroll
                for (int dt = 0; dt < 4; ++dt) oa[dt] = oa[dt] * alpha;
#pragma unroll
                for (int i = 0; i < 9; ++i)
#pragma unroll
                    for (int j = 0; j < 4; ++j) { const float p = __expf(sc[i][j] - mnew); sc[i][j] = p; lsum += p; }
#pragma unroll
                for (int j4 = 0; j4 < 4; ++j4) {
                    union { bf16x8 v; unsigned u[4]; } pf;
                    pf.u[0] = cvt_pk_bf16(sc[2 * j4][0], sc[2 * j4][1]); pf.u[1] = cvt_pk_bf16(sc[2 * j4][2], sc[2 * j4][3]);
                    pf.u[2] = cvt_pk_bf16(sc[2 * j4 + 1][0], sc[2 * j4 + 1][1]); pf.u[3] = cvt_pk_bf16(sc[2 * j4 + 1][2], sc[2 * j4 + 1][3]);
#pragma unroll
                    for (int dt = 0; dt < 4; ++dt) oa[dt] = __builtin_amdgcn_mfma_f32_16x16x32_bf16(vf[j4][dt], pf.v, oa[dt], 0, 0, 0); }
                if (hf == 1) { union { s16x4 v; unsigned u[2]; } pm; pm.u[0] = cvt_pk_bf16(sc[8][0], sc[8][1]); pm.u[1] = cvt_pk_bf16(sc[8][2], sc[8][3]);
#pragma unroll
                    for (int dt = 0; dt < 4; ++dt) oa[dt] = __builtin_amdgcn_mfma_f32_16x16x16bf16_1k(vmf[dt], pm.v, oa[dt], 0, 0, 0); }
            }
            lsum += __shfl_xor(lsum, 16); lsum += __shfl_xor(lsum, 32);
            const float inv = 1.0f / lsum;
#pragma unroll
            for (int dt = 0; dt < 4; ++dt) { v2u o; o.x = cvt_pk_bf16(oa[dt][0] * inv, oa[dt][1] * inv); o.y = cvt_pk_bf16(oa[dt][2] * inv, oa[dt][3] * inv);
                *(v2u*)(ONA + rowq * 512 + h * 64 + 16 * dt + 4 * kq) = o; }
        }
        __syncthreads();
    }
    PHASE_BAR();

    { const int it = xq * 32 + rk;
        const int seg = it & 7, h = (it >> 3) & 3, b = it >> 5;
        const int dir = wave >> 2, vq = wave & 3, sitem = ((b * 4 + h) * 2 + dir) * 8 + seg;
        LAS unsigned short* ob = (LAS unsigned short*)lds;
        LAS unsigned char* stg0 = lds + 65536 + dir * 17408;
        __syncthreads();
        f32x4 S[8][2], Dp[8];
        { const float* sp = SBUF + ((size_t)(sitem * 4 + vq) * 16) * 256 + lane * 4;
#pragma unroll
          for (int kt = 0; kt < 8; ++kt) { S[kt][0] = *(const f32x4*)(sp + (kt * 2 + 0) * 256); S[kt][1] = *(const f32x4*)(sp + (kt * 2 + 1) * 256); Dp[kt] = (f32x4){1.f, 1.f, 1.f, 1.f}; } }
        if (dir == 0 && seg == 0) hg_update<false>(S, Dp, KFTm, VHTm, GFm, (unsigned)(h * 128), vq, lm, kq);
        const bf16* Qn = dir ? QB : QF; const bf16* Kn = dir ? KB : KF; const bf16* KTp = dir ? KBT : KFT; const float* Gp = dir ? GB : GF;
        s16x4 qv[2][2], kv[2][2], vbn[2][2]; v2u g8 = (v2u){0u, 0u};
#define B3_LOADS(IT) do { _Pragma("unroll") for (int u = 0; u < 2; ++u) { const int cl_ = dir ? 15 - (2 * (IT) + u) : 2 * (IT) + u; const size_t cgi_ = (size_t)b * 128 + seg * 16 + cl_, row0_ = cgi_ * 16; const unsigned cb_ = (unsigned)(cgi_ * 512 + h * 128); \
            _Pragma("unroll") for (int kk = 0; kk < 2; ++kk) { const int kt_ = 2 * vq + kk; \
                qv[u][kk] = *(const s16x4*)(Qn + (row0_ + lm) * 512 + h * 128 + 16 * kt_ + 4 * kq); \
                kv[u][kk] = *(const s16x4*)(KTp + (unsigned)((cb_ + 16 * kt_ + lm) * 16 + 4 * kq)); } \
            _Pragma("unroll") for (int vt = 0; vt < 2; ++vt) vbn[u][vt] = *(const s16x4*)(VHT + (unsigned)((cb_ + 32 * vq + 16 * vt + lm) * 16 + 4 * kq)); \
            if (vq == u) g8 = *(const v2u*)(Gp + cb_ + 2 * lane); } } while (0)
#define B3_STORE(STG) do { _Pragma("unroll") for (int u = 0; u < 2; ++u) { \
            _Pragma("unroll") for (int kk = 0; kk < 2; ++kk) { const int f_ = u * 8 + 2 * vq + kk; \
                *(LAS s16x4*)((STG) + f_ * 512 + lane * 8) = qv[u][kk]; *(LAS s16x4*)((STG) + 8192 + f_ * 512 + lane * 8) = kv[u][kk]; } \
            if (vq == u) *(LAS v2u*)((STG) + 16384 + u * 512 + lane * 8) = g8; } } while (0)
        B3_LOADS(0);
        {
            LAS v2u* PA = (LAS v2u*)(lds + 135168);
            bf16x8 kn4[4][4], qn4[4][4];
#pragma unroll
            for (int q = 0; q < 4; ++q) { const size_t r0 = ((size_t)b * 128 + seg * 16 + vq + 4 * q) * 16;
#pragma unroll
                for (int ii = 0; ii < 4; ++ii) { const size_t o = (r0 + lm) * 512 + h * 128 + 32 * ii + 8 * kq; kn4[q][ii] = *(const bf16x8*)(Kn + o); qn4[q][ii] = *(const bf16x8*)(Qn + o); } }
#pragma unroll
            for (int q = 0; q < 4; ++q) { f32x4 at = (f32x4){0.f, 0.f, 0.f, 0.f};
#pragma unroll
                for (int ii = 0; ii < 4; ++ii) at = __builtin_amdgcn_mfma_f32_16x16x32_bf16(kn4[q][ii], qn4[q][ii], at, 0, 0, 0);
#pragma unroll
                for (int j = 0; j < 4; ++j) { const int s = 4 * kq + j; const bool keep = dir ? (s >= lm) : (s <= lm); at[j] = keep ? at[j] : 0.f; }
                v2u w; w.x = cvt_pk_bf16(at[0], at[1]); w.y = cvt_pk_bf16(at[2], at[3]);
                PA[(dir * 16 + vq + 4 * q) * 64 + lane] = w; }
        }
        __syncthreads();
        B3_STORE(stg0);
        s16x4 vbr[2][2];
#pragma unroll
        for (int u = 0; u < 2; ++u) { vbr[u][0] = vbn[u][0]; vbr[u][1] = vbn[u][1]; }
        for (int it = 0; it < 8; ++it) {
            __syncthreads();
            LAS unsigned char* stg = stg0 + (it & 1) * 34816;
            if (it < 7) B3_LOADS(it + 1);
            __builtin_amdgcn_sched_barrier(0);
#pragma unroll
            for (int u = 0; u < 2; ++u) { const int cl = dir ? 15 - (2 * it + u) : 2 * it + u;
                union { s16x4 v; v2u u2; } pa; pa.u2 = ((const LAS v2u*)(lds + 135168))[(dir * 16 + cl) * 64 + lane];
                f32x4 o2[2]; o2[0] = (f32x4){0.f, 0.f, 0.f, 0.f}; o2[1] = (f32x4){0.f, 0.f, 0.f, 0.f};
#pragma unroll
                for (int kt = 0; kt < 8; ++kt) { const s16x4 q4 = *(const LAS s16x4*)(stg + (u * 8 + kt) * 512 + lane * 8);
#pragma unroll
                    for (int vt = 0; vt < 2; ++vt) { union { s16x4 v; unsigned u[2]; } sb; sb.u[0] = cvt_pk_bf16(S[kt][vt][0], S[kt][vt][1]); sb.u[1] = cvt_pk_bf16(S[kt][vt][2], S[kt][vt][3]);
                        o2[vt] = __builtin_amdgcn_mfma_f32_16x16x16bf16_1k(q4, sb.v, o2[vt], 0, 0, 0); } }
#pragma unroll
                for (int vt = 0; vt < 2; ++vt) { o2[vt] = __builtin_amdgcn_mfma_f32_16x16x16bf16_1k(pa.v, vbr[u][vt], o2[vt], 0, 0, 0);
#pragma unroll
                    for (int j = 0; j < 4; ++j) { LAS unsigned short* op = ob + (16 * cl + 4 * kq + j) * 128 + 32 * vq + 16 * vt + lm;
                        const float val = (it < 4) ? o2[vt][j] : (bflo((unsigned)*op) + o2[vt][j]); *op = f2bf(val); } }
#pragma unroll
                for (int kt = 0; kt < 8; ++kt) { const s16x4 ka = *(const LAS s16x4*)(stg + 8192 + (u * 8 + kt) * 512 + lane * 8); const f32x4 g = *(const LAS f32x4*)(stg + 16384 + u * 512 + (16 * kt + 4 * kq) * 4);
#pragma unroll
                    for (int vt = 0; vt < 2; ++vt) { S[kt][vt] = __builtin_amdgcn_mfma_f32_16x16x16bf16_1k(ka, vbr[u][vt], S[kt][vt], 0, 0, 0); S[kt][vt] = S[kt][vt] * g; } }
            }
            __builtin_amdgcn_sched_barrier(0);
            if (it < 7) { B3_STORE(stg0 + ((it + 1) & 1) * 34816);
#pragma unroll
                for (int u = 0; u < 2; ++u) { vbr[u][0] = vbn[u][0]; vbr[u][1] = vbn[u][1]; } }
        }
#undef B3_LOADS
#undef B3_STORE
        v4u ggp[8];
#pragma unroll
        for (int i = 0; i < 8; ++i) ggp[i] = __builtin_nontemporal_load((const v4u*)(GHG + ((size_t)b * SEQ + seg * 256 + wave * 32 + 4 * i + kq) * 512 + h * 128 + 8 * lm));
        __syncthreads();
#pragma unroll
        for (int i = 0; i < 8; ++i) { const int tl = wave * 32 + 4 * i + kq; const size_t row = (size_t)b * SEQ + seg * 256 + tl;
            const v4u ov = *(const LAS v4u*)(ob + tl * 128 + 8 * lm);
            const f32x4 v0 = (f32x4){bflo(ov.x), bfhi(ov.x), bflo(ov.y), bfhi(ov.y)}, v1 = (f32x4){bflo(ov.z), bfhi(ov.z), bflo(ov.w), bfhi(ov.w)};
            const v4u gg = ggp[i];
            float s = (v0.x * v0.x + v0.y * v0.y) + (v0.z * v0.z + v0.w * v0.w) + (v1.x * v1.x + v1.y * v1.y) + (v1.z * v1.z + v1.w * v1.w);
            s += __shfl_xor(s, 1); s += __shfl_xor(s, 2); s += __shfl_xor(s, 4); s += __shfl_xor(s, 8);
            const float rs = rsqrtf(s * (1.0f / 128.0f) + EPS);
            v4u o; o.x = cvt_pk_bf16(v0.x * rs * bflo(gg.x), v0.y * rs * bfhi(gg.x)); o.y = cvt_pk_bf16(v0.z * rs * bflo(gg.y), v0.w * rs * bfhi(gg.y));
            o.z = cvt_pk_bf16(v1.x * rs * bflo(gg.z), v1.y * rs * bfhi(gg.z)); o.w = cvt_pk_bf16(v1.z * rs * bflo(gg.w), v1.w * rs * bfhi(gg.w));
            *(v4u*)(OHG + row * 512 + h * 128 + 8 * lm) = o; }
        __syncthreads();
    }
    PHASE_BAR();

    {
        MK_EPI(E, pg8::EM_C1A)
        pg8::Gemm g{ONA, WT_na, 2 * M, 2 * D, 512}; pg8::PairOrder S; S.init(M, D, G, vb);
        pg8::gemm_phase<pg8::EpiAll<pg8::EM_C1A>, pg8::PairOrder, true, true>(lds, g, S, E);
    }
    PHASE_BAR();
    {
        MK_EPI(E, pg8::EM_C2)
        pg8::Gemm g{MIX, WT_o, M, D, D}; pg8::StaticOrder S; S.init(M, D, G, vb);
        pg8::gemm_phase<pg8::EpiAll<pg8::EM_C2>, pg8::StaticOrder, true, true>(lds, g, S, E);
    }
    PHASE_BAR();
    {
        MK_EPI(E, pg8::EM_C3)
        pg8::Gemm g{H1B, WT_up, M, FF, D}; pg8::StaticOrder S; S.init(M, FF, G, vb);
        pg8::gemm_phase<pg8::EpiAll<pg8::EM_C3>, pg8::StaticOrder, true, true>(lds, g, S, E);
    }
    PHASE_BAR();
    {
        MK_EPI(E, pg8::EM_C4)
        pg8::Gemm g{U, WT_dn, M, D, FF}; pg8::StaticOrder S; S.init(M, D, G, vb);
        pg8::gemm_phase<pg8::EpiAll<pg8::EM_C4>, pg8::StaticOrder, true, true>(lds, g, S, E);
    }

}

extern "C" void kernel_launch(void* const* d_in, const int* in_sizes, int n_in, void* d_out, int out_size, void* d_ws, size_t ws_size, hipStream_t stream) {
    static int grid = 0;
    if (grid == 0) {
        if (n_in != 14 || in_sizes[0] != M * D || out_size != M * D || ws_size < WS_END) { fprintf(stderr, "kernel_launch: unexpected shapes / workspace (n_in %d, in0 %d, out %d, ws %zu)\n", n_in, n_in > 0 ? in_sizes[0] : -1, out_size, ws_size); grid = -1; return; }
        int dev = 0, cus = 0, per_cu = 0;
        if (hipGetDevice(&dev) != hipSuccess || hipDeviceGetAttribute(&cus, hipDeviceAttributeMultiprocessorCount, dev) != hipSuccess) { grid = -1; return; }
        if (hipFuncSetAttribute((const void*)mk_fwd, hipFuncAttributeMaxDynamicSharedMemorySize, LDS_BYTES) != hipSuccess) { fprintf(stderr, "kernel_launch: hipFuncSetAttribute failed\n"); grid = -1; return; }
        if (hipOccupancyMaxActiveBlocksPerMultiprocessor(&per_cu, (const void*)mk_fwd, NWAVES * 64, LDS_BYTES) != hipSuccess || per_cu < 1) { fprintf(stderr, "kernel_launch: occupancy query failed (%d)\n", per_cu); (void)hipGetLastError(); per_cu = 1; }
        if (cus != 256) fprintf(stderr, "kernel_launch: built for a 256-CU device (found %d)\n", cus);
        grid = 256;
    }
    if (grid < 0) return;
    Args a{};
    for (int i = 0; i < 14; ++i) a.in[i] = (const float*)d_in[i];
    a.out = (float*)d_out; a.ws = (unsigned char*)d_ws;
    if (hipMemsetAsync((char*)d_ws + WS_BAR, 0, BAR_BYTES, stream) != hipSuccess) { fprintf(stderr, "kernel_launch: memset failed\n"); return; }
    hipLaunchKernelGGL(mk_fwd, dim3(grid), dim3(NWAVES * 64), LDS_BYTES, stream, a);
    const hipError_t e = hipPeekAtLastError();
    if (e != hipSuccess) fprintf(stderr, "kernel_launch: launch failed: %s (grid %d)\n", hipGetErrorName(e), grid);
}
```
